# Optimizing an MI355X kernel written in HIP

```python
import math
import jax, jax.numpy as jnp
from jax import lax
import numpy as np

D_MODEL = 1024
BATCH = 2
SEQ = 8192
DEPTH = 2

GRID_W = 64
CTX_LEN = 256
EPS = 1e-6
NEG_INF = -1e30

CHUNK = 128
SGU_GROUPS = 4
SGU_CH = 128
SGU_WIDTH = SGU_GROUPS * SGU_CH
HEAD_DIM = 64
N_Q_HEADS = 8
N_KV_HEADS = 2
Q_PER_KV = N_Q_HEADS // N_KV_HEADS
ATTN_WIDTH = N_Q_HEADS * HEAD_DIM
KV_WIDTH = N_KV_HEADS * HEAD_DIM
WINDOW = 128
ATTN_BLOCK = 128
ATTN_SCALE = HEAD_DIM ** -0.5
ROPE_BASE = 10000.0
ROPE_FREQS = HEAD_DIM // 4
EVEN_SPLITS = (SGU_WIDTH, 2 * SGU_WIDTH, 2 * SGU_WIDTH + ATTN_WIDTH, 2 * SGU_WIDTH + ATTN_WIDTH + KV_WIDTH)
IN_EVEN = 2 * SGU_WIDTH + ATTN_WIDTH + 2 * KV_WIDTH
MIX_EVEN = SGU_WIDTH + ATTN_WIDTH
D_RNN = 1280
LRU_BLOCKS = 10
LRU_BLOCK = D_RNN // LRU_BLOCKS
CONV_W = 4
CONV_LEFT = 2
LRU_C = 8.0
D_FF = 2816
N_EXPERTS = 8
TOP_K = 2

N_EVEN = (DEPTH + 1) // 2
N_ODD = DEPTH // 2

kernel_name = "hybrid_sgu_swa_rglru_moe_dit_block"


def rmsnorm(x, g):
    xf = x.astype(jnp.float32)
    y = xf * lax.rsqrt(jnp.mean(xf * xf, axis=-1, keepdims=True) + EPS)
    return (y * g.astype(jnp.float32)).astype(x.dtype)


def adaln_params(act, w, b):
    return jnp.split(act @ w + b, 6, axis=-1)


def axial_rope_tables(rows):
    row = jnp.repeat(jnp.arange(rows, dtype=jnp.float32), GRID_W)
    col = jnp.tile(jnp.arange(GRID_W, dtype=jnp.float32), rows)
    freqs = ROPE_BASE ** (-jnp.arange(ROPE_FREQS, dtype=jnp.float32) / ROPE_FREQS)
    ang = jnp.stack([row[:, None] * freqs, col[:, None] * freqs], axis=1)
    return jnp.cos(ang), jnp.sin(ang)


def apply_axial_rope(t, cos, sin):
    B, S, H, _ = t.shape
    tf = t.astype(jnp.float32).reshape(B, S, H, 2, 2, ROPE_FREQS)
    t1, t2 = tf[..., 0, :], tf[..., 1, :]
    cs, sn = cos[None, :, None], sin[None, :, None]
    out = jnp.stack([t1 * cs - t2 * sn, t2 * cs + t1 * sn], axis=-2)
    return out.reshape(B, S, H, HEAD_DIM).astype(t.dtype)


def chunk_spatial_gating(u, v, w_s, b_s):
    B, N, _ = v.shape
    vg = v.astype(jnp.float32).reshape(B, N // CHUNK, CHUNK, SGU_GROUPS, SGU_CH)
    mu = jnp.mean(vg, axis=-1, keepdims=True)
    var = jnp.mean(jnp.square(vg - mu), axis=-1, keepdims=True)
    vg = (vg - mu) * lax.rsqrt(var + EPS)
    mixed = jnp.einsum('gpq,bnqgc->bnpgc', w_s.astype(jnp.float32), vg) \
        + b_s.T.astype(jnp.float32)[None, None, :, :, None]
    return (u.astype(jnp.float32) * mixed.reshape(B, N, SGU_WIDTH)).astype(u.dtype)


def window_attention(q, k, v, k_ctx, v_ctx, sink):
    B, S = q.shape[:2]
    nb = S // ATTN_BLOCK
    qb = q.reshape(B, nb, ATTN_BLOCK, N_KV_HEADS, Q_PER_KV, HEAD_DIM)
    pad = ((0, 0), (ATTN_BLOCK, ATTN_BLOCK), (0, 0), (0, 0))

    def band(t):
        tb = jnp.pad(t, pad).reshape(B, nb + 2, ATTN_BLOCK, N_KV_HEADS, HEAD_DIM)
        return jnp.concatenate([tb[:, :-2], tb[:, 1:-1], tb[:, 2:]], axis=2)

    kw, vw = band(k), band(v)
    s_loc = jnp.einsum('bnqkgd,bnskd->bnkgqs', qb, kw,
                       preferred_element_type=jnp.float32) * ATTN_SCALE
    q_off = jnp.arange(ATTN_BLOCK)[:, None]
    k_off = jnp.arange(3 * ATTN_BLOCK)[None, :] - ATTN_BLOCK
    k_pos = jnp.arange(nb)[:, None, None] * ATTN_BLOCK + k_off[None]
    valid = (jnp.abs(k_off - q_off) <= WINDOW)[None] & (k_pos >= 0) & (k_pos < S)
    s_loc = jnp.where(valid[None, :, None, None], s_loc, NEG_INF)
    s_ctx = jnp.einsum('bnqkgd,blkd->bnkgql', qb, k_ctx,
                       preferred_element_type=jnp.float32) * ATTN_SCALE
    s_sink = sink.astype(jnp.float32).reshape(1, 1, N_KV_HEADS, Q_PER_KV, 1, 1)
    m = jnp.maximum(jnp.maximum(jnp.max(s_loc, axis=-1, keepdims=True),
                                jnp.max(s_ctx, axis=-1, keepdims=True)), s_sink)
    p_loc = jnp.exp(s_loc - m)
    p_ctx = jnp.exp(s_ctx - m)
    inv = 1.0 / (jnp.sum(p_loc, axis=-1, keepdims=True) + jnp.sum(p_ctx, axis=-1, keepdims=True)
                 + jnp.exp(s_sink - m))
    o = jnp.einsum('bnkgqs,bnskd->bnqkgd', (p_loc * inv).astype(v.dtype), vw) \
        + jnp.einsum('bnkgql,blkd->bnqkgd', (p_ctx * inv).astype(v.dtype), v_ctx)
    return o.reshape(B, S, ATTN_WIDTH)


def context_attention(q, k, v, sink):
    B, L = q.shape[:2]
    qg = q.reshape(B, L, N_KV_HEADS, Q_PER_KV, HEAD_DIM)
    s = jnp.einsum('bqkgd,blkd->bkgql', qg, k, preferred_element_type=jnp.float32) * ATTN_SCALE
    sk = jnp.broadcast_to(sink.astype(jnp.float32).reshape(1, N_KV_HEADS, Q_PER_KV, 1, 1), s.shape[:-1] + (1,))
    p = jax.nn.softmax(jnp.concatenate([s, sk], axis=-1), axis=-1)[..., :-1]
    o = jnp.einsum('bkgql,blkd->bqkgd', p.astype(v.dtype), v)
    return o.reshape(B, L, ATTN_WIDTH)


def centred_depthwise_conv(t, w, b):
    out = lax.conv_general_dilated(t, w[:, None, :], window_strides=(1,),
                                   padding=[(CONV_LEFT, CONV_W - 1 - CONV_LEFT)],
                                   dimension_numbers=('NWC', 'WIO', 'NWC'),
                                   feature_group_count=t.shape[-1])
    return out + b


def block_diag_linear(t, w, b):
    lead = t.shape[:-1]
    tb = t.reshape(*lead, LRU_BLOCKS, LRU_BLOCK)
    return jnp.einsum('...hi,hij->...hj', tb, w).reshape(*lead, D_RNN) + b


def rglru_coefficients(t, w_a, b_a, w_x, b_x, lam):
    tf = t.astype(jnp.float32)
    r = jax.nn.sigmoid(block_diag_linear(tf, w_a.astype(jnp.float32), b_a.astype(jnp.float32)))
    i = jax.nn.sigmoid(block_diag_linear(tf, w_x.astype(jnp.float32), b_x.astype(jnp.float32)))
    log_a = -LRU_C * r * jax.nn.softplus(-lam.astype(jnp.float32))
    return jnp.exp(log_a), jnp.sqrt(-jnp.expm1(2.0 * log_a)) * (i * tf)


def _lin_combine(e1, e2):
    a1, b1 = e1
    a2, b2 = e2
    return a1 * a2, a2 * b1 + b2


def linear_recurrence(a, b, h0, reverse):
    edge = -1 if reverse else 0
    b = b.at[:, edge].add(a[:, edge] * h0)
    _, h = lax.associative_scan(_lin_combine, (a, b), reverse=reverse, axis=1)
    return h


def swiglu(t, w1, w3, w2):
    return (jax.nn.silu(t @ w1) * (t @ w3)) @ w2


def moe_swiglu(h, router_w, w1, w3, w2):
    B, N, D = h.shape
    t = h.reshape(B * N, D)
    logits = (t @ router_w).astype(jnp.float32)
    top_v, top_i = lax.top_k(logits, TOP_K)
    gk = jax.nn.softmax(top_v, axis=-1)
    gates = jnp.sum(jax.nn.one_hot(top_i, N_EXPERTS, dtype=jnp.float32) * gk[..., None], axis=1)
    out = jnp.zeros_like(t)
    for e in range(N_EXPERTS):
        out = out + gates[:, e:e + 1].astype(t.dtype) * swiglu(t, w1[e], w3[e], w2[e])
    return out.reshape(B, N, D)


def even_layer(x, xc, c_act, cc_act, cos, sin, ada_w, ada_b, n1, n2, w_in, sgu_w, sgu_b, sink,
               w_out, w1, w3, w2, need_ctx_out):
    B, S, _ = x.shape
    L = xc.shape[1]
    sh1, sc1, g1, sh2, sc2, g2 = [m[:, None, :] for m in adaln_params(c_act, ada_w, ada_b)]
    csh1, csc1, cg1, csh2, csc2, cg2 = adaln_params(cc_act, ada_w, ada_b)
    h = rmsnorm(x, n1) * (1.0 + sc1) + sh1
    hc = rmsnorm(xc, n1) * (1.0 + csc1) + csh1
    u, v, q, k, val = jnp.split(h @ w_in, EVEN_SPLITS, axis=-1)
    uc, vc, qc, kc, valc = jnp.split(hc @ w_in, EVEN_SPLITS, axis=-1)
    kc = kc.reshape(B, L, N_KV_HEADS, HEAD_DIM)
    valc = valc.reshape(B, L, N_KV_HEADS, HEAD_DIM)
    a_out = chunk_spatial_gating(jax.nn.gelu(u), jax.nn.gelu(v), sgu_w, sgu_b)
    q = apply_axial_rope(q.reshape(B, S, N_Q_HEADS, HEAD_DIM), cos, sin)
    k = apply_axial_rope(k.reshape(B, S, N_KV_HEADS, HEAD_DIM), cos, sin)
    b_out = window_attention(q, k, val.reshape(B, S, N_KV_HEADS, HEAD_DIM), kc, valc, sink)
    x = x + g1 * (jnp.concatenate([a_out, b_out], axis=-1) @ w_out)
    x = x + g2 * swiglu(rmsnorm(x, n2) * (1.0 + sc2) + sh2, w1, w3, w2)
    if need_ctx_out:
        ac = chunk_spatial_gating(jax.nn.gelu(uc), jax.nn.gelu(vc), sgu_w, sgu_b)
        bc = context_attention(qc.reshape(B, L, N_Q_HEADS, HEAD_DIM), kc, valc, sink)
        xc = xc + cg1 * (jnp.concatenate([ac, bc], axis=-1) @ w_out)
        xc = xc + cg2 * swiglu(rmsnorm(xc, n2) * (1.0 + csc2) + csh2, w1, w3, w2)
    return x, xc


def odd_layer(x, xc, c_act, cc_act, ada_w, ada_b, n1, n2, w_in, conv_w, conv_b, lru_wa, lru_ba,
              lru_wx, lru_bx, lru_lambda, w_out, router_w, w1, w3, w2, need_ctx_out):
    B = x.shape[0]
    sh1, sc1, g1, sh2, sc2, g2 = [m[:, None, :] for m in adaln_params(c_act, ada_w, ada_b)]
    csh1, csc1, cg1, csh2, csc2, cg2 = adaln_params(cc_act, ada_w, ada_b)
    h = rmsnorm(x, n1) * (1.0 + sc1) + sh1
    hc = rmsnorm(xc, n1) * (1.0 + csc1) + csh1
    gate_l, rec_l = jnp.split(h @ w_in, 2, axis=-1)
    gate_c, rec_c = jnp.split(hc @ w_in, 2, axis=-1)
    rec_l = centred_depthwise_conv(rec_l, conv_w, conv_b)
    rec_c = centred_depthwise_conv(rec_c, conv_w, conv_b)
    lat_dirs, ctx_dirs = [], []
    for d in range(2):
        rev = d == 1
        a_c, b_c = rglru_coefficients(rec_c, lru_wa[d], lru_ba[d], lru_wx[d], lru_bx[d], lru_lambda[d])
        h_ctx = linear_recurrence(a_c, b_c, jnp.zeros((B, D_RNN), jnp.float32), rev)
        h0 = h_ctx[:, 0] if rev else h_ctx[:, -1]
        a_l, b_l = rglru_coefficients(rec_l, lru_wa[d], lru_ba[d], lru_wx[d], lru_bx[d], lru_lambda[d])
        lat_dirs.append(linear_recurrence(a_l, b_l, h0, rev))
        ctx_dirs.append(h_ctx)
    y = jax.nn.gelu(gate_l) * (lat_dirs[0] + lat_dirs[1]).astype(x.dtype)
    x = x + g1 * (y @ w_out)
    x = x + g2 * moe_swiglu(rmsnorm(x, n2) * (1.0 + sc2) + sh2, router_w, w1, w3, w2)
    if need_ctx_out:
        yc = jax.nn.gelu(gate_c) * (ctx_dirs[0] + ctx_dirs[1]).astype(xc.dtype)
        xc = xc + cg1 * (yc @ w_out)
        xc = xc + cg2 * moe_swiglu(rmsnorm(xc, n2) * (1.0 + csc2) + csh2, router_w, w1, w3, w2)
    return x, xc


def setup_inputs(seed: int = 0) -> dict:
    key = jax.random.key(seed)
    keys = iter(jax.random.split(key, 48))
    D = D_MODEL

    def nrm(shape, scale):
        return scale * jax.random.normal(next(keys), shape, jnp.float32)

    u_lam = jax.random.uniform(next(keys), (N_ODD, 2, D_RNN), jnp.float32, minval=0.9, maxval=0.999)
    a0 = u_lam ** (1.0 / LRU_C)
    lru_lambda = jnp.log(a0) - jnp.log1p(-a0)
    return {
        "x": nrm((BATCH, SEQ, D), 1.0),
        "c": nrm((BATCH, D), 1.0),
        "ctx": nrm((BATCH, CTX_LEN, D), 1.0),
        "c_ctx": nrm((D,), 1.0),
        "ada_w_e": nrm((N_EVEN, D, 6 * D), 0.5 * D ** -0.5),
        "ada_b_e": nrm((N_EVEN, 6 * D), 0.02),
        "norm1_e": 1.0 + nrm((N_EVEN, D), 0.05),
        "norm2_e": 1.0 + nrm((N_EVEN, D), 0.05),
        "w_in_e": nrm((N_EVEN, D, IN_EVEN), D ** -0.5),
        "sgu_w": nrm((N_EVEN, SGU_GROUPS, CHUNK, CHUNK), 0.5 * CHUNK ** -0.5),
        "sgu_b": 1.0 + nrm((N_EVEN, SGU_GROUPS, CHUNK), 0.05),
        "attn_sink": nrm((N_EVEN, N_Q_HEADS), 0.5),
        "w_out_e": nrm((N_EVEN, MIX_EVEN, D), MIX_EVEN ** -0.5),
        "ffn_w1": nrm((N_EVEN, D, D_FF), D ** -0.5),
        "ffn_w3": nrm((N_EVEN, D, D_FF), D ** -0.5),
        "ffn_w2": nrm((N_EVEN, D_FF, D), D_FF ** -0.5),
        "ada_w_o": nrm((N_ODD, D, 6 * D), 0.5 * D ** -0.5),
        "ada_b_o": nrm((N_ODD, 6 * D), 0.02),
        "norm1_o": 1.0 + nrm((N_ODD, D), 0.05),
        "norm2_o": 1.0 + nrm((N_ODD, D), 0.05),
        "w_in_o": nrm((N_ODD, D, 2 * D_RNN), D ** -0.5),
        "conv_w": nrm((N_ODD, CONV_W, D_RNN), CONV_W ** -0.5),
        "conv_b": nrm((N_ODD, D_RNN), 0.02),
        "lru_wa": nrm((N_ODD, 2, LRU_BLOCKS, LRU_BLOCK, LRU_BLOCK), LRU_BLOCK ** -0.5),
        "lru_ba": nrm((N_ODD, 2, D_RNN), 0.02),
        "lru_wx": nrm((N_ODD, 2, LRU_BLOCKS, LRU_BLOCK, LRU_BLOCK), LRU_BLOCK ** -0.5),
        "lru_bx": nrm((N_ODD, 2, D_RNN), 0.02),
        "lru_lambda": lru_lambda,
        "w_out_o": nrm((N_ODD, D_RNN, D), D_RNN ** -0.5),
        "router_w": nrm((N_ODD, D, N_EXPERTS), D ** -0.5),
        "moe_w1": nrm((N_ODD, N_EXPERTS, D, D_FF), D ** -0.5),
        "moe_w3": nrm((N_ODD, N_EXPERTS, D, D_FF), D ** -0.5),
        "moe_w2": nrm((N_ODD, N_EXPERTS, D_FF, D), D_FF ** -0.5),
        "final_norm": 1.0 + nrm((D,), 0.05),
    }


def reference(x, c, ctx, c_ctx, ada_w_e, ada_b_e, norm1_e, norm2_e, w_in_e, sgu_w, sgu_b, attn_sink,
              w_out_e, ffn_w1, ffn_w3, ffn_w2, ada_w_o, ada_b_o, norm1_o, norm2_o, w_in_o, conv_w, conv_b,
              lru_wa, lru_ba, lru_wx, lru_bx, lru_lambda, w_out_o, router_w, moe_w1, moe_w3, moe_w2,
              final_norm):
    n_tok = x.shape[1]
    rows = n_tok // GRID_W
    cos, sin = axial_rope_tables(rows)
    c_act = jax.nn.silu(c)
    cc_act = jax.nn.silu(c_ctx)
    xc = ctx
    for layer in range(DEPTH):
        need_ctx_out = layer < DEPTH - 1
        j = layer // 2
        if layer % 2 == 0:
            x, xc = even_layer(x, xc, c_act, cc_act, cos, sin, ada_w_e[j], ada_b_e[j], norm1_e[j], norm2_e[j],
                               w_in_e[j], sgu_w[j], sgu_b[j], attn_sink[j], w_out_e[j],
                               ffn_w1[j], ffn_w3[j], ffn_w2[j], need_ctx_out)
        else:
            x, xc = odd_layer(x, xc, c_act, cc_act, ada_w_o[j], ada_b_o[j], norm1_o[j], norm2_o[j],
                              w_in_o[j], conv_w[j], conv_b[j], lru_wa[j], lru_ba[j], lru_wx[j], lru_bx[j],
                              lru_lambda[j], w_out_o[j], router_w[j], moe_w1[j], moe_w3[j], moe_w2[j],
                              need_ctx_out)
    return rmsnorm(x, final_norm)
```

```cpp
#include <hip/hip_runtime.h>
#include <cstdio>
#include <cstdint>
namespace pg8 {
#define PG8_LAS __attribute__((address_space(3)))
typedef unsigned short bf16_t;
typedef short bf16x8 __attribute__((ext_vector_type(8)));
typedef float f32x4 __attribute__((ext_vector_type(4)));
typedef unsigned u32x4 __attribute__((ext_vector_type(4)));
constexpr int BM = 256, BK = 64, HALF = 128, HTB = HALF * BK * 2  , STAGE_BYTES = 8 * HTB, NXCD = 8, WGM = 8;

__host__ __device__ __forceinline__ int lds_byte(int r, int c) { const int st = (r >> 4) * 2 + (c >> 5), rr = r & 15, cc = c & 31, ob = rr * 64 + cc * 2; return st * 1024 + (ob ^ (((ob >> 9) & 1) << 5)); }
__host__ __device__ __forceinline__ void stage_rc(int b, int& R, int& C) { const int st = b / 1024, sb = b % 1024, swz = sb ^ (((sb >> 9) & 1) << 5); R = (st >> 1) * 16 + swz / 64; C = (st & 1) * 32 + (swz % 64) / 2; }
__host__ __device__ __forceinline__ int perm32(int rho) { const int n = rho >> 4, i = rho & 15; return 8 * (i >> 2) + 4 * n + (i & 3); }

struct Unit { int pm, pn; };
struct Gemm { const bf16_t* A; const bf16_t* Bt; int M, N, K; };

struct StaticOrder {
    int nM, nN, nwg, G, c;
    __host__ __device__ void init(int M, int N, int G_, int c_) { nM = M / BM; nN = N / BM; nwg = nM * nN; G = G_; c = c_; }
    __host__ __device__ bool next(int i, Unit& u) const {
        const long L = (long)i * G + c; if (L >= nwg) return false;
        int wgid = (int)L; { const int q = nwg / NXCD, r = nwg % NXCD, xcd = wgid % NXCD, off = wgid / NXCD; wgid = (xcd < r ? xcd * (q + 1) : r * (q + 1) + (xcd - r) * q) + off; }
        const int nig = WGM * nN, gid = wgid / nig, fm = gid * WGM, gsz = (nM - fm) < WGM ? (nM - fm) : WGM;
        u.pm = fm + ((wgid % nig) % gsz); u.pn = (wgid % nig) / gsz; return true;
    }
    __device__ __forceinline__ void a_ready(const Unit&) const {}
    __device__ __forceinline__ void done(const Unit&) const {}
};

__device__ __forceinline__ unsigned cvt_pk_bf16(float lo, float hi) { unsigned r; asm volatile("v_cvt_pk_bf16_f32 %0, %1, %2" : "=v"(r) : "v"(lo), "v"(hi)); return r; }
typedef float f32x2 __attribute__((ext_vector_type(2)));
template <class Epi, class Sched, bool ALIGN_EPI = false, bool SP2 = false>
__device__ __forceinline__ void gemm_phase(PG8_LAS unsigned char* lds, const Gemm g, const Sched& S, const Epi& E) {
    const int tid = threadIdx.x, wid = __builtin_amdgcn_readfirstlane(tid >> 6), lane = tid & 63, wr = wid >> 2, wc = wid & 3, fr = lane & 15, fq = lane >> 4;
    const int K = g.K, nt = K / BK;
    unsigned voffA[2], voffB[2];
#pragma unroll
    for (int i = 0; i < 2; ++i) { int R, C; stage_rc(tid * 16 + i * 8192, R, C); const int Rb = Epi::PERM ? ((R & ~31) + perm32(R & 31)) : R;
        voffA[i] = (unsigned)(R * K + C) * 2u; voffB[i] = (unsigned)(Rb * K + C) * 2u; }
    const size_t kstep = (size_t)(BK * 2);
    const size_t hstep = (size_t)HALF * K * 2;
    const size_t tstep = 2 * hstep;
    const unsigned ldsw = (unsigned)wid * 1024u;
    const int aoff = lds_byte(wr * 64 + fr, fq * 8), boff = lds_byte(wc * 32 + fr, fq * 8);
#define PG8_SA(b, h) (((b) * 2 + (h)) * HTB)
#define PG8_SB(b, h) ((4 + (b) * 2 + (h)) * HTB)
#define PG8_STAGE(bufoff, gbase, voff) do { _Pragma("unroll") for (int _i = 0; _i < 2; ++_i) \
        __builtin_amdgcn_global_load_lds((const unsigned*)((const char*)(gbase) + (voff)[_i]), (PG8_LAS unsigned*)(lds + (bufoff) + ldsw + _i * 8192), 16, 0, 0); } while (0)
#define PG8_LDA(dst, b, h) do { _Pragma("unroll") for (int m = 0; m < 4; ++m) _Pragma("unroll") for (int k = 0; k < 2; ++k) dst[m][k] = *(const PG8_LAS bf16x8*)(lds + PG8_SA(b, h) + aoff + m * 2048 + k * 1024); } while (0)
#define PG8_LDB(dst, b, h) do { _Pragma("unroll") for (int n = 0; n < 2; ++n) _Pragma("unroll") for (int k = 0; k < 2; ++k) dst[n][k] = *(const PG8_LAS bf16x8*)(lds + PG8_SB(b, h) + boff + n * 2048 + k * 1024); } while (0)
#define PG8_MMA(ai, bj, At, Bt) do { __builtin_amdgcn_s_setprio(1); _Pragma("unroll") for (int m = 0; m < 4; ++m) _Pragma("unroll") for (int n = 0; n < 2; ++n) _Pragma("unroll") for (int k = 0; k < 2; ++k) \
        acc[ai][bj][m][n] = __builtin_amdgcn_mfma_f32_16x16x32_bf16(Bt[n][k], At[m][k], acc[ai][bj][m][n], 0, 0, 0); __builtin_amdgcn_s_setprio(0); } while (0)
#define PG8_WAIT_V(n) asm volatile("s_waitcnt vmcnt(" #n ")" ::: "memory")
#define PG8_WAIT_L(n) asm volatile("s_waitcnt lgkmcnt(" #n ")" ::: "memory")
#define PG8_BAR __builtin_amdgcn_s_barrier()
#define PG8_SCHED __builtin_amdgcn_sched_barrier(0)
    Unit cur, nxt; int ui = 0;
    if (!S.next(0, cur)) return;
    f32x4 acc[2][2][4][2];
#pragma unroll
    for (int a = 0; a < 2; ++a)
#pragma unroll
        for (int b = 0; b < 2; ++b)
#pragma unroll
            for (int m = 0; m < 4; ++m)
#pragma unroll
                for (int n = 0; n < 2; ++n) acc[a][b][m][n] = (f32x4){0.f, 0.f, 0.f, 0.f};
    bf16x8 At[4][2], B0[2][2], B1[2][2];
    const char* cA = (const char*)g.A + (size_t)cur.pm * tstep; const char* cB = (const char*)g.Bt + (size_t)cur.pn * tstep;
    S.a_ready(cur);
    if constexpr (SP2) {
        PG8_STAGE(PG8_SB(0, 0), cB, voffB); PG8_STAGE(PG8_SB(0, 1), cB + hstep, voffB); PG8_STAGE(PG8_SA(0, 0), cA, voffA); PG8_STAGE(PG8_SA(0, 1), cA + hstep, voffA);
        if (wr == 1) PG8_BAR;
        PG8_WAIT_V(2); PG8_BAR;
        PG8_STAGE(PG8_SB(1, 0), cB + kstep, voffB); PG8_STAGE(PG8_SA(1, 0), cA + kstep, voffA); PG8_STAGE(PG8_SB(1, 1), cB + hstep + kstep, voffB);
        PG8_WAIT_V(6); PG8_BAR;
    } else {
        PG8_STAGE(PG8_SB(0, 0), cB, voffB); PG8_STAGE(PG8_SA(0, 0), cA, voffA); PG8_STAGE(PG8_SB(0, 1), cB + hstep, voffB); PG8_STAGE(PG8_SA(0, 1), cA + hstep, voffA);
        if (wr == 1) PG8_BAR;
        PG8_WAIT_V(4); PG8_BAR;
        PG8_STAGE(PG8_SB(1, 0), cB + kstep, voffB); PG8_STAGE(PG8_SA(1, 0), cA + kstep, voffA); PG8_STAGE(PG8_SB(1, 1), cB + hstep + kstep, voffB);
        PG8_WAIT_V(6); PG8_BAR;
    }
    for (;;) {
        const bool has_next = S.next(ui + 1, nxt);
        const char* nA = has_next ? (const char*)g.A + (size_t)nxt.pm * tstep : cA; const char* nB = has_next ? (const char*)g.Bt + (size_t)nxt.pn * tstep : cB;
        for (int t = 0; t < nt; t += 2) {
            const bool last = (t == nt - 2);
            const char* a1 = cA + (size_t)(t + 1) * kstep;
            const char* a2 = last ? nA : cA + (size_t)(t + 2) * kstep; const char* b2 = last ? nB : cB + (size_t)(t + 2) * kstep;
            const char* a3 = a2 + kstep; const char* b3 = b2 + kstep;
            if (last && has_next) S.a_ready(nxt);
            if constexpr (SP2) {
            PG8_LDB(B0, 0, 0); PG8_LDB(B1, 0, 1); PG8_SCHED; PG8_LDA(At, 0, 0); PG8_STAGE(PG8_SA(1, 1), a1 + hstep, voffA);
            PG8_WAIT_V(8); PG8_WAIT_L(0); PG8_BAR; PG8_MMA(0, 0, At, B0); PG8_MMA(0, 1, At, B1); PG8_BAR; PG8_SCHED;
            PG8_LDA(At, 0, 1); PG8_STAGE(PG8_SB(0, 0), b2, voffB); PG8_STAGE(PG8_SB(0, 1), b2 + hstep, voffB); PG8_STAGE(PG8_SA(0, 0), a2, voffA);
            PG8_WAIT_V(8); PG8_WAIT_L(0); PG8_BAR; PG8_MMA(1, 0, At, B0); PG8_MMA(1, 1, At, B1); PG8_BAR; PG8_SCHED;
            PG8_LDB(B0, 1, 0); PG8_LDB(B1, 1, 1); PG8_SCHED; PG8_LDA(At, 1, 0); PG8_STAGE(PG8_SA(0, 1), a2 + hstep, voffA);
            PG8_WAIT_V(8); PG8_WAIT_L(0); PG8_BAR; PG8_MMA(0, 0, At, B0); PG8_MMA(0, 1, At, B1); PG8_BAR; PG8_SCHED;
            PG8_LDA(At, 1, 1); PG8_STAGE(PG8_SB(1, 0), b3, voffB); PG8_STAGE(PG8_SB(1, 1), b3 + hstep, voffB); PG8_STAGE(PG8_SA(1, 0), a3, voffA);
            PG8_WAIT_V(8); PG8_WAIT_L(0); PG8_BAR; PG8_MMA(1, 0, At, B0); PG8_MMA(1, 1, At, B1); PG8_BAR; PG8_SCHED;
            } else {
            PG8_LDB(B0, 0, 0); PG8_SCHED; PG8_LDA(At, 0, 0); PG8_STAGE(PG8_SA(1, 1), a1 + hstep, voffA);
            PG8_WAIT_L(8); PG8_BAR; PG8_WAIT_L(0); PG8_MMA(0, 0, At, B0); PG8_BAR; PG8_SCHED;
            PG8_LDB(B1, 0, 1); PG8_STAGE(PG8_SB(0, 0), b2, voffB);
            PG8_BAR; PG8_WAIT_L(0); PG8_MMA(0, 1, At, B1); PG8_BAR;
            PG8_LDA(At, 0, 1); PG8_STAGE(PG8_SA(0, 0), a2, voffA);
            PG8_BAR; PG8_WAIT_L(0); PG8_MMA(1, 0, At, B0); PG8_BAR; PG8_SCHED;
            PG8_STAGE(PG8_SB(0, 1), b2 + hstep, voffB);
            PG8_WAIT_V(6); PG8_BAR; PG8_MMA(1, 1, At, B1); PG8_BAR;
            PG8_LDB(B0, 1, 0); PG8_SCHED; PG8_LDA(At, 1, 0); PG8_STAGE(PG8_SA(0, 1), a2 + hstep, voffA);
            PG8_WAIT_L(8); PG8_BAR; PG8_WAIT_L(0); PG8_MMA(0, 0, At, B0); PG8_BAR; PG8_SCHED;
            PG8_LDB(B1, 1, 1); PG8_STAGE(PG8_SB(1, 0), b3, voffB);
            PG8_BAR; PG8_WAIT_L(0); PG8_MMA(0, 1, At, B1); PG8_BAR;
            PG8_LDA(At, 1, 1); PG8_STAGE(PG8_SA(1, 0), a3, voffA);
            PG8_BAR; PG8_WAIT_L(0); PG8_MMA(1, 0, At, B0); PG8_BAR; PG8_SCHED;
            PG8_STAGE(PG8_SB(1, 1), b3 + hstep, voffB);
            PG8_WAIT_V(6); PG8_BAR; PG8_MMA(1, 1, At, B1); PG8_BAR;
            }
        }
        if constexpr (ALIGN_EPI) { if (wr == 0) PG8_BAR; }
        if constexpr (!Epi::AFTER_DRAIN) { E(acc, cur, wr, wc, fr, fq); S.done(cur); }
        if (!has_next) break;
#pragma unroll
        for (int a = 0; a < 2; ++a)
#pragma unroll
            for (int b = 0; b < 2; ++b)
#pragma unroll
                for (int m = 0; m < 4; ++m)
#pragma unroll
                    for (int n = 0; n < 2; ++n) acc[a][b][m][n] = (f32x4){0.f, 0.f, 0.f, 0.f};
        cur = nxt; cA = nA; cB = nB; ++ui;
        if constexpr (ALIGN_EPI) { if (wr == 1) PG8_BAR; }
    }
    PG8_WAIT_V(0);
    if constexpr (!ALIGN_EPI) { if (wr == 0) PG8_BAR; }
    PG8_BAR;
    if constexpr (Epi::AFTER_DRAIN) { E.fused(acc, cur, wr, wc, fr, fq, lds, wid, lane); S.done(cur); }
#undef PG8_SA
#undef PG8_SB
#undef PG8_STAGE
#undef PG8_LDA
#undef PG8_LDB
#undef PG8_MMA
#undef PG8_WAIT_V
#undef PG8_WAIT_L
#undef PG8_BAR
#undef PG8_SCHED
}
}

constexpr int DM = 1024, NB = 2, SEQ = 8192, CTXL = 256;
constexpr int MLAT = NB * SEQ, MCTX = NB * CTXL, MTOT = MLAT + MCTX;
constexpr int NIN_E = 1792, NIN_O = 2560, DRNN = 1280, DFF = 2816, NEXP = 8, NFF2 = 2 * DFF;
constexpr int COL_V = 512, COL_Q = 1024, COL_K = 1536, COL_VAL = 1664;
constexpr float EPS = 1e-6f, LOG2E = 1.4426950408889634f, QSCALE = 0.125f * LOG2E;
constexpr int MOE_MAXT = 136;
constexpr int MOE_ROWS = MOE_MAXT * 256;

typedef unsigned short bf16;
typedef unsigned v4u __attribute__((ext_vector_type(4)));
typedef unsigned v2u __attribute__((ext_vector_type(2)));
typedef float f32x4 __attribute__((ext_vector_type(4)));
typedef float f32x2 __attribute__((ext_vector_type(2)));
#define GAS __attribute__((address_space(1)))
#define LAS __attribute__((address_space(3)))
typedef GAS unsigned gu32;
#define RLX_AGENT __ATOMIC_RELAXED, __HIP_MEMORY_SCOPE_AGENT
#define LDS_WAIT() asm volatile("s_waitcnt lgkmcnt(0)" ::: "memory")
#define VM_WAIT() asm volatile("s_waitcnt vmcnt(0)" ::: "memory")

__device__ __forceinline__ float bf2f(unsigned short u) { return __builtin_bit_cast(float, (unsigned)u << 16); }
__device__ __forceinline__ float bflo(unsigned u) { return __builtin_bit_cast(float, u << 16); }
__device__ __forceinline__ float bfhi(unsigned u) { return __builtin_bit_cast(float, u & 0xffff0000u); }
__device__ __forceinline__ unsigned pk2(float lo, float hi) { return pg8::cvt_pk_bf16(lo, hi); }
__device__ __forceinline__ unsigned short f2bf1(float x) { return (unsigned short)(pg8::cvt_pk_bf16(x, 0.f) & 0xffffu); }
__device__ __forceinline__ float fexp2(float x) { return __builtin_amdgcn_exp2f(x); }
__device__ __forceinline__ float frcp(float x) { return __builtin_amdgcn_rcpf(x); }
__device__ __forceinline__ float sigmoid_f(float x) { return frcp(1.f + fexp2(-LOG2E * x)); }
__device__ __forceinline__ float silu_f(float x) { return x * sigmoid_f(x); }
__device__ __forceinline__ float gelu_f(float x) { const float u = x * (1.f + 0.044715f * x * x); return x * frcp(1.f + fexp2((-2.f * 0.7978845608028654f * LOG2E) * u)); }
__device__ __forceinline__ f32x4 gelu4(f32x4 v) { return (f32x4){gelu_f(v[0]), gelu_f(v[1]), gelu_f(v[2]), gelu_f(v[3])}; }
__device__ __forceinline__ int ld_i32_agent(const int* p) { return __hip_atomic_load(p, RLX_AGENT); }
__device__ __forceinline__ float wave_sum(float v) {
#pragma unroll
    for (int o = 1; o < 64; o <<= 1) v += __shfl_xor(v, o);
    return v;
}
__device__ __forceinline__ float wave_max(float v) {
#pragma unroll
    for (int o = 1; o < 64; o <<= 1) v = fmaxf(v, __shfl_xor(v, o));
    return v;
}
__device__ __forceinline__ int mod_of_tile(int pm) { return pm < 32 ? 0 : (pm < 64 ? 1 : 2); }
__device__ __forceinline__ int mod_of_row(int r) { return r < SEQ ? 0 : (r < MLAT ? 1 : 2); }

struct EpiInEven {
    static constexpr bool PERM = true, AFTER_DRAIN = false;
    bf16* G1; const float* rope;
    __device__ __forceinline__ void operator()(const pg8::f32x4 (&acc)[2][2][4][2], const pg8::Unit& u, int wr, int wc, int fr, int fq) const {
        const int pn = u.pn; const bool lat = u.pm < 64;
#pragma unroll
        for (int ai = 0; ai < 2; ++ai)
#pragma unroll
            for (int m = 0; m < 4; ++m) {
                const int row = u.pm * 256 + ai * 128 + wr * 64 + m * 16 + fr;
                bf16* rowp = G1 + (size_t)row * NIN_E + pn * 256 + wc * 32 + 8 * fq;
                const int t = row & (SEQ - 1);
#pragma unroll
                for (int bj = 0; bj < 2; ++bj) {
                    f32x4 v0 = acc[ai][bj][m][0], v1 = acc[ai][bj][m][1];
                    if (pn < 4) { v0 = gelu4(v0); v1 = gelu4(v1); }
                    else if (pn < 6 || bj == 0) {
                        if (lat) {
                            const int pos = (wc & 1) ? (t & 63) : (t >> 6);
                            const f32x4* tp = (const f32x4*)(rope + (pos * 16 + 4 * fq) * 2);
                            const f32x4 c0 = tp[0], c1 = tp[1];
                            f32x4 w0, w1;
                            w0[0] = v0[0] * c0[0] - v0[1] * c0[1]; w0[1] = v0[1] * c0[0] + v0[0] * c0[1];
                            w0[2] = v0[2] * c0[2] - v0[3] * c0[3]; w0[3] = v0[3] * c0[2] + v0[2] * c0[3];
                            w1[0] = v1[0] * c1[0] - v1[1] * c1[1]; w1[1] = v1[1] * c1[0] + v1[0] * c1[1];
                            w1[2] = v1[2] * c1[2] - v1[3] * c1[3]; w1[3] = v1[3] * c1[2] + v1[2] * c1[3];
                            v0 = w0; v1 = w1;
                        }
                        if (pn < 6) { v0 = v0 * QSCALE; v1 = v1 * QSCALE; }
                    }
                    v4u w; w.x = pk2(v0[0], v0[1]); w.y = pk2(v0[2], v0[3]); w.z = pk2(v1[0], v1[1]); w.w = pk2(v1[2], v1[3]);
                    *(v4u*)(rowp + bj * 128) = w;
                }
            }
    }
};
struct EpiResid {
    static constexpr bool PERM = true, AFTER_DRAIN = false;
    const float* rin_lat; const float* rin_ctx; float* out_lat; float* out_ctx; const float* gate;
    __device__ __forceinline__ void operator()(const pg8::f32x4 (&acc)[2][2][4][2], const pg8::Unit& u, int wr, int wc, int fr, int fq) const {
        const bool lat = u.pm < 64; const float* g = gate + mod_of_tile(u.pm) * 6144;
        const float* rb = lat ? rin_lat : rin_ctx - (size_t)MLAT * DM; float* ob = lat ? out_lat : out_ctx - (size_t)MLAT * DM;
        const int col0 = u.pn * 256 + wc * 32 + 8 * fq;
        f32x4 gv[2][2];
#pragma unroll
        for (int bj = 0; bj < 2; ++bj)
#pragma unroll
            for (int n = 0; n < 2; ++n) gv[bj][n] = *(const f32x4*)(g + col0 + bj * 128 + 4 * n);
#pragma unroll
        for (int ai = 0; ai < 2; ++ai)
#pragma unroll
            for (int m = 0; m < 4; ++m) {
                const size_t p = (size_t)(u.pm * 256 + ai * 128 + wr * 64 + m * 16 + fr) * DM + col0;
#pragma unroll
                for (int bj = 0; bj < 2; ++bj) {
                    const f32x4 r0 = *(const f32x4*)(rb + p + bj * 128), r1 = *(const f32x4*)(rb + p + bj * 128 + 4);
                    *(f32x4*)(ob + p + bj * 128) = r0 + gv[bj][0] * acc[ai][bj][m][0];
                    *(f32x4*)(ob + p + bj * 128 + 4) = r1 + gv[bj][1] * acc[ai][bj][m][1];
                }
            }
    }
};
struct EpiSwiGLU {
    static constexpr bool PERM = true, AFTER_DRAIN = false;
    bf16* H; int nN;
    __device__ __forceinline__ void operator()(const pg8::f32x4 (&acc)[2][2][4][2], const pg8::Unit& u, int wr, int wc, int fr, int fq) const {
        const int pnl = u.pn % nN, col0 = pnl * 128 + wc * 32 + 8 * fq;
#pragma unroll
        for (int ai = 0; ai < 2; ++ai)
#pragma unroll
            for (int m = 0; m < 4; ++m) {
                const size_t row = (size_t)(u.pm * 256 + ai * 128 + wr * 64 + m * 16 + fr);
                const f32x4 a0 = acc[ai][0][m][0], a1 = acc[ai][0][m][1], b0 = acc[ai][1][m][0], b1 = acc[ai][1][m][1];
                v4u w;
                w.x = pk2(silu_f(a0[0]) * b0[0], silu_f(a0[1]) * b0[1]); w.y = pk2(silu_f(a0[2]) * b0[2], silu_f(a0[3]) * b0[3]);
                w.z = pk2(silu_f(a1[0]) * b1[0], silu_f(a1[1]) * b1[1]); w.w = pk2(silu_f(a1[2]) * b1[2], silu_f(a1[3]) * b1[3]);
                *(v4u*)(H + row * DFF + col0) = w;
            }
    }
};
struct EpiStore {
    static constexpr bool PERM = true, AFTER_DRAIN = false;
    bf16* O; int ldc; int nN; int ngelu;
    __device__ __forceinline__ void operator()(const pg8::f32x4 (&acc)[2][2][4][2], const pg8::Unit& u, int wr, int wc, int fr, int fq) const {
        const int pnl = u.pn % nN, col0 = pnl * 256 + wc * 32 + 8 * fq; const bool g = pnl < ngelu;
#pragma unroll
        for (int ai = 0; ai < 2; ++ai)
#pragma unroll
            for (int m = 0; m < 4; ++m) {
                bf16* rowp = O + (size_t)(u.pm * 256 + ai * 128 + wr * 64 + m * 16 + fr) * ldc + col0;
#pragma unroll
                for (int bj = 0; bj < 2; ++bj) {
                    f32x4 v0 = acc[ai][bj][m][0], v1 = acc[ai][bj][m][1];
                    if (g) { v0 = gelu4(v0); v1 = gelu4(v1); }
                    v4u w; w.x = pk2(v0[0], v0[1]); w.y = pk2(v0[2], v0[3]); w.z = pk2(v1[0], v1[1]); w.w = pk2(v1[2], v1[3]);
                    *(v4u*)(rowp + bj * 128) = w;
                }
            }
    }
};
struct MoeOrder {
    const int* tile_e; int ntiles, nN, G, c;
    __device__ __forceinline__ bool next(int i, pg8::Unit& u) const {
        const long L = (long)i * G + c; if (L >= (long)ntiles * nN) return false;
        const int pm = (int)(L / nN), pn = (int)(L % nN);
        u.pm = pm; u.pn = __builtin_amdgcn_readfirstlane(ld_i32_agent(tile_e + pm)) * nN + pn; return true;
    }
    __device__ __forceinline__ void a_ready(const pg8::Unit&) const {}
    __device__ __forceinline__ void done(const pg8::Unit&) const {}
};
#define XB_TMO      128
#define XB_XCNT(j)  (256  + 64 * (j))
#define XB_XSUB(j)  (1280 + 64 * (j))
#define XB_XGEN(j)  (2304 + 64 * (j))
#define XB_TOP      3328
#define XB_TOPGEN   3392
#define XCD_BAR_WORDS 3456
#define XB_SPIN_CAP (1u << 18)

__device__ __forceinline__ unsigned xb_ld(unsigned* p)              { return __hip_atomic_load(p, __ATOMIC_RELAXED, __HIP_MEMORY_SCOPE_AGENT); }
__device__ __forceinline__ unsigned xb_add(unsigned* p, unsigned v) { return __hip_atomic_fetch_add(p, v, __ATOMIC_RELAXED, __HIP_MEMORY_SCOPE_AGENT); }
__device__ __forceinline__ unsigned xb_xcc_id() { return (unsigned)__builtin_amdgcn_s_getreg((3 << 11) | 20) & 0xFu; }
#define XB_SPIN(cond, bar) do { unsigned _sp = 0; while (cond) { __builtin_amdgcn_s_sleep(1); \
    if ((++_sp & 255u) == 0u) { if (xb_ld(&(bar)[XB_TMO])) break; if (_sp > XB_SPIN_CAP) { atomicAdd(&(bar)[XB_TMO], 1u); break; } } } } while (0)

struct XcdBarrier {
    unsigned* bar; unsigned x;
    volatile LAS unsigned* st;
};

__device__ __forceinline__ XcdBarrier xcd_barrier_post(unsigned* bar, volatile LAS unsigned* st) {
    XcdBarrier b; b.bar = bar; b.x = xb_xcc_id(); b.st = st;
    if (threadIdx.x == 0) (void)xb_add(&bar[XB_XCNT(b.x)], 1u);
    return b;
}
__device__ __forceinline__ void xcd_barrier_complete(unsigned* bar, unsigned x, unsigned& nloc, unsigned& nx) {
    const unsigned G = gridDim.x * gridDim.y * gridDim.z;
    unsigned sum, cnt, mine, sp = 0u;
    for (;;) {
        sum = 0u; cnt = 0u; mine = 0u;
#pragma unroll
        for (unsigned j = 0; j < 16; ++j) { const unsigned c = xb_ld(&bar[XB_XCNT(j)]); sum += c; cnt += (c > 0u) ? 1u : 0u; mine = (j == x) ? c : mine; }
        if (sum == G) break;
        __builtin_amdgcn_s_sleep(1);
        if ((++sp & 255u) == 0u) { if (xb_ld(&bar[XB_TMO])) break; if (sp > XB_SPIN_CAP) { atomicAdd(&bar[XB_TMO], 1u); break; } }
    }
    nloc = mine > 0u ? mine : 1u; nx = cnt > 0u ? cnt : 1u;
}

__device__ __forceinline__ void xcd_barrier(const XcdBarrier& b) {
    asm volatile("s_waitcnt vmcnt(0)" ::: "memory");
    __syncthreads();
    if (threadIdx.x == 0) {
        unsigned* bar = b.bar;
        __builtin_amdgcn_s_waitcnt(0);
        unsigned nloc = b.st[0], nx = b.st[1];
        if (nloc == 0u) { xcd_barrier_complete(bar, b.x, nloc, nx); b.st[0] = nloc; b.st[1] = nx; }
        const unsigned old = xb_add(&bar[XB_XSUB(b.x)], 1u);
        const unsigned gen = old / nloc;
        if (old + 1u == (gen + 1u) * nloc) {
            __builtin_amdgcn_fence(__ATOMIC_RELEASE, "agent");
            asm volatile("s_waitcnt vmcnt(0)" ::: "memory");
            const unsigned og = xb_add(&bar[XB_TOP], 1u);
            const unsigned tg = og / nx;
            if (og + 1u == (tg + 1u) * nx) xb_add(&bar[XB_TOPGEN], 1u);
            else XB_SPIN(xb_ld(&bar[XB_TOPGEN]) == tg, bar);
            __builtin_amdgcn_fence(__ATOMIC_ACQUIRE, "agent");
            xb_add(&bar[XB_XGEN(b.x)], 1u);
            asm volatile("s_waitcnt vmcnt(0)" ::: "memory");
        } else {
            XB_SPIN(xb_ld(&bar[XB_XGEN(b.x)]) == gen, bar);
            __builtin_amdgcn_fence(__ATOMIC_ACQUIRE, "agent");
            asm volatile("s_waitcnt vmcnt(0)" ::: "memory");
        }
    }
    __syncthreads();
}

constexpr size_t MiB = 1u << 20;
constexpr size_t WS_CTL = 0, CTL_ZERO_BYTES = 1 * MiB;
constexpr size_t WS_MOD = 1 * MiB;
constexpr size_t WS_ROPE = 1 * MiB + 256 * 1024;
constexpr size_t WS_TOKE = 1 * MiB + 512 * 1024;
constexpr size_t WS_TOKG = WS_TOKE + 128 * 1024;
constexpr size_t WS_TOKR = WS_TOKG + 128 * 1024;
constexpr size_t WS_META = 2 * MiB;
constexpr size_t WS_WINE = 4 * MiB, WS_WOUTE = 8 * MiB, WS_FFN13 = 10 * MiB, WS_FFN2 = 21 * MiB, WS_WINO = 27 * MiB, WS_WOUTO = 32 * MiB;
constexpr size_t WS_MOE13 = 36 * MiB, WS_MOE2 = 124 * MiB;
constexpr size_t WS_H = 168 * MiB;
constexpr size_t WS_G1 = 201 * MiB;
constexpr size_t WS_MIX = 259 * MiB;
constexpr size_t WS_XC = 292 * MiB;
constexpr size_t WS_FH = 294 * MiB;
constexpr size_t WS_G2 = 201 * MiB;
constexpr size_t WS_Y1 = 284 * MiB;
constexpr size_t WS_LAF = 36 * MiB, WS_BBF = 78 * MiB, WS_LAB = 120 * MiB, WS_BBB = 324 * MiB, WS_HF = 366 * MiB;
constexpr size_t WS_HP = 168 * MiB;
constexpr size_t WS_MH = 236 * MiB;
constexpr size_t WS_YD = 36 * MiB;
constexpr size_t WS_NEED = 424 * MiB;
constexpr int CW_CNT = 64;
constexpr int CW_BAR = 4096;

constexpr int RING_BYTES = 131072, LDSCTL_OFF = RING_BYTES, MISC_OFF = LDSCTL_OFF + 320, LDS_BYTES = 147456;
constexpr int NWAVES = 8, NTHR = 512;

enum Phase { PH_PRO = 0, PH_NORM1E, PH_GIN_E, PH_MIX_E, PH_GOUT_E, PH_NORM2E, PH_FFN_UP, PH_FFN_DN, PH_NORM1O, PH_GIN_O, PH_LRU_G, PH_LRU_S, PH_GOUT_O, PH_ROUTE, PH_CVT_MOE, PH_PERM,
             PH_MOE_UP, PH_MOE_DN, PH_COMB, NPH };
#ifndef MK_ONE_LAUNCH
#define MK_ONE_LAUNCH 0
#endif

struct Args { const float* in[34]; float* out; unsigned char* ws; int ph_lo, ph_hi; };
struct Frame {
    LAS unsigned char* lds; volatile LAS unsigned* MISC; gu32* ctl;
    int tid, lane, wave, vcu, G;
};

struct MapId { __device__ __forceinline__ int operator()(int n) const { return n; } };
struct MapRope {
    __device__ __forceinline__ int operator()(int n) const {
        if (n < COL_Q || n >= COL_VAL) return n;
        const int base = n < COL_K ? COL_Q : COL_K, r = n - base, h = r >> 6, d = r & 63;
        return base + h * 64 + (d & 32) + 2 * (d & 15) + ((d >> 4) & 1);
    }
};
struct MapGLU { int off; __device__ __forceinline__ int operator()(int n) const { return (n >> 7) * 256 + off + (n & 127); } };

template <class RowMap>
__device__ __forceinline__ void tr_item(const float* W, int K, int N, bf16* WT, LAS float* scr, int item, int lane, RowMap rm) {
    const int nblk = N / 32, kb = item / nblk, nb = item % nblk, k0 = 64 * kb, n0 = 32 * nb;
#pragma unroll 8
    for (int i = 0; i < 32; ++i) { const int kk = 2 * i + (lane >> 5); scr[kk * 33 + (lane & 31)] = W[(size_t)(k0 + kk) * N + n0 + (lane & 31)]; }
    LDS_WAIT(); asm volatile("" ::: "memory");
    const int c = lane & 7;
#pragma unroll
    for (int j = 0; j < 4; ++j) { const int n = (lane >> 3) + 8 * j; const LAS float* s = scr + (8 * c) * 33 + n;
        v4u o; o.x = pk2(s[0 * 33], s[1 * 33]); o.y = pk2(s[2 * 33], s[3 * 33]); o.z = pk2(s[4 * 33], s[5 * 33]); o.w = pk2(s[6 * 33], s[7 * 33]);
        *(GAS v4u*)(WT + (size_t)rm(n0 + n) * K + k0 + 8 * c) = o; }
    LDS_WAIT(); asm volatile("" ::: "memory");
}

__device__ __forceinline__ void ph_prologue(const Args& A, Frame& F) {
    unsigned char* ws = A.ws;
    LAS float* sact = (LAS float*)F.lds;
    LAS float* red = sact + 3 * 1024;
    for (int t = F.tid; t < 3 * 1024; t += NTHR) { const int v = t >> 10, k = t & 1023; const float x = v < 2 ? A.in[1][v * 1024 + k] : A.in[3][k]; sact[t] = silu_f(x); }
    __syncthreads();
    float* mod = (float*)(ws + WS_MOD);
    for (int item = blockIdx.x; item < 256; item += F.G) {
        const int L = item >> 7, ch = item & 127; const float* W = (L ? A.in[16] : A.in[4]) + ch * 48; const float* bias = (L ? A.in[17] : A.in[5]);
        if (F.tid < 504) {
            const int c4 = F.tid % 12, ks = F.tid / 12; f32x4 a0 = {0.f, 0.f, 0.f, 0.f}, a1 = a0, a2 = a0;
            for (int k = ks; k < 1024; k += 42) { const f32x4 w = *(const f32x4*)(W + (size_t)k * 6144 + c4 * 4); a0 += sact[k] * w; a1 += sact[1024 + k] * w; a2 += sact[2048 + k] * w; }
            LAS float* r = red + ks * 144 + c4 * 4;
#pragma unroll
            for (int j = 0; j < 4; ++j) { r[j] = a0[j]; r[48 + j] = a1[j]; r[96 + j] = a2[j]; }
        }
        __syncthreads();
        if (F.tid < 144) { const int v = F.tid / 48, cc = F.tid % 48, n = ch * 48 + cc; float s = 0.f; for (int ks = 0; ks < 42; ++ks) s += red[ks * 144 + F.tid]; mod[(L * 3 + v) * 6144 + n] = s + bias[n]; }
        __syncthreads();
    }
    { const int idx = blockIdx.x * NTHR + F.tid; if (idx < 128 * 16) { const int pos = idx >> 4, f = idx & 15; const float freq = fexp2(-(float)f * (13.287712379549449f / 16.f)); const float rev = (float)pos * freq * 0.15915494309189535f;
        float* rp = (float*)(ws + WS_ROPE) + idx * 2; rp[0] = __builtin_amdgcn_cosf(rev); rp[1] = __builtin_amdgcn_sinf(rev); } }
    LAS float* scr = (LAS float*)(F.lds + F.wave * 16384);
    const int gw = F.vcu * NWAVES + F.wave, NGW = F.G * NWAVES;
    constexpr int I_WINE = 16 * 56, I_WOUTE = 16 * 32, I_F1 = 16 * 88, I_F2 = 44 * 32, I_WINO = 16 * 80, I_WOUTO = 20 * 32;
    constexpr int NITEMS = I_WINE + I_WOUTE + 2 * I_F1 + I_F2 + I_WINO + I_WOUTO;
    for (int it = gw; it < NITEMS; it += NGW) {
        int r = it;
        if (r < I_WINE) { tr_item(A.in[8], DM, NIN_E, (bf16*)(ws + WS_WINE), scr, r, F.lane, MapRope{}); continue; } r -= I_WINE;
        if (r < I_WOUTE) { tr_item(A.in[12], DM, DM, (bf16*)(ws + WS_WOUTE), scr, r, F.lane, MapId{}); continue; } r -= I_WOUTE;
        if (r < I_F1) { tr_item(A.in[13], DM, DFF, (bf16*)(ws + WS_FFN13), scr, r, F.lane, MapGLU{0}); continue; } r -= I_F1;
        if (r < I_F1) { tr_item(A.in[14], DM, DFF, (bf16*)(ws + WS_FFN13), scr, r, F.lane, MapGLU{128}); continue; } r -= I_F1;
        if (r < I_F2) { tr_item(A.in[15], DFF, DM, (bf16*)(ws + WS_FFN2), scr, r, F.lane, MapId{}); continue; } r -= I_F2;
        if (r < I_WINO) { tr_item(A.in[20], DM, NIN_O, (bf16*)(ws + WS_WINO), scr, r, F.lane, MapId{}); continue; } r -= I_WINO;
        tr_item(A.in[28], DRNN, DM, (bf16*)(ws + WS_WOUTO), scr, r, F.lane, MapId{});
    }
}
__device__ __forceinline__ void ph_convert_moe(const Args& A, Frame& F) {
    unsigned char* ws = A.ws;
    LAS float* scr = (LAS float*)(F.lds + F.wave * 16384);
    const int gw = F.vcu * NWAVES + F.wave, NGW = F.G * NWAVES;
    constexpr int I_F1 = 16 * 88, I_F2 = 44 * 32, PER_E = 2 * I_F1 + I_F2;
    for (int it = gw; it < NEXP * PER_E; it += NGW) {
        const int e = it / PER_E; int r = it % PER_E;
        bf16* w13 = (bf16*)(ws + WS_MOE13) + (size_t)e * NFF2 * DM; bf16* w2 = (bf16*)(ws + WS_MOE2) + (size_t)e * DM * DFF;
        if (r < I_F1) { tr_item(A.in[30] + (size_t)e * DM * DFF, DM, DFF, w13, scr, r, F.lane, MapGLU{0}); continue; } r -= I_F1;
        if (r < I_F1) { tr_item(A.in[31] + (size_t)e * DM * DFF, DM, DFF, w13, scr, r, F.lane, MapGLU{128}); continue; } r -= I_F1;
        tr_item(A.in[32] + (size_t)e * DFF * DM, DFF, DM, w2, scr, r, F.lane, MapId{});
    }
}

__device__ __forceinline__ void norm_mod_regs(const float* xrow, const float* gain, const float* scale, const float* shift, int lane, f32x4 (&v)[4]) {
    const f32x4* xr = (const f32x4*)xrow + lane; float ss = 0.f;
#pragma unroll
    for (int j = 0; j < 4; ++j) { v[j] = xr[64 * j]; ss += (v[j][0] * v[j][0] + v[j][1] * v[j][1]) + (v[j][2] * v[j][2] + v[j][3] * v[j][3]); }
    const float rstd = 1.f / sqrtf(wave_sum(ss) * (1.f / DM) + EPS);
#pragma unroll
    for (int j = 0; j < 4; ++j) { const f32x4 g = ((const f32x4*)gain)[lane + 64 * j], sc = ((const f32x4*)scale)[lane + 64 * j], sh = ((const f32x4*)shift)[lane + 64 * j];
        v[j] = v[j] * rstd * g * (1.f + sc) + sh; }
}
__device__ __forceinline__ void ph_norm(Frame& F, const float* xl, const float* xc, const float* gain, const float* modL, int p_shift, int p_scale, bf16* H, int nrows) {
    const int gw = F.vcu * NWAVES + F.wave, NGW = F.G * NWAVES;
    for (int r = gw; r < nrows; r += NGW) {
        const float* md = modL + mod_of_row(r) * 6144; const float* xrow = r < MLAT ? xl + (size_t)r * DM : xc + (size_t)(r - MLAT) * DM;
        f32x4 v[4]; norm_mod_regs(xrow, gain, md + p_scale * 1024, md + p_shift * 1024, F.lane, v);
        GAS v2u* o = (GAS v2u*)(H + (size_t)r * DM) + F.lane;
#pragma unroll
        for (int j = 0; j < 4; ++j) { v2u w; w.x = pk2(v[j][0], v[j][1]); w.y = pk2(v[j][2], v[j][3]); o[64 * j] = w; }
    }
}

__device__ __forceinline__ void ph_attn_simple(const Args& A, Frame& F) {
    const bf16* G1 = (const bf16*)(A.ws + WS_G1); bf16* MIX = (bf16*)(A.ws + WS_MIX); const float* sink = A.in[11];
    LAS float* wq = (LAS float*)(F.lds + F.wave * 4096); LAS float* wp = wq + 64;
    const int gw = F.vcu * NWAVES + F.wave, NGW = F.G * NWAVES, lane = F.lane;
    for (int it = gw; it < MTOT * 8; it += NGW) {
        const int row = it >> 3, h = it & 7, kvh = h >> 2; const bool lat = row < MLAT;
        const int b = lat ? (row >> 13) : ((row - MLAT) >> 8), t = row & (SEQ - 1);
        wq[lane] = bf2f(G1[(size_t)row * NIN_E + COL_Q + h * 64 + lane]);
        LDS_WAIT();
        const float sk = sink[h] * LOG2E;
        float sc[9]; float mx = sk;
#pragma unroll
        for (int i = 0; i < 9; ++i) {
            const int s = lane + 64 * i; bool valid; int krow;
            if (lat) { if (s < 257) { const int j = t - 128 + s; valid = (j >= 0) && (j < SEQ); krow = b * SEQ + j; } else { valid = s < 513; krow = MLAT + b * CTXL + (s - 257); } }
            else { valid = s < CTXL; krow = MLAT + b * CTXL + s; }
            float d = -INFINITY;
            if (valid) { const v4u* kp = (const v4u*)(G1 + (size_t)krow * NIN_E + COL_K + kvh * 64); d = 0.f;
#pragma unroll
                for (int c = 0; c < 8; ++c) { const v4u kk = kp[c]; const LAS float* q = wq + 8 * c;
                    d += bflo(kk.x) * q[0] + bfhi(kk.x) * q[1] + bflo(kk.y) * q[2] + bfhi(kk.y) * q[3] + bflo(kk.z) * q[4] + bfhi(kk.z) * q[5] + bflo(kk.w) * q[6] + bfhi(kk.w) * q[7]; } }
            sc[i] = d; mx = fmaxf(mx, d);
        }
        mx = wave_max(mx);
        float sum = 0.f;
#pragma unroll
        for (int i = 0; i < 9; ++i) { const float p = fexp2(sc[i] - mx); wp[lane + 64 * i] = p; sum += p; }
        sum = wave_sum(sum) + fexp2(sk - mx);
        LDS_WAIT();
        float o = 0.f;
        const bf16* vb = G1 + COL_VAL + kvh * 64 + lane;
        if (lat) {
            const int s_lo = (128 - t) > 0 ? (128 - t) : 0, s_hi = (SEQ - 1 - t + 128) < 256 ? (SEQ - 1 - t + 128) : 256;
#pragma unroll 8
            for (int s = s_lo; s <= s_hi; ++s) o += wp[s] * bf2f(vb[(size_t)(b * SEQ + t - 128 + s) * NIN_E]);
#pragma unroll 8
            for (int s = 0; s < CTXL; ++s) o += wp[257 + s] * bf2f(vb[(size_t)(MLAT + b * CTXL + s) * NIN_E]);
        } else {
#pragma unroll 8
            for (int s = 0; s < CTXL; ++s) o += wp[s] * bf2f(vb[(size_t)(MLAT + b * CTXL + s) * NIN_E]);
        }
        MIX[(size_t)row * DM + 512 + h * 64 + lane] = f2bf1(o / sum);
        LDS_WAIT();
    }
}
__device__ __forceinline__ void ph_sgu_simple(const Args& A, Frame& F) {
    const bf16* G1 = (const bf16*)(A.ws + WS_G1); bf16* MIX = (bf16*)(A.ws + WS_MIX); const float* sgw = A.in[9]; const float* sgb = A.in[10];
    LAS float* vn = (LAS float*)F.lds;
    for (int item = blockIdx.x; item < (MTOT / 128) * 4; item += F.G) {
        const int chunk = item >> 2, g = item & 3, row0 = chunk * 128;
        for (int i = 0; i < 16; ++i) { const int q = F.wave * 16 + i;
            const unsigned u = ((const unsigned*)(G1 + (size_t)(row0 + q) * NIN_E + COL_V + g * 128))[F.lane];
            const float x0 = bflo(u), x1 = bfhi(u); const float mean = wave_sum(x0 + x1) * (1.f / 128.f); const float d0 = x0 - mean, d1 = x1 - mean;
            const float var = wave_sum(d0 * d0 + d1 * d1) * (1.f / 128.f); const float rs = 1.f / sqrtf(var + EPS);
            vn[q * 128 + 2 * F.lane] = d0 * rs; vn[q * 128 + 2 * F.lane + 1] = d1 * rs; }
        __syncthreads();
        const int c = F.tid & 127, pb = F.tid >> 7;
        for (int i = 0; i < 32; ++i) { const int p = pb + 4 * i; const float* wrow = sgw + (size_t)(g * 128 + p) * 128; float acc = 0.f;
#pragma unroll 8
            for (int q = 0; q < 128; ++q) acc += wrow[q] * vn[q * 128 + c];
            const float uu = bf2f(G1[(size_t)(row0 + p) * NIN_E + g * 128 + c]);
            MIX[(size_t)(row0 + p) * DM + g * 128 + c] = f2bf1(uu * (acc + sgb[g * 128 + p])); }
        __syncthreads();
    }
}
__device__ __forceinline__ void ph_lru_gates_simple(const Args& A, Frame& F) {
    const bf16* G2 = (const bf16*)(A.ws + WS_G2); const float* cw = A.in[21]; const float* cb = A.in[22];
    const float *wa = A.in[23], *ba = A.in[24], *wx = A.in[25], *bx = A.in[26], *lam = A.in[27];
    LAS float* rc = (LAS float*)F.lds;
    for (int rg = blockIdx.x; rg < MTOT / 8; rg += F.G) {
        const int r0 = rg * 8;
        for (int e = F.tid; e < 8 * DRNN; e += NTHR) { const int rr = e / DRNN, c = e % DRNN, row = r0 + rr;
            const int pos = row < MLAT ? (row & (SEQ - 1)) : ((row - MLAT) & (CTXL - 1)), len = row < MLAT ? SEQ : CTXL;
            float acc = cb[c];
#pragma unroll
            for (int j = 0; j < 4; ++j) { const int pp = pos + j - 2; if (pp >= 0 && pp < len) acc += cw[j * DRNN + c] * bf2f(G2[(size_t)(row + j - 2) * NIN_O + DRNN + c]); }
            rc[rr * DRNN + c] = acc; }
        __syncthreads();
        for (int q5 = 0; q5 < 5; ++q5) { const int pc = F.tid + NTHR * q5, d = pc / DRNN, c = pc % DRNN, blk = c >> 7, j = c & 127;
            const float* wap = wa + (size_t)((d * 10 + blk) * 128) * 128 + j; const float* wxp = wx + (size_t)((d * 10 + blk) * 128) * 128 + j;
            float ar[8], ai[8];
#pragma unroll
            for (int r = 0; r < 8; ++r) { ar[r] = 0.f; ai[r] = 0.f; }
            for (int i = 0; i < 128; ++i) { const float wav = wap[i * 128], wxv = wxp[i * 128];
#pragma unroll
                for (int r = 0; r < 8; ++r) { const float x = rc[r * DRNN + blk * 128 + i]; ar[r] += x * wav; ai[r] += x * wxv; } }
            const float bav = ba[d * DRNN + c], bxv = bx[d * DRNN + c], sp = log1pf(expf(-lam[d * DRNN + c]));
            bf16* LA = (bf16*)(A.ws + (d ? WS_LAB : WS_LAF)); bf16* BB = (bf16*)(A.ws + (d ? WS_BBB : WS_BBF));
#pragma unroll
            for (int r = 0; r < 8; ++r) { const float rgt = sigmoid_f(ar[r] + bav), igt = sigmoid_f(ai[r] + bxv), la = -8.f * rgt * sp;
                const float bbv = sqrtf(-expm1f(2.f * la)) * (igt * rc[r * DRNN + c]);
                LA[(size_t)(r0 + r) * DRNN + c] = f2bf1(la); BB[(size_t)(r0 + r) * DRNN + c] = f2bf1(bbv); } }
        __syncthreads();
    }
}
__device__ __forceinline__ void ph_lru_scan_simple(const Args& A, Frame& F) {
    const int gt = blockIdx.x * NTHR + F.tid; if (gt >= NB * DRNN) return;
    const int b = gt / DRNN, c = gt % DRNN;
    const bf16* LAf = (const bf16*)(A.ws + WS_LAF) + c; const bf16* BBf = (const bf16*)(A.ws + WS_BBF) + c; const bf16* LAb = (const bf16*)(A.ws + WS_LAB) + c; const bf16* BBb = (const bf16*)(A.ws + WS_BBB) + c;
    bf16* HF = (bf16*)(A.ws + WS_HF) + c; const bf16* G2 = (const bf16*)(A.ws + WS_G2) + c; bf16* Y1 = (bf16*)(A.ws + WS_Y1) + c;
    float h = 0.f;
#pragma unroll 8
    for (int l = 0; l < CTXL; ++l) { const size_t row = MLAT + b * CTXL + l; h = expf(bf2f(LAf[row * DRNN])) * h + bf2f(BBf[row * DRNN]); }
#pragma unroll 8
    for (int t = 0; t < SEQ; ++t) { const size_t row = (size_t)b * SEQ + t; h = expf(bf2f(LAf[row * DRNN])) * h + bf2f(BBf[row * DRNN]); HF[row * DRNN] = f2bf1(h); }
    h = 0.f;
#pragma unroll 8
    for (int l = CTXL - 1; l >= 0; --l) { const size_t row = MLAT + b * CTXL + l; h = expf(bf2f(LAb[row * DRNN])) * h + bf2f(BBb[row * DRNN]); }
#pragma unroll 8
    for (int t = SEQ - 1; t >= 0; --t) { const size_t row = (size_t)b * SEQ + t; h = expf(bf2f(LAb[row * DRNN])) * h + bf2f(BBb[row * DRNN]);
        Y1[row * DRNN] = f2bf1(bf2f(G2[row * NIN_O]) * (bf2f(HF[row * DRNN]) + h)); }
}

__device__ __forceinline__ void route_row(const Args& A, Frame& F, const LAS float* rw, int t, f32x4 (&v)[4], float (&lg)[8]) {
    const float* md = (const float*)(A.ws + WS_MOD) + (3 + (t >> 13)) * 6144;
    norm_mod_regs(A.out + (size_t)t * DM, A.in[19], md + 4 * 1024, md + 3 * 1024, F.lane, v);
#pragma unroll
    for (int e = 0; e < 8; ++e) lg[e] = 0.f;
#pragma unroll
    for (int j = 0; j < 4; ++j)
#pragma unroll
        for (int i = 0; i < 4; ++i) { const int k = 4 * (F.lane + 64 * j) + i; const f32x4 w0 = *(const LAS f32x4*)(rw + k * 8), w1 = *(const LAS f32x4*)(rw + k * 8 + 4); const float x = v[j][i];
            lg[0] += x * w0[0]; lg[1] += x * w0[1]; lg[2] += x * w0[2]; lg[3] += x * w0[3]; lg[4] += x * w1[0]; lg[5] += x * w1[1]; lg[6] += x * w1[2]; lg[7] += x * w1[3]; }
#pragma unroll
    for (int e = 0; e < 8; ++e) lg[e] = wave_sum(lg[e]);
}
__device__ __forceinline__ void ph_route(const Args& A, Frame& F) {
    LAS float* rw = (LAS float*)F.lds;
    for (int i = F.tid; i < DM * 8; i += NTHR) rw[i] = A.in[29][i];
    __syncthreads();
    int* toke = (int*)(A.ws + WS_TOKE); float* tokg = (float*)(A.ws + WS_TOKG); int* tokr = (int*)(A.ws + WS_TOKR);
    const int gw = F.vcu * NWAVES + F.wave, NGW = F.G * NWAVES;
    for (int t = gw; t < MLAT; t += NGW) {
        f32x4 v[4]; float lg[8]; route_row(A, F, rw, t, v, lg);
        int i0 = 0; float l0 = lg[0];
#pragma unroll
        for (int e = 1; e < 8; ++e) if (lg[e] > l0) { l0 = lg[e]; i0 = e; }
        int i1 = -1; float l1 = -INFINITY;
#pragma unroll
        for (int e = 0; e < 8; ++e) if (e != i0 && lg[e] > l1) { l1 = lg[e]; i1 = e; }
        const float g0 = 1.f / (1.f + expf(l1 - l0)), g1 = 1.f - g0;
        if (F.lane == 0) {
            const int r0 = (int)__hip_atomic_fetch_add((unsigned*)(F.ctl + CW_CNT + 16 * i0), 1u, RLX_AGENT), r1 = (int)__hip_atomic_fetch_add((unsigned*)(F.ctl + CW_CNT + 16 * i1), 1u, RLX_AGENT);
            toke[t] = i0; toke[MLAT + t] = i1; tokg[t] = g0; tokg[MLAT + t] = g1; tokr[t] = r0; tokr[MLAT + t] = r1;
        }
    }
}
__device__ __forceinline__ void ph_permute(const Args& A, Frame& F) {
    int* toke = (int*)(A.ws + WS_TOKE); int* tokr = (int*)(A.ws + WS_TOKR); int* meta = (int*)(A.ws + WS_META); bf16* HP = (bf16*)(A.ws + WS_HP);
    int off[8]; int tot = 0;
#pragma unroll
    for (int e = 0; e < 8; ++e) { const int c = (int)__hip_atomic_load((unsigned*)(F.ctl + CW_CNT + 16 * e), RLX_AGENT); off[e] = tot; tot += ((c + 255) >> 8) << 8; }
    if (blockIdx.x == 0 && F.tid < MOE_MAXT + 8) { int e = 0;
#pragma unroll
        for (int k = 1; k < 8; ++k) if (F.tid * 256 >= off[k]) e = k;
        meta[F.tid] = e; if (F.tid == 0) meta[256] = tot >> 8; }
    const int gw = F.vcu * NWAVES + F.wave, NGW = F.G * NWAVES;
    for (int t = gw; t < MLAT; t += NGW) {
        const float* md = (const float*)(A.ws + WS_MOD) + (3 + (t >> 13)) * 6144;
        f32x4 v[4]; norm_mod_regs(A.out + (size_t)t * DM, A.in[19], md + 4 * 1024, md + 3 * 1024, F.lane, v);
        const int e0 = toke[t], e1 = toke[MLAT + t]; int s0 = tokr[t], s1 = tokr[MLAT + t];
        int o0 = 0, o1 = 0;
#pragma unroll
        for (int k = 0; k < 8; ++k) { if (k == e0) o0 = off[k]; if (k == e1) o1 = off[k]; }
        s0 += o0; s1 += o1;
        GAS v2u* p0 = (GAS v2u*)(HP + (size_t)s0 * DM) + F.lane; GAS v2u* p1 = (GAS v2u*)(HP + (size_t)s1 * DM) + F.lane;
#pragma unroll
        for (int j = 0; j < 4; ++j) { v2u w; w.x = pk2(v[j][0], v[j][1]); w.y = pk2(v[j][2], v[j][3]); p0[64 * j] = w; p1[64 * j] = w; }
        if (F.lane == 0) { tokr[t] = s0; tokr[MLAT + t] = s1; }
    }
}
__device__ __forceinline__ void ph_combine(const Args& A, Frame& F) {
    const float* tokg = (const float*)(A.ws + WS_TOKG); const int* tokr = (const int*)(A.ws + WS_TOKR); const bf16* YD = (const bf16*)(A.ws + WS_YD); const float* fn = A.in[33];
    const int gw = F.vcu * NWAVES + F.wave, NGW = F.G * NWAVES;
    for (int t = gw; t < MLAT; t += NGW) {
        const float* g2 = (const float*)(A.ws + WS_MOD) + (3 + (t >> 13)) * 6144 + 5 * 1024;
        const int s0 = tokr[t], s1 = tokr[MLAT + t]; const float g0 = tokg[t], g1 = tokg[MLAT + t];
        f32x4* xr = (f32x4*)(A.out + (size_t)t * DM) + F.lane; const v2u* y0 = (const v2u*)(YD + (size_t)s0 * DM) + F.lane; const v2u* y1 = (const v2u*)(YD + (size_t)s1 * DM) + F.lane;
        f32x4 z[4]; float ss = 0.f;
#pragma unroll
        for (int j = 0; j < 4; ++j) { const f32x4 x = xr[64 * j], g = ((const f32x4*)g2)[F.lane + 64 * j]; const v2u a = y0[64 * j], b = y1[64 * j];
            f32x4 m; m[0] = g0 * bflo(a.x) + g1 * bflo(b.x); m[1] = g0 * bfhi(a.x) + g1 * bfhi(b.x); m[2] = g0 * bflo(a.y) + g1 * bflo(b.y); m[3] = g0 * bfhi(a.y) + g1 * bfhi(b.y);
            z[j] = x + g * m; ss += (z[j][0] * z[j][0] + z[j][1] * z[j][1]) + (z[j][2] * z[j][2] + z[j][3] * z[j][3]); }
        const float rstd = 1.f / sqrtf(wave_sum(ss) * (1.f / DM) + EPS);
#pragma unroll
        for (int j = 0; j < 4; ++j) xr[64 * j] = z[j] * rstd * ((const f32x4*)fn)[F.lane + 64 * j];
    }
}

__global__ void __launch_bounds__(NTHR, 2) fwd_kernel(Args A) {
    extern __shared__ __attribute__((aligned(16))) unsigned char lds[];
    Frame F;
    F.lds = (LAS unsigned char*)lds; F.MISC = (volatile LAS unsigned*)(F.lds + MISC_OFF);
    F.tid = threadIdx.x; F.lane = F.tid & 63; F.wave = __builtin_amdgcn_readfirstlane(F.tid >> 6);
    F.G = gridDim.x; { const int bx = blockIdx.x; F.vcu = (F.G % 8 == 0) ? (bx % 8) * (F.G / 8) + bx / 8 : bx; }
    unsigned char* ws = A.ws;
    F.ctl = (gu32*)(ws + WS_CTL);
    for (int u = F.tid; u < (LDS_BYTES - LDSCTL_OFF) / 4; u += NTHR) ((LAS unsigned*)(F.lds + LDSCTL_OFF))[u] = 0u;
    __syncthreads();
    XcdBarrier bar; bar.bar = (unsigned*)(F.ctl + CW_BAR); bar.x = 0; bar.st = nullptr;
    if (MK_ONE_LAUNCH) bar = xcd_barrier_post((unsigned*)(F.ctl + CW_BAR), F.MISC + 8);
    const int lo = A.ph_lo, hi = A.ph_hi;
#define IN(k) (lo <= (k) && (k) < hi)
#define SEAM(k) do { if (IN(k) && IN((k) + 1)) xcd_barrier(bar); } while (0)
    const float* mod = (const float*)(ws + WS_MOD);
    bf16* Hb = (bf16*)(ws + WS_H); float* XC = (float*)(ws + WS_XC);

    if (IN(PH_PRO)) { ph_prologue(A, F); __syncthreads(); } SEAM(PH_PRO);
    if (IN(PH_NORM1E)) ph_norm(F, A.in[0], A.in[2], A.in[6], mod, 0, 1, Hb, MTOT); SEAM(PH_NORM1E);
    if (IN(PH_GIN_E)) {
        pg8::Gemm g{Hb, (const bf16*)(ws + WS_WINE), MTOT, NIN_E, DM}; pg8::StaticOrder S; S.init(MTOT, NIN_E, F.G, (int)blockIdx.x);
        EpiInEven E{(bf16*)(ws + WS_G1), (const float*)(ws + WS_ROPE)};
        pg8::gemm_phase<EpiInEven, pg8::StaticOrder, true, true>(F.lds, g, S, E);
    } SEAM(PH_GIN_E);
    if (IN(PH_MIX_E)) { ph_attn_simple(A, F); __syncthreads(); ph_sgu_simple(A, F); } SEAM(PH_MIX_E);
    if (IN(PH_GOUT_E)) {
        pg8::Gemm g{(const bf16*)(ws + WS_MIX), (const bf16*)(ws + WS_WOUTE), MTOT, DM, DM}; pg8::StaticOrder S; S.init(MTOT, DM, F.G, (int)blockIdx.x);
        EpiResid E{A.in[0], A.in[2], A.out, XC, mod + 2 * 1024};
        pg8::gemm_phase<EpiResid, pg8::StaticOrder, true, true>(F.lds, g, S, E);
    } SEAM(PH_GOUT_E);
    if (IN(PH_NORM2E)) ph_norm(F, A.out, XC, A.in[7], mod, 3, 4, Hb, MTOT); SEAM(PH_NORM2E);
    if (IN(PH_FFN_UP)) {
        pg8::Gemm g{Hb, (const bf16*)(ws + WS_FFN13), MTOT, NFF2, DM}; pg8::StaticOrder S; S.init(MTOT, NFF2, F.G, (int)blockIdx.x);
        EpiSwiGLU E{(bf16*)(ws + WS_FH), NFF2 / 256};
        pg8::gemm_phase<EpiSwiGLU, pg8::StaticOrder, true, true>(F.lds, g, S, E);
    } SEAM(PH_FFN_UP);
    if (IN(PH_FFN_DN)) {
        pg8::Gemm g{(const bf16*)(ws + WS_FH), (const bf16*)(ws + WS_FFN2), MTOT, DM, DFF}; pg8::StaticOrder S; S.init(MTOT, DM, F.G, (int)blockIdx.x);
        EpiResid E{A.out, XC, A.out, XC, mod + 5 * 1024};
        pg8::gemm_phase<EpiResid, pg8::StaticOrder, true, true>(F.lds, g, S, E);
    } SEAM(PH_FFN_DN);
    if (IN(PH_NORM1O)) ph_norm(F, A.out, XC, A.in[18], mod + 3 * 6144, 0, 1, Hb, MTOT); SEAM(PH_NORM1O);
    if (IN(PH_GIN_O)) {
        pg8::Gemm g{Hb, (const bf16*)(ws + WS_WINO), MTOT, NIN_O, DM}; pg8::StaticOrder S; S.init(MTOT, NIN_O, F.G, (int)blockIdx.x);
        EpiStore E{(bf16*)(ws + WS_G2), NIN_O, NIN_O / 256, 5};
        pg8::gemm_phase<EpiStore, pg8::StaticOrder, true, true>(F.lds, g, S, E);
    } SEAM(PH_GIN_O);
    if (IN(PH_LRU_G)) ph_lru_gates_simple(A, F); SEAM(PH_LRU_G);
    if (IN(PH_LRU_S)) ph_lru_scan_simple(A, F); SEAM(PH_LRU_S);
    if (IN(PH_GOUT_O)) {
        pg8::Gemm g{(const bf16*)(ws + WS_Y1), (const bf16*)(ws + WS_WOUTO), MLAT, DM, DRNN}; pg8::StaticOrder S; S.init(MLAT, DM, F.G, (int)blockIdx.x);
        EpiResid E{A.out, XC, A.out, XC, mod + 3 * 6144 + 2 * 1024};
        pg8::gemm_phase<EpiResid, pg8::StaticOrder, true, true>(F.lds, g, S, E);
    } SEAM(PH_GOUT_O);
    if (IN(PH_ROUTE)) { ph_route(A, F); __syncthreads(); } SEAM(PH_ROUTE);
    if (IN(PH_CVT_MOE)) ph_convert_moe(A, F); SEAM(PH_CVT_MOE);
    if (IN(PH_PERM)) ph_permute(A, F); SEAM(PH_PERM);
    if (IN(PH_MOE_UP)) {
        const int* meta = (const int*)(ws + WS_META); const int nt = __builtin_amdgcn_readfirstlane(ld_i32_agent(meta + 256));
        pg8::Gemm g{(const bf16*)(ws + WS_HP), (const bf16*)(ws + WS_MOE13), MOE_ROWS, NFF2, DM}; MoeOrder S{meta, nt, NFF2 / 256, F.G, (int)blockIdx.x};
        EpiSwiGLU E{(bf16*)(ws + WS_MH), NFF2 / 256};
        pg8::gemm_phase<EpiSwiGLU, MoeOrder, true, true>(F.lds, g, S, E);
    } SEAM(PH_MOE_UP);
    if (IN(PH_MOE_DN)) {
        const int* meta = (const int*)(ws + WS_META); const int nt = __builtin_amdgcn_readfirstlane(ld_i32_agent(meta + 256));
        pg8::Gemm g{(const bf16*)(ws + WS_MH), (const bf16*)(ws + WS_MOE2), MOE_ROWS, DM, DFF}; MoeOrder S{meta, nt, DM / 256, F.G, (int)blockIdx.x};
        EpiStore E{(bf16*)(ws + WS_YD), DM, DM / 256, 0};
        pg8::gemm_phase<EpiStore, MoeOrder, true, true>(F.lds, g, S, E);
    } SEAM(PH_MOE_DN);
    if (IN(PH_COMB)) ph_combine(A, F);
#undef IN
#undef SEAM
}

extern "C" void kernel_launch(void* const* d_in, const int* in_sizes, int n_in, void* d_out, int out_size, void* d_ws, size_t ws_size, hipStream_t stream) {
    static int grid = 0;
    if (grid == 0) {
        if (n_in != 34 || in_sizes[0] != MLAT * DM || out_size != MLAT * DM || ws_size < WS_NEED) { fprintf(stderr, "kernel_launch: unexpected shapes (n_in %d, out %d, ws %zu)\n", n_in, out_size, ws_size); grid = -1; return; }
        int dev = 0, cus = 0, per_cu = 0;
        if (hipGetDevice(&dev) != hipSuccess || hipDeviceGetAttribute(&cus, hipDeviceAttributeMultiprocessorCount, dev) != hipSuccess) { grid = -1; return; }
        if (hipFuncSetAttribute((const void*)fwd_kernel, hipFuncAttributeMaxDynamicSharedMemorySize, LDS_BYTES) != hipSuccess) { grid = -1; return; }
        if (hipOccupancyMaxActiveBlocksPerMultiprocessor(&per_cu, (const void*)fwd_kernel, NTHR, LDS_BYTES) != hipSuccess || per_cu < 1) { fprintf(stderr, "kernel_launch: occupancy query says %d\n", per_cu); }
        (void)hipGetLastError();
        grid = cus;
    }
    if (grid < 0) return;
    (void)hipMemsetAsync((char*)d_ws + WS_CTL, 0, CTL_ZERO_BYTES, stream);
    Args a{};
    for (int i = 0; i < 34; ++i) a.in[i] = (const float*)d_in[i];
    a.out = (float*)d_out; a.ws = (unsigned char*)d_ws;
#if MK_ONE_LAUNCH
    a.ph_lo = 0; a.ph_hi = NPH;
    hipLaunchKernelGGL(fwd_kernel, dim3(grid), dim3(NTHR), LDS_BYTES, stream, a);
#else
    for (int p = 0; p < NPH; ++p) { a.ph_lo = p; a.ph_hi = p + 1; hipLaunchKernelGGL(fwd_kernel, dim3(grid), dim3(NTHR), LDS_BYTES, stream, a); }
#endif
}
```

```cpp
#include <hip/hip_runtime.h>
#include <cstdio>
#include <cstdint>
namespace pg8 {
#define PG8_LAS __attribute__((address_space(3)))
typedef unsigned short bf16_t;
typedef short bf16x8 __attribute__((ext_vector_type(8)));
typedef float f32x4 __attribute__((ext_vector_type(4)));
typedef unsigned u32x4 __attribute__((ext_vector_type(4)));
constexpr int BM = 256, BK = 64, HALF = 128, HTB = HALF * BK * 2  , STAGE_BYTES = 8 * HTB, NXCD = 8, WGM = 8;

__host__ __device__ __forceinline__ int lds_byte(int r, int c) { const int st = (r >> 4) * 2 + (c >> 5), rr = r & 15, cc = c & 31, ob = rr * 64 + cc * 2; return st * 1024 + (ob ^ (((ob >> 9) & 1) << 5)); }
__host__ __device__ __forceinline__ void stage_rc(int b, int& R, int& C) { const int st = b / 1024, sb = b % 1024, swz = sb ^ (((sb >> 9) & 1) << 5); R = (st >> 1) * 16 + swz / 64; C = (st & 1) * 32 + (swz % 64) / 2; }
__host__ __device__ __forceinline__ int perm32(int rho) { const int n = rho >> 4, i = rho & 15; return 8 * (i >> 2) + 4 * n + (i & 3); }

struct Unit { int pm, pn; };
struct Gemm { const bf16_t* A; const bf16_t* Bt; int M, N, K; };

struct StaticOrder {
    int nM, nN, nwg, G, c;
    __host__ __device__ void init(int M, int N, int G_, int c_) { nM = M / BM; nN = N / BM; nwg = nM * nN; G = G_; c = c_; }
    __host__ __device__ bool next(int i, Unit& u) const {
        const long L = (long)i * G + c; if (L >= nwg) return false;
        int wgid = (int)L; { const int q = nwg / NXCD, r = nwg % NXCD, xcd = wgid % NXCD, off = wgid / NXCD; wgid = (xcd < r ? xcd * (q + 1) : r * (q + 1) + (xcd - r) * q) + off; }
        const int nig = WGM * nN, gid = wgid / nig, fm = gid * WGM, gsz = (nM - fm) < WGM ? (nM - fm) : WGM;
        u.pm = fm + ((wgid % nig) % gsz); u.pn = (wgid % nig) / gsz; return true;
    }
    __device__ __forceinline__ void a_ready(const Unit&) const {}
    __device__ __forceinline__ void done(const Unit&) const {}
};

__device__ __forceinline__ unsigned cvt_pk_bf16(float lo, float hi) { unsigned r; asm volatile("v_cvt_pk_bf16_f32 %0, %1, %2" : "=v"(r) : "v"(lo), "v"(hi)); return r; }
typedef float f32x2 __attribute__((ext_vector_type(2)));
template <class Epi, class Sched, bool ALIGN_EPI = false, bool SP2 = false>
__device__ __forceinline__ void gemm_phase(PG8_LAS unsigned char* lds, const Gemm g, const Sched& S, const Epi& E) {
    const int tid = threadIdx.x, wid = __builtin_amdgcn_readfirstlane(tid >> 6), lane = tid & 63, wr = wid >> 2, wc = wid & 3, fr = lane & 15, fq = lane >> 4;
    const int K = g.K, nt = K / BK;
    unsigned voffA[2], voffB[2];
#pragma unroll
    for (int i = 0; i < 2; ++i) { int R, C; stage_rc(tid * 16 + i * 8192, R, C); const int Rb = Epi::PERM ? ((R & ~31) + perm32(R & 31)) : R;
        voffA[i] = (unsigned)(R * K + C) * 2u; voffB[i] = (unsigned)(Rb * K + C) * 2u; }
    const size_t kstep = (size_t)(BK * 2);
    const size_t hstep = (size_t)HALF * K * 2;
    const size_t tstep = 2 * hstep;
    const unsigned ldsw = (unsigned)wid * 1024u;
    const int aoff = lds_byte(wr * 64 + fr, fq * 8), boff = lds_byte(wc * 32 + fr, fq * 8);
#define PG8_SA(b, h) (((b) * 2 + (h)) * HTB)
#define PG8_SB(b, h) ((4 + (b) * 2 + (h)) * HTB)
#define PG8_STAGE(bufoff, gbase, voff) do { _Pragma("unroll") for (int _i = 0; _i < 2; ++_i) \
        __builtin_amdgcn_global_load_lds((const unsigned*)((const char*)(gbase) + (voff)[_i]), (PG8_LAS unsigned*)(lds + (bufoff) + ldsw + _i * 8192), 16, 0, 0); } while (0)
#define PG8_LDA(dst, b, h) do { _Pragma("unroll") for (int m = 0; m < 4; ++m) _Pragma("unroll") for (int k = 0; k < 2; ++k) dst[m][k] = *(const PG8_LAS bf16x8*)(lds + PG8_SA(b, h) + aoff + m * 2048 + k * 1024); } while (0)
#define PG8_LDB(dst, b, h) do { _Pragma("unroll") for (int n = 0; n < 2; ++n) _Pragma("unroll") for (int k = 0; k < 2; ++k) dst[n][k] = *(const PG8_LAS bf16x8*)(lds + PG8_SB(b, h) + boff + n * 2048 + k * 1024); } while (0)
#define PG8_MMA(ai, bj, At, Bt) do { __builtin_amdgcn_s_setprio(1); _Pragma("unroll") for (int m = 0; m < 4; ++m) _Pragma("unroll") for (int n = 0; n < 2; ++n) _Pragma("unroll") for (int k = 0; k < 2; ++k) \
        acc[ai][bj][m][n] = __builtin_amdgcn_mfma_f32_16x16x32_bf16(Bt[n][k], At[m][k], acc[ai][bj][m][n], 0, 0, 0); __builtin_amdgcn_s_setprio(0); } while (0)
#define PG8_WAIT_V(n) asm volatile("s_waitcnt vmcnt(" #n ")" ::: "memory")
#define PG8_WAIT_L(n) asm volatile("s_waitcnt lgkmcnt(" #n ")" ::: "memory")
#define PG8_BAR __builtin_amdgcn_s_barrier()
#define PG8_SCHED __builtin_amdgcn_sched_barrier(0)
    Unit cur, nxt; int ui = 0;
    if (!S.next(0, cur)) return;
    f32x4 acc[2][2][4][2];
#pragma unroll
    for (int a = 0; a < 2; ++a)
#pragma unroll
        for (int b = 0; b < 2; ++b)
#pragma unroll
            for (int m = 0; m < 4; ++m)
#pragma unroll
                for (int n = 0; n < 2; ++n) acc[a][b][m][n] = (f32x4){0.f, 0.f, 0.f, 0.f};
    bf16x8 At[4][2], B0[2][2], B1[2][2];
    const char* cA = (const char*)g.A + (size_t)cur.pm * tstep; const char* cB = (const char*)g.Bt + (size_t)cur.pn * tstep;
    S.a_ready(cur);
    if constexpr (SP2) {
        PG8_STAGE(PG8_SB(0, 0), cB, voffB); PG8_STAGE(PG8_SB(0, 1), cB + hstep, voffB); PG8_STAGE(PG8_SA(0, 0), cA, voffA); PG8_STAGE(PG8_SA(0, 1), cA + hstep, voffA);
        if (wr == 1) PG8_BAR;
        PG8_WAIT_V(2); PG8_BAR;
        PG8_STAGE(PG8_SB(1, 0), cB + kstep, voffB); PG8_STAGE(PG8_SA(1, 0), cA + kstep, voffA); PG8_STAGE(PG8_SB(1, 1), cB + hstep + kstep, voffB);
        PG8_WAIT_V(6); PG8_BAR;
    } else {
        PG8_STAGE(PG8_SB(0, 0), cB, voffB); PG8_STAGE(PG8_SA(0, 0), cA, voffA); PG8_STAGE(PG8_SB(0, 1), cB + hstep, voffB); PG8_STAGE(PG8_SA(0, 1), cA + hstep, voffA);
        if (wr == 1) PG8_BAR;
        PG8_WAIT_V(4); PG8_BAR;
        PG8_STAGE(PG8_SB(1, 0), cB + kstep, voffB); PG8_STAGE(PG8_SA(1, 0), cA + kstep, voffA); PG8_STAGE(PG8_SB(1, 1), cB + hstep + kstep, voffB);
        PG8_WAIT_V(6); PG8_BAR;
    }
    for (;;) {
        const bool has_next = S.next(ui + 1, nxt);
        const char* nA = has_next ? (const char*)g.A + (size_t)nxt.pm * tstep : cA; const char* nB = has_next ? (const char*)g.Bt + (size_t)nxt.pn * tstep : cB;
        for (int t = 0; t < nt; t += 2) {
            const bool last = (t == nt - 2);
            const char* a1 = cA + (size_t)(t + 1) * kstep;
            const char* a2 = last ? nA : cA + (size_t)(t + 2) * kstep; const char* b2 = last ? nB : cB + (size_t)(t + 2) * kstep;
            const char* a3 = a2 + kstep; const char* b3 = b2 + kstep;
            if (last && has_next) S.a_ready(nxt);
            if constexpr (SP2) {
            PG8_LDB(B0, 0, 0); PG8_LDB(B1, 0, 1); PG8_SCHED; PG8_LDA(At, 0, 0); PG8_STAGE(PG8_SA(1, 1), a1 + hstep, voffA);
            PG8_WAIT_V(8); PG8_WAIT_L(0); PG8_BAR; PG8_MMA(0, 0, At, B0); PG8_MMA(0, 1, At, B1); PG8_BAR; PG8_SCHED;
            PG8_LDA(At, 0, 1); PG8_STAGE(PG8_SB(0, 0), b2, voffB); PG8_STAGE(PG8_SB(0, 1), b2 + hstep, voffB); PG8_STAGE(PG8_SA(0, 0), a2, voffA);
            PG8_WAIT_V(8); PG8_WAIT_L(0); PG8_BAR; PG8_MMA(1, 0, At, B0); PG8_MMA(1, 1, At, B1); PG8_BAR; PG8_SCHED;
            PG8_LDB(B0, 1, 0); PG8_LDB(B1, 1, 1); PG8_SCHED; PG8_LDA(At, 1, 0); PG8_STAGE(PG8_SA(0, 1), a2 + hstep, voffA);
            PG8_WAIT_V(8); PG8_WAIT_L(0); PG8_BAR; PG8_MMA(0, 0, At, B0); PG8_MMA(0, 1, At, B1); PG8_BAR; PG8_SCHED;
            PG8_LDA(At, 1, 1); PG8_STAGE(PG8_SB(1, 0), b3, voffB); PG8_STAGE(PG8_SB(1, 1), b3 + hstep, voffB); PG8_STAGE(PG8_SA(1, 0), a3, voffA);
            PG8_WAIT_V(8); PG8_WAIT_L(0); PG8_BAR; PG8_MMA(1, 0, At, B0); PG8_MMA(1, 1, At, B1); PG8_BAR; PG8_SCHED;
            } else {
            PG8_LDB(B0, 0, 0); PG8_SCHED; PG8_LDA(At, 0, 0); PG8_STAGE(PG8_SA(1, 1), a1 + hstep, voffA);
            PG8_WAIT_L(8); PG8_BAR; PG8_WAIT_L(0); PG8_MMA(0, 0, At, B0); PG8_BAR; PG8_SCHED;
            PG8_LDB(B1, 0, 1); PG8_STAGE(PG8_SB(0, 0), b2, voffB);
            PG8_BAR; PG8_WAIT_L(0); PG8_MMA(0, 1, At, B1); PG8_BAR;
            PG8_LDA(At, 0, 1); PG8_STAGE(PG8_SA(0, 0), a2, voffA);
            PG8_BAR; PG8_WAIT_L(0); PG8_MMA(1, 0, At, B0); PG8_BAR; PG8_SCHED;
            PG8_STAGE(PG8_SB(0, 1), b2 + hstep, voffB);
            PG8_WAIT_V(6); PG8_BAR; PG8_MMA(1, 1, At, B1); PG8_BAR;
            PG8_LDB(B0, 1, 0); PG8_SCHED; PG8_LDA(At, 1, 0); PG8_STAGE(PG8_SA(0, 1), a2 + hstep, voffA);
            PG8_WAIT_L(8); PG8_BAR; PG8_WAIT_L(0); PG8_MMA(0, 0, At, B0); PG8_BAR; PG8_SCHED;
            PG8_LDB(B1, 1, 1); PG8_STAGE(PG8_SB(1, 0), b3, voffB);
            PG8_BAR; PG8_WAIT_L(0); PG8_MMA(0, 1, At, B1); PG8_BAR;
            PG8_LDA(At, 1, 1); PG8_STAGE(PG8_SA(1, 0), a3, voffA);
            PG8_BAR; PG8_WAIT_L(0); PG8_MMA(1, 0, At, B0); PG8_BAR; PG8_SCHED;
            PG8_STAGE(PG8_SB(1, 1), b3 + hstep, voffB);
            PG8_WAIT_V(6); PG8_BAR; PG8_MMA(1, 1, At, B1); PG8_BAR;
            }
        }
        if constexpr (ALIGN_EPI) { if (wr == 0) PG8_BAR; }
        if constexpr (!Epi::AFTER_DRAIN) { E(acc, cur, wr, wc, fr, fq); S.done(cur); }
        if (!has_next) break;
#pragma unroll
        for (int a = 0; a < 2; ++a)
#pragma unroll
            for (int b = 0; b < 2; ++b)
#pragma unroll
                for (int m = 0; m < 4; ++m)
#pragma unroll
                    for (int n = 0; n < 2; ++n) acc[a][b][m][n] = (f32x4){0.f, 0.f, 0.f, 0.f};
        cur = nxt; cA = nA; cB = nB; ++ui;
        if constexpr (ALIGN_EPI) { if (wr == 1) PG8_BAR; }
    }
    PG8_WAIT_V(0);
    if constexpr (!ALIGN_EPI) { if (wr == 0) PG8_BAR; }
    PG8_BAR;
    if constexpr (Epi::AFTER_DRAIN) { E.fused(acc, cur, wr, wc, fr, fq, lds, wid, lane); S.done(cur); }
#undef PG8_SA
#undef PG8_SB
#undef PG8_STAGE
#undef PG8_LDA
#undef PG8_LDB
#undef PG8_MMA
#undef PG8_WAIT_V
#undef PG8_WAIT_L
#undef PG8_BAR
#undef PG8_SCHED
}
}

constexpr int DM = 1024, NB = 2, SEQ = 8192, CTXL = 256;
constexpr int MLAT = NB * SEQ, MCTX = NB * CTXL, MTOT = MLAT + MCTX;
constexpr int NIN_E = 1792, NIN_O = 2560, DRNN = 1280, DFF = 2816, NEXP = 8, NFF2 = 2 * DFF;
constexpr int COL_V = 512, COL_Q = 1024, COL_K = 1536, COL_VAL = 1664;
constexpr float EPS = 1e-6f, LOG2E = 1.4426950408889634f, QSCALE = 0.125f * LOG2E;
constexpr int MOE_MAXT = 136;
constexpr int MOE_ROWS = MOE_MAXT * 256;

typedef unsigned short bf16;
typedef unsigned v4u __attribute__((ext_vector_type(4)));
typedef unsigned v2u __attribute__((ext_vector_type(2)));
typedef float f32x4 __attribute__((ext_vector_type(4)));
typedef float f32x2 __attribute__((ext_vector_type(2)));
#define GAS __attribute__((address_space(1)))
#define LAS __attribute__((address_space(3)))
typedef GAS unsigned gu32;
#define RLX_AGENT __ATOMIC_RELAXED, __HIP_MEMORY_SCOPE_AGENT
#define LDS_WAIT() asm volatile("s_waitcnt lgkmcnt(0)" ::: "memory")
#define VM_WAIT() asm volatile("s_waitcnt vmcnt(0)" ::: "memory")

__device__ __forceinline__ float bf2f(unsigned short u) { return __builtin_bit_cast(float, (unsigned)u << 16); }
__device__ __forceinline__ float bflo(unsigned u) { return __builtin_bit_cast(float, u << 16); }
__device__ __forceinline__ float bfhi(unsigned u) { return __builtin_bit_cast(float, u & 0xffff0000u); }
__device__ __forceinline__ unsigned pk2(float lo, float hi) { return pg8::cvt_pk_bf16(lo, hi); }
__device__ __forceinline__ unsigned short f2bf1(float x) { return (unsigned short)(pg8::cvt_pk_bf16(x, 0.f) & 0xffffu); }
__device__ __forceinline__ float fexp2(float x) { return __builtin_amdgcn_exp2f(x); }
__device__ __forceinline__ float frcp(float x) { return __builtin_amdgcn_rcpf(x); }
__device__ __forceinline__ float sigmoid_f(float x) { return frcp(1.f + fexp2(-LOG2E * x)); }
__device__ __forceinline__ float silu_f(float x) { return x * sigmoid_f(x); }
__device__ __forceinline__ float gelu_f(float x) { const float u = x * (1.f + 0.044715f * x * x); return x * frcp(1.f + fexp2((-2.f * 0.7978845608028654f * LOG2E) * u)); }
__device__ __forceinline__ f32x4 gelu4(f32x4 v) { return (f32x4){gelu_f(v[0]), gelu_f(v[1]), gelu_f(v[2]), gelu_f(v[3])}; }
__device__ __forceinline__ int ld_i32_agent(const int* p) { return __hip_atomic_load(p, RLX_AGENT); }
__device__ __forceinline__ float wave_sum(float v) {
#pragma unroll
    for (int o = 1; o < 64; o <<= 1) v += __shfl_xor(v, o);
    return v;
}
__device__ __forceinline__ float wave_max(float v) {
#pragma unroll
    for (int o = 1; o < 64; o <<= 1) v = fmaxf(v, __shfl_xor(v, o));
    return v;
}
__device__ __forceinline__ int mod_of_tile(int pm) { return pm < 32 ? 0 : (pm < 64 ? 1 : 2); }
__device__ __forceinline__ int mod_of_row(int r) { return r < SEQ ? 0 : (r < MLAT ? 1 : 2); }

struct EpiInEven {
    static constexpr bool PERM = true, AFTER_DRAIN = false;
    bf16* G1; const float* rope;
    __device__ __forceinline__ void operator()(const pg8::f32x4 (&acc)[2][2][4][2], const pg8::Unit& u, int wr, int wc, int fr, int fq) const {
        const int pn = u.pn; const bool lat = u.pm < 64;
#pragma unroll
        for (int ai = 0; ai < 2; ++ai)
#pragma unroll
            for (int m = 0; m < 4; ++m) {
                const int row = u.pm * 256 + ai * 128 + wr * 64 + m * 16 + fr;
                bf16* rowp = G1 + (size_t)row * NIN_E + pn * 256 + wc * 32 + 8 * fq;
                const int t = row & (SEQ - 1);
#pragma unroll
                for (int bj = 0; bj < 2; ++bj) {
                    f32x4 v0 = acc[ai][bj][m][0], v1 = acc[ai][bj][m][1];
                    if (pn < 4) { v0 = gelu4(v0); v1 = gelu4(v1); }
                    else if (pn < 6 || bj == 0) {
                        if (lat) {
                            const int pos = (wc & 1) ? (t & 63) : (t >> 6);
                            const f32x4* tp = (const f32x4*)(rope + (pos * 16 + 4 * fq) * 2);
                            const f32x4 c0 = tp[0], c1 = tp[1];
                            f32x4 w0, w1;
                            w0[0] = v0[0] * c0[0] - v0[1] * c0[1]; w0[1] = v0[1] * c0[0] + v0[0] * c0[1];
                            w0[2] = v0[2] * c0[2] - v0[3] * c0[3]; w0[3] = v0[3] * c0[2] + v0[2] * c0[3];
                            w1[0] = v1[0] * c1[0] - v1[1] * c1[1]; w1[1] = v1[1] * c1[0] + v1[0] * c1[1];
                            w1[2] = v1[2] * c1[2] - v1[3] * c1[3]; w1[3] = v1[3] * c1[2] + v1[2] * c1[3];
                            v0 = w0; v1 = w1;
                        }
                        if (pn < 6) { v0 = v0 * QSCALE; v1 = v1 * QSCALE; }
                    }
                    v4u w; w.x = pk2(v0[0], v0[1]); w.y = pk2(v0[2], v0[3]); w.z = pk2(v1[0], v1[1]); w.w = pk2(v1[2], v1[3]);
                    *(v4u*)(rowp + bj * 128) = w;
                }
            }
    }
};
struct EpiResid {
    static constexpr bool PERM = true, AFTER_DRAIN = false;
    const float* rin_lat; const float* rin_ctx; float* out_lat; float* out_ctx; const float* gate;
    __device__ __forceinline__ void operator()(const pg8::f32x4 (&acc)[2][2][4][2], const pg8::Unit& u, int wr, int wc, int fr, int fq) const {
        const bool lat = u.pm < 64; const float* g = gate + mod_of_tile(u.pm) * 6144;
        const float* rb = lat ? rin_lat : rin_ctx - (size_t)MLAT * DM; float* ob = lat ? out_lat : out_ctx - (size_t)MLAT * DM;
        const int col0 = u.pn * 256 + wc * 32 + 8 * fq;
        f32x4 gv[2][2];
#pragma unroll
        for (int bj = 0; bj < 2; ++bj)
#pragma unroll
            for (int n = 0; n < 2; ++n) gv[bj][n] = *(const f32x4*)(g + col0 + bj * 128 + 4 * n);
#pragma unroll
        for (int ai = 0; ai < 2; ++ai)
#pragma unroll
            for (int m = 0; m < 4; ++m) {
                const size_t p = (size_t)(u.pm * 256 + ai * 128 + wr * 64 + m * 16 + fr) * DM + col0;
#pragma unroll
                for (int bj = 0; bj < 2; ++bj) {
                    const f32x4 r0 = *(const f32x4*)(rb + p + bj * 128), r1 = *(const f32x4*)(rb + p + bj * 128 + 4);
                    *(f32x4*)(ob + p + bj * 128) = r0 + gv[bj][0] * acc[ai][bj][m][0];
                    *(f32x4*)(ob + p + bj * 128 + 4) = r1 + gv[bj][1] * acc[ai][bj][m][1];
                }
            }
    }
};
struct EpiSwiGLU {
    static constexpr bool PERM = true, AFTER_DRAIN = false;
    bf16* H; int nN;
    __device__ __forceinline__ void operator()(const pg8::f32x4 (&acc)[2][2][4][2], const pg8::Unit& u, int wr, int wc, int fr, int fq) const {
        const int pnl = u.pn % nN, col0 = pnl * 128 + wc * 32 + 8 * fq;
#pragma unroll
        for (int ai = 0; ai < 2; ++ai)
#pragma unroll
            for (int m = 0; m < 4; ++m) {
                const size_t row = (size_t)(u.pm * 256 + ai * 128 + wr * 64 + m * 16 + fr);
                const f32x4 a0 = acc[ai][0][m][0], a1 = acc[ai][0][m][1], b0 = acc[ai][1][m][0], b1 = acc[ai][1][m][1];
                v4u w;
                w.x = pk2(silu_f(a0[0]) * b0[0], silu_f(a0[1]) * b0[1]); w.y = pk2(silu_f(a0[2]) * b0[2], silu_f(a0[3]) * b0[3]);
                w.z = pk2(silu_f(a1[0]) * b1[0], silu_f(a1[1]) * b1[1]); w.w = pk2(silu_f(a1[2]) * b1[2], silu_f(a1[3]) * b1[3]);
                *(v4u*)(H + row * DFF + col0) = w;
            }
    }
};
struct EpiStore {
    static constexpr bool PERM = true, AFTER_DRAIN = false;
    bf16* O; int ldc; int nN; int ngelu;
    __device__ __forceinline__ void operator()(const pg8::f32x4 (&acc)[2][2][4][2], const pg8::Unit& u, int wr, int wc, int fr, int fq) const {
        const int pnl = u.pn % nN, col0 = pnl * 256 + wc * 32 + 8 * fq; const bool g = pnl < ngelu;
#pragma unroll
        for (int ai = 0; ai < 2; ++ai)
#pragma unroll
            for (int m = 0; m < 4; ++m) {
                bf16* rowp = O + (size_t)(u.pm * 256 + ai * 128 + wr * 64 + m * 16 + fr) * ldc + col0;
#pragma unroll
                for (int bj = 0; bj < 2; ++bj) {
                    f32x4 v0 = acc[ai][bj][m][0], v1 = acc[ai][bj][m][1];
                    if (g) { v0 = gelu4(v0); v1 = gelu4(v1); }
                    v4u w; w.x = pk2(v0[0], v0[1]); w.y = pk2(v0[2], v0[3]); w.z = pk2(v1[0], v1[1]); w.w = pk2(v1[2], v1[3]);
                    *(v4u*)(rowp + bj * 128) = w;
                }
            }
    }
};
struct MoeOrder {
    const int* tile_e; int ntiles, nN, G, c;
    __device__ __forceinline__ bool next(int i, pg8::Unit& u) const {
        const long L = (long)i * G + c; if (L >= (long)ntiles * nN) return false;
        const int pm = (int)(L / nN), pn = (int)(L % nN);
        u.pm = pm; u.pn = __builtin_amdgcn_readfirstlane(ld_i32_agent(tile_e + pm)) * nN + pn; return true;
    }
    __device__ __forceinline__ void a_ready(const pg8::Unit&) const {}
    __device__ __forceinline__ void done(const pg8::Unit&) const {}
};
#define XB_TMO      128
#define XB_XCNT(j)  (256  + 64 * (j))
#define XB_XSUB(j)  (1280 + 64 * (j))
#define XB_XGEN(j)  (2304 + 64 * (j))
#define XB_TOP      3328
#define XB_TOPGEN   3392
#define XCD_BAR_WORDS 3456
#define XB_SPIN_CAP (1u << 18)

__device__ __forceinline__ unsigned xb_ld(unsigned* p)              { return __hip_atomic_load(p, __ATOMIC_RELAXED, __HIP_MEMORY_SCOPE_AGENT); }
__device__ __forceinline__ unsigned xb_add(unsigned* p, unsigned v) { return __hip_atomic_fetch_add(p, v, __ATOMIC_RELAXED, __HIP_MEMORY_SCOPE_AGENT); }
__device__ __forceinline__ unsigned xb_xcc_id() { return (unsigned)__builtin_amdgcn_s_getreg((3 << 11) | 20) & 0xFu; }
#define XB_SPIN(cond, bar) do { unsigned _sp = 0; while (cond) { __builtin_amdgcn_s_sleep(1); \
    if ((++_sp & 255u) == 0u) { if (xb_ld(&(bar)[XB_TMO])) break; if (_sp > XB_SPIN_CAP) { atomicAdd(&(bar)[XB_TMO], 1u); break; } } } } while (0)

struct XcdBarrier {
    unsigned* bar; unsigned x;
    volatile LAS unsigned* st;
};

__device__ __forceinline__ XcdBarrier xcd_barrier_post(unsigned* bar, volatile LAS unsigned* st) {
    XcdBarrier b; b.bar = bar; b.x = xb_xcc_id(); b.st = st;
    if (threadIdx.x == 0) (void)xb_add(&bar[XB_XCNT(b.x)], 1u);
    return b;
}
__device__ __forceinline__ void xcd_barrier_complete(unsigned* bar, unsigned x, unsigned& nloc, unsigned& nx) {
    const unsigned G = gridDim.x * gridDim.y * gridDim.z;
    unsigned sum, cnt, mine, sp = 0u;
    for (;;) {
        sum = 0u; cnt = 0u; mine = 0u;
#pragma unroll
        for (unsigned j = 0; j < 16; ++j) { const unsigned c = xb_ld(&bar[XB_XCNT(j)]); sum += c; cnt += (c > 0u) ? 1u : 0u; mine = (j == x) ? c : mine; }
        if (sum == G) break;
        __builtin_amdgcn_s_sleep(1);
        if ((++sp & 255u) == 0u) { if (xb_ld(&bar[XB_TMO])) break; if (sp > XB_SPIN_CAP) { atomicAdd(&bar[XB_TMO], 1u); break; } }
    }
    nloc = mine > 0u ? mine : 1u; nx = cnt > 0u ? cnt : 1u;
}

__device__ __forceinline__ void xcd_barrier(const XcdBarrier& b) {
    asm volatile("s_waitcnt vmcnt(0)" ::: "memory");
    __syncthreads();
    if (threadIdx.x == 0) {
        unsigned* bar = b.bar;
        __builtin_amdgcn_s_waitcnt(0);
        unsigned nloc = b.st[0], nx = b.st[1];
        if (nloc == 0u) { xcd_barrier_complete(bar, b.x, nloc, nx); b.st[0] = nloc; b.st[1] = nx; }
        const unsigned old = xb_add(&bar[XB_XSUB(b.x)], 1u);
        const unsigned gen = old / nloc;
        if (old + 1u == (gen + 1u) * nloc) {
            __builtin_amdgcn_fence(__ATOMIC_RELEASE, "agent");
            asm volatile("s_waitcnt vmcnt(0)" ::: "memory");
            const unsigned og = xb_add(&bar[XB_TOP], 1u);
            const unsigned tg = og / nx;
            if (og + 1u == (tg + 1u) * nx) xb_add(&bar[XB_TOPGEN], 1u);
            else XB_SPIN(xb_ld(&bar[XB_TOPGEN]) == tg, bar);
            __builtin_amdgcn_fence(__ATOMIC_ACQUIRE, "agent");
            xb_add(&bar[XB_XGEN(b.x)], 1u);
            asm volatile("s_waitcnt vmcnt(0)" ::: "memory");
        } else {
            XB_SPIN(xb_ld(&bar[XB_XGEN(b.x)]) == gen, bar);
            __builtin_amdgcn_fence(__ATOMIC_ACQUIRE, "agent");
            asm volatile("s_waitcnt vmcnt(0)" ::: "memory");
        }
    }
    __syncthreads();
}

constexpr size_t MiB = 1u << 20;
constexpr size_t WS_CTL = 0, CTL_ZERO_BYTES = 1 * MiB;
constexpr size_t WS_MOD = 1 * MiB;
constexpr size_t WS_ROPE = 1 * MiB + 256 * 1024;
constexpr size_t WS_TOKE = 1 * MiB + 512 * 1024;
constexpr size_t WS_TOKG = WS_TOKE + 128 * 1024;
constexpr size_t WS_TOKR = WS_TOKG + 128 * 1024;
constexpr size_t WS_META = 2 * MiB;
constexpr size_t WS_WINE = 4 * MiB, WS_WOUTE = 8 * MiB, WS_FFN13 = 10 * MiB, WS_FFN2 = 21 * MiB, WS_WINO = 27 * MiB, WS_WOUTO = 32 * MiB;
constexpr size_t WS_MOE13 = 36 * MiB, WS_MOE2 = 124 * MiB;
constexpr size_t WS_H = 168 * MiB;
constexpr size_t WS_G1 = 201 * MiB;
constexpr size_t WS_MIX = 259 * MiB;
constexpr size_t WS_XC = 292 * MiB;
constexpr size_t WS_FH = 294 * MiB;
constexpr size_t WS_G2 = 201 * MiB;
constexpr size_t WS_Y1 = 284 * MiB;
constexpr size_t WS_LAF = 36 * MiB, WS_BBF = 78 * MiB, WS_LAB = 120 * MiB, WS_BBB = 324 * MiB, WS_HF = 366 * MiB;
constexpr size_t WS_HP = 168 * MiB;
constexpr size_t WS_MH = 236 * MiB;
constexpr size_t WS_YD = 36 * MiB;
constexpr size_t WS_NEED = 424 * MiB;
constexpr int CW_CNT = 64;
constexpr int CW_BAR = 4096;

constexpr int RING_BYTES = 131072, LDSCTL_OFF = RING_BYTES, MISC_OFF = LDSCTL_OFF + 320, LDS_BYTES = 147456;
constexpr int NWAVES = 8, NTHR = 512;

enum Phase { PH_PRO = 0, PH_NORM1E, PH_GIN_E, PH_MIX_E, PH_GOUT_E, PH_NORM2E, PH_FFN_UP, PH_FFN_DN, PH_NORM1O, PH_GIN_O, PH_LRU_G, PH_LRU_S, PH_GOUT_O, PH_ROUTE, PH_CVT_MOE, PH_PERM,
             PH_MOE_UP, PH_MOE_DN, PH_COMB, NPH };
#ifndef MK_ONE_LAUNCH
#define MK_ONE_LAUNCH 1
#endif

struct Args { const float* in[34]; float* out; unsigned char* ws; int ph_lo, ph_hi; };
struct Frame {
    LAS unsigned char* lds; volatile LAS unsigned* MISC; gu32* ctl;
    int tid, lane, wave, vcu, G;
};

struct MapId { __device__ __forceinline__ int operator()(int n) const { return n; } };
struct MapRope {
    __device__ __forceinline__ int operator()(int n) const {
        if (n < COL_Q || n >= COL_VAL) return n;
        const int base = n < COL_K ? COL_Q : COL_K, r = n - base, h = r >> 6, d = r & 63;
        return base + h * 64 + (d & 32) + 2 * (d & 15) + ((d >> 4) & 1);
    }
};
struct MapGLU { int off; __device__ __forceinline__ int operator()(int n) const { return (n >> 7) * 256 + off + (n & 127); } };

template <class RowMap>
__device__ __forceinline__ void tr_item(const float* W, int K, int N, bf16* WT, LAS float* scr, int item, int lane, RowMap rm) {
    const int nblk = N / 32, kb = item / nblk, nb = item % nblk, k0 = 64 * kb, n0 = 32 * nb;
#pragma unroll 8
    for (int i = 0; i < 32; ++i) { const int kk = 2 * i + (lane >> 5); scr[kk * 33 + (lane & 31)] = W[(size_t)(k0 + kk) * N + n0 + (lane & 31)]; }
    LDS_WAIT(); asm volatile("" ::: "memory");
    const int c = lane & 7;
#pragma unroll
    for (int j = 0; j < 4; ++j) { const int n = (lane >> 3) + 8 * j; const LAS float* s = scr + (8 * c) * 33 + n;
        v4u o; o.x = pk2(s[0 * 33], s[1 * 33]); o.y = pk2(s[2 * 33], s[3 * 33]); o.z = pk2(s[4 * 33], s[5 * 33]); o.w = pk2(s[6 * 33], s[7 * 33]);
        *(GAS v4u*)(WT + (size_t)rm(n0 + n) * K + k0 + 8 * c) = o; }
    LDS_WAIT(); asm volatile("" ::: "memory");
}

__device__ __forceinline__ void ph_prologue(const Args& A, Frame& F) {
    unsigned char* ws = A.ws;
    LAS float* sact = (LAS float*)F.lds;
    LAS float* red = sact + 3 * 1024;
    for (int t = F.tid; t < 3 * 1024; t += NTHR) { const int v = t >> 10, k = t & 1023; const float x = v < 2 ? A.in[1][v * 1024 + k] : A.in[3][k]; sact[t] = silu_f(x); }
    __syncthreads();
    float* mod = (float*)(ws + WS_MOD);
    for (int item = blockIdx.x; item < 256; item += F.G) {
        const int L = item >> 7, ch = item & 127; const float* W = (L ? A.in[16] : A.in[4]) + ch * 48; const float* bias = (L ? A.in[17] : A.in[5]);
        if (F.tid < 504) {
            const int c4 = F.tid % 12, ks = F.tid / 12; f32x4 a0 = {0.f, 0.f, 0.f, 0.f}, a1 = a0, a2 = a0;
            for (int k = ks; k < 1024; k += 42) { const f32x4 w = *(const f32x4*)(W + (size_t)k * 6144 + c4 * 4); a0 += sact[k] * w; a1 += sact[1024 + k] * w; a2 += sact[2048 + k] * w; }
            LAS float* r = red + ks * 144 + c4 * 4;
#pragma unroll
            for (int j = 0; j < 4; ++j) { r[j] = a0[j]; r[48 + j] = a1[j]; r[96 + j] = a2[j]; }
        }
        __syncthreads();
        if (F.tid < 144) { const int v = F.tid / 48, cc = F.tid % 48, n = ch * 48 + cc; float s = 0.f; for (int ks = 0; ks < 42; ++ks) s += red[ks * 144 + F.tid]; mod[(L * 3 + v) * 6144 + n] = s + bias[n]; }
        __syncthreads();
    }
    { const int idx = blockIdx.x * NTHR + F.tid; if (idx < 128 * 16) { const int pos = idx >> 4, f = idx & 15; const float freq = fexp2(-(float)f * (13.287712379549449f / 16.f)); const float rev = (float)pos * freq * 0.15915494309189535f;
        float* rp = (float*)(ws + WS_ROPE) + idx * 2; rp[0] = __builtin_amdgcn_cosf(rev); rp[1] = __builtin_amdgcn_sinf(rev); } }
    LAS float* scr = (LAS float*)(F.lds + F.wave * 16384);
    const int gw = F.vcu * NWAVES + F.wave, NGW = F.G * NWAVES;
    constexpr int I_WINE = 16 * 56, I_WOUTE = 16 * 32, I_F1 = 16 * 88, I_F2 = 44 * 32, I_WINO = 16 * 80, I_WOUTO = 20 * 32;
    constexpr int NITEMS = I_WINE + I_WOUTE + 2 * I_F1 + I_F2 + I_WINO + I_WOUTO;
    for (int it = gw; it < NITEMS; it += NGW) {
        int r = it;
        if (r < I_WINE) { tr_item(A.in[8], DM, NIN_E, (bf16*)(ws + WS_WINE), scr, r, F.lane, MapRope{}); continue; } r -= I_WINE;
        if (r < I_WOUTE) { tr_item(A.in[12], DM, DM, (bf16*)(ws + WS_WOUTE), scr, r, F.lane, MapId{}); continue; } r -= I_WOUTE;
        if (r < I_F1) { tr_item(A.in[13], DM, DFF, (bf16*)(ws + WS_FFN13), scr, r, F.lane, MapGLU{0}); continue; } r -= I_F1;
        if (r < I_F1) { tr_item(A.in[14], DM, DFF, (bf16*)(ws + WS_FFN13), scr, r, F.lane, MapGLU{128}); continue; } r -= I_F1;
        if (r < I_F2) { tr_item(A.in[15], DFF, DM, (bf16*)(ws + WS_FFN2), scr, r, F.lane, MapId{}); continue; } r -= I_F2;
        if (r < I_WINO) { tr_item(A.in[20], DM, NIN_O, (bf16*)(ws + WS_WINO), scr, r, F.lane, MapId{}); continue; } r -= I_WINO;
        tr_item(A.in[28], DRNN, DM, (bf16*)(ws + WS_WOUTO), scr, r, F.lane, MapId{});
    }
}
__device__ __forceinline__ void ph_convert_moe(const Args& A, Frame& F) {
    unsigned char* ws = A.ws;
    LAS float* scr = (LAS float*)(F.lds + F.wave * 16384);
    const int gw = F.vcu * NWAVES + F.wave, NGW = F.G * NWAVES;
    constexpr int I_F1 = 16 * 88, I_F2 = 44 * 32, PER_E = 2 * I_F1 + I_F2;
    for (int it = gw; it < NEXP * PER_E; it += NGW) {
        const int e = it / PER_E; int r = it % PER_E;
        bf16* w13 = (bf16*)(ws + WS_MOE13) + (size_t)e * NFF2 * DM; bf16* w2 = (bf16*)(ws + WS_MOE2) + (size_t)e * DM * DFF;
        if (r < I_F1) { tr_item(A.in[30] + (size_t)e * DM * DFF, DM, DFF, w13, scr, r, F.lane, MapGLU{0}); continue; } r -= I_F1;
        if (r < I_F1) { tr_item(A.in[31] + (size_t)e * DM * DFF, DM, DFF, w13, scr, r, F.lane, MapGLU{128}); continue; } r -= I_F1;
        tr_item(A.in[32] + (size_t)e * DFF * DM, DFF, DM, w2, scr, r, F.lane, MapId{});
    }
}

__device__ __forceinline__ void norm_mod_regs(const float* xrow, const float* gain, const float* scale, const float* shift, int lane, f32x4 (&v)[4]) {
    const f32x4* xr = (const f32x4*)xrow + lane; float ss = 0.f;
#pragma unroll
    for (int j = 0; j < 4; ++j) { v[j] = xr[64 * j]; ss += (v[j][0] * v[j][0] + v[j][1] * v[j][1]) + (v[j][2] * v[j][2] + v[j][3] * v[j][3]); }
    const float rstd = 1.f / sqrtf(wave_sum(ss) * (1.f / DM) + EPS);
#pragma unroll
    for (int j = 0; j < 4; ++j) { const f32x4 g = ((const f32x4*)gain)[lane + 64 * j], sc = ((const f32x4*)scale)[lane + 64 * j], sh = ((const f32x4*)shift)[lane + 64 * j];
        v[j] = v[j] * rstd * g * (1.f + sc) + sh; }
}
__device__ __forceinline__ void ph_norm(Frame& F, const float* xl, const float* xc, const float* gain, const float* modL, int p_shift, int p_scale, bf16* H, int nrows) {
    const int gw = F.vcu * NWAVES + F.wave, NGW = F.G * NWAVES;
    for (int r = gw; r < nrows; r += NGW) {
        const float* md = modL + mod_of_row(r) * 6144; const float* xrow = r < MLAT ? xl + (size_t)r * DM : xc + (size_t)(r - MLAT) * DM;
        f32x4 v[4]; norm_mod_regs(xrow, gain, md + p_scale * 1024, md + p_shift * 1024, F.lane, v);
        GAS v2u* o = (GAS v2u*)(H + (size_t)r * DM) + F.lane;
#pragma unroll
        for (int j = 0; j < 4; ++j) { v2u w; w.x = pk2(v[j][0], v[j][1]); w.y = pk2(v[j][2], v[j][3]); o[64 * j] = w; }
    }
}

__device__ __forceinline__ void ph_attn_simple(const Args& A, Frame& F) {
    const bf16* G1 = (const bf16*)(A.ws + WS_G1); bf16* MIX = (bf16*)(A.ws + WS_MIX); const float* sink = A.in[11];
    LAS float* wq = (LAS float*)(F.lds + F.wave * 4096); LAS float* wp = wq + 64;
    const int gw = F.vcu * NWAVES + F.wave, NGW = F.G * NWAVES, lane = F.lane;
    for (int it = gw; it < MTOT * 8; it += NGW) {
        const int row = it >> 3, h = it & 7, kvh = h >> 2; const bool lat = row < MLAT;
        const int b = lat ? (row >> 13) : ((row - MLAT) >> 8), t = row & (SEQ - 1);
        wq[lane] = bf2f(G1[(size_t)row * NIN_E + COL_Q + h * 64 + lane]);
        LDS_WAIT();
        const float sk = sink[h] * LOG2E;
        float sc[9]; float mx = sk;
#pragma unroll
        for (int i = 0; i < 9; ++i) {
            const int s = lane + 64 * i; bool valid; int krow;
            if (lat) { if (s < 257) { const int j = t - 128 + s; valid = (j >= 0) && (j < SEQ); krow = b * SEQ + j; } else { valid = s < 513; krow = MLAT + b * CTXL + (s - 257); } }
            else { valid = s < CTXL; krow = MLAT + b * CTXL + s; }
            float d = -INFINITY;
            if (valid) { const v4u* kp = (const v4u*)(G1 + (size_t)krow * NIN_E + COL_K + kvh * 64); d = 0.f;
#pragma unroll
                for (int c = 0; c < 8; ++c) { const v4u kk = kp[c]; const LAS float* q = wq + 8 * c;
                    d += bflo(kk.x) * q[0] + bfhi(kk.x) * q[1] + bflo(kk.y) * q[2] + bfhi(kk.y) * q[3] + bflo(kk.z) * q[4] + bfhi(kk.z) * q[5] + bflo(kk.w) * q[6] + bfhi(kk.w) * q[7]; } }
            sc[i] = d; mx = fmaxf(mx, d);
        }
        mx = wave_max(mx);
        float sum = 0.f;
#pragma unroll
        for (int i = 0; i < 9; ++i) { const float p = fexp2(sc[i] - mx); wp[lane + 64 * i] = p; sum += p; }
        sum = wave_sum(sum) + fexp2(sk - mx);
        LDS_WAIT();
        float o = 0.f;
        const bf16* vb = G1 + COL_VAL + kvh * 64 + lane;
        if (lat) {
            const int s_lo = (128 - t) > 0 ? (128 - t) : 0, s_hi = (SEQ - 1 - t + 128) < 256 ? (SEQ - 1 - t + 128) : 256;
#pragma unroll 8
            for (int s = s_lo; s <= s_hi; ++s) o += wp[s] * bf2f(vb[(size_t)(b * SEQ + t - 128 + s) * NIN_E]);
#pragma unroll 8
            for (int s = 0; s < CTXL; ++s) o += wp[257 + s] * bf2f(vb[(size_t)(MLAT + b * CTXL + s) * NIN_E]);
        } else {
#pragma unroll 8
            for (int s = 0; s < CTXL; ++s) o += wp[s] * bf2f(vb[(size_t)(MLAT + b * CTXL + s) * NIN_E]);
        }
        MIX[(size_t)row * DM + 512 + h * 64 + lane] = f2bf1(o / sum);
        LDS_WAIT();
    }
}
__device__ __forceinline__ void ph_sgu_simple(const Args& A, Frame& F) {
    const bf16* G1 = (const bf16*)(A.ws + WS_G1); bf16* MIX = (bf16*)(A.ws + WS_MIX); const float* sgw = A.in[9]; const float* sgb = A.in[10];
    LAS float* vn = (LAS float*)F.lds;
    for (int item = blockIdx.x; item < (MTOT / 128) * 4; item += F.G) {
        const int chunk = item >> 2, g = item & 3, row0 = chunk * 128;
        for (int i = 0; i < 16; ++i) { const int q = F.wave * 16 + i;
            const unsigned u = ((const unsigned*)(G1 + (size_t)(row0 + q) * NIN_E + COL_V + g * 128))[F.lane];
            const float x0 = bflo(u), x1 = bfhi(u); const float mean = wave_sum(x0 + x1) * (1.f / 128.f); const float d0 = x0 - mean, d1 = x1 - mean;
            const float var = wave_sum(d0 * d0 + d1 * d1) * (1.f / 128.f); const float rs = 1.f / sqrtf(var + EPS);
            vn[q * 128 + 2 * F.lane] = d0 * rs; vn[q * 128 + 2 * F.lane + 1] = d1 * rs; }
        __syncthreads();
        const int c = F.tid & 127, pb = F.tid >> 7;
        for (int i = 0; i < 32; ++i) { const int p = pb + 4 * i; const float* wrow = sgw + (size_t)(g * 128 + p) * 128; float acc = 0.f;
#pragma unroll 8
            for (int q = 0; q < 128; ++q) acc += wrow[q] * vn[q * 128 + c];
            const float uu = bf2f(G1[(size_t)(row0 + p) * NIN_E + g * 128 + c]);
            MIX[(size_t)(row0 + p) * DM + g * 128 + c] = f2bf1(uu * (acc + sgb[g * 128 + p])); }
        __syncthreads();
    }
}
__device__ __forceinline__ void ph_lru_gates_simple(const Args& A, Frame& F) {
    const bf16* G2 = (const bf16*)(A.ws + WS_G2); const float* cw = A.in[21]; const float* cb = A.in[22];
    const float *wa = A.in[23], *ba = A.in[24], *wx = A.in[25], *bx = A.in[26], *lam = A.in[27];
    LAS float* rc = (LAS float*)F.lds;
    for (int rg = blockIdx.x; rg < MTOT / 8; rg += F.G) {
        const int r0 = rg * 8;
        for (int e = F.tid; e < 8 * DRNN; e += NTHR) { const int rr = e / DRNN, c = e % DRNN, row = r0 + rr;
            const int pos = row < MLAT ? (row & (SEQ - 1)) : ((row - MLAT) & (CTXL - 1)), len = row < MLAT ? SEQ : CTXL;
            float acc = cb[c];
#pragma unroll
            for (int j = 0; j < 4; ++j) { const int pp = pos + j - 2; if (pp >= 0 && pp < len) acc += cw[j * DRNN + c] * bf2f(G2[(size_t)(row + j - 2) * NIN_O + DRNN + c]); }
            rc[rr * DRNN + c] = acc; }
        __syncthreads();
        for (int q5 = 0; q5 < 5; ++q5) { const int pc = F.tid + NTHR * q5, d = pc / DRNN, c = pc % DRNN, blk = c >> 7, j = c & 127;
            const float* wap = wa + (size_t)((d * 10 + blk) * 128) * 128 + j; const float* wxp = wx + (size_t)((d * 10 + blk) * 128) * 128 + j;
            float ar[8], ai[8];
#pragma unroll
            for (int r = 0; r < 8; ++r) { ar[r] = 0.f; ai[r] = 0.f; }
            for (int i = 0; i < 128; ++i) { const float wav = wap[i * 128], wxv = wxp[i * 128];
#pragma unroll
                for (int r = 0; r < 8; ++r) { const float x = rc[r * DRNN + blk * 128 + i]; ar[r] += x * wav; ai[r] += x * wxv; } }
            const float bav = ba[d * DRNN + c], bxv = bx[d * DRNN + c], sp = log1pf(expf(-lam[d * DRNN + c]));
            bf16* LA = (bf16*)(A.ws + (d ? WS_LAB : WS_LAF)); bf16* BB = (bf16*)(A.ws + (d ? WS_BBB : WS_BBF));
#pragma unroll
            for (int r = 0; r < 8; ++r) { const float rgt = sigmoid_f(ar[r] + bav), igt = sigmoid_f(ai[r] + bxv), la = -8.f * rgt * sp;
                const float bbv = sqrtf(-expm1f(2.f * la)) * (igt * rc[r * DRNN + c]);
                LA[(size_t)(r0 + r) * DRNN + c] = f2bf1(la); BB[(size_t)(r0 + r) * DRNN + c] = f2bf1(bbv); } }
        __syncthreads();
    }
}
__device__ __forceinline__ void ph_lru_scan_simple(const Args& A, Frame& F) {
    const int gt = blockIdx.x * NTHR + F.tid; if (gt >= NB * DRNN) return;
    const int b = gt / DRNN, c = gt % DRNN;
    const bf16* LAf = (const bf16*)(A.ws + WS_LAF) + c; const bf16* BBf = (const bf16*)(A.ws + WS_BBF) + c; const bf16* LAb = (const bf16*)(A.ws + WS_LAB) + c; const bf16* BBb = (const bf16*)(A.ws + WS_BBB) + c;
    bf16* HF = (bf16*)(A.ws + WS_HF) + c; const bf16* G2 = (const bf16*)(A.ws + WS_G2) + c; bf16* Y1 = (bf16*)(A.ws + WS_Y1) + c;
    float h = 0.f;
#pragma unroll 8
    for (int l = 0; l < CTXL; ++l) { const size_t row = MLAT + b * CTXL + l; h = expf(bf2f(LAf[row * DRNN])) * h + bf2f(BBf[row * DRNN]); }
#pragma unroll 8
    for (int t = 0; t < SEQ; ++t) { const size_t row = (size_t)b * SEQ + t; h = expf(bf2f(LAf[row * DRNN])) * h + bf2f(BBf[row * DRNN]); HF[row * DRNN] = f2bf1(h); }
    h = 0.f;
#pragma unroll 8
    for (int l = CTXL - 1; l >= 0; --l) { const size_t row = MLAT + b * CTXL + l; h = expf(bf2f(LAb[row * DRNN])) * h + bf2f(BBb[row * DRNN]); }
#pragma unroll 8
    for (int t = SEQ - 1; t >= 0; --t) { const size_t row = (size_t)b * SEQ + t; h = expf(bf2f(LAb[row * DRNN])) * h + bf2f(BBb[row * DRNN]);
        Y1[row * DRNN] = f2bf1(bf2f(G2[row * NIN_O]) * (bf2f(HF[row * DRNN]) + h)); }
}

__device__ __forceinline__ void route_row(const Args& A, Frame& F, const LAS float* rw, int t, f32x4 (&v)[4], float (&lg)[8]) {
    const float* md = (const float*)(A.ws + WS_MOD) + (3 + (t >> 13)) * 6144;
    norm_mod_regs(A.out + (size_t)t * DM, A.in[19], md + 4 * 1024, md + 3 * 1024, F.lane, v);
#pragma unroll
    for (int e = 0; e < 8; ++e) lg[e] = 0.f;
#pragma unroll
    for (int j = 0; j < 4; ++j)
#pragma unroll
        for (int i = 0; i < 4; ++i) { const int k = 4 * (F.lane + 64 * j) + i; const f32x4 w0 = *(const LAS f32x4*)(rw + k * 8), w1 = *(const LAS f32x4*)(rw + k * 8 + 4); const float x = v[j][i];
            lg[0] += x * w0[0]; lg[1] += x * w0[1]; lg[2] += x * w0[2]; lg[3] += x * w0[3]; lg[4] += x * w1[0]; lg[5] += x * w1[1]; lg[6] += x * w1[2]; lg[7] += x * w1[3]; }
#pragma unroll
    for (int e = 0; e < 8; ++e) lg[e] = wave_sum(lg[e]);
}
__device__ __forceinline__ void ph_route(const Args& A, Frame& F) {
    LAS float* rw = (LAS float*)F.lds;
    for (int i = F.tid; i < DM * 8; i += NTHR) rw[i] = A.in[29][i];
    __syncthreads();
    int* toke = (int*)(A.ws + WS_TOKE); float* tokg = (float*)(A.ws + WS_TOKG); int* tokr = (int*)(A.ws + WS_TOKR);
    const int gw = F.vcu * NWAVES + F.wave, NGW = F.G * NWAVES;
    for (int t = gw; t < MLAT; t += NGW) {
        f32x4 v[4]; float lg[8]; route_row(A, F, rw, t, v, lg);
        int i0 = 0; float l0 = lg[0];
#pragma unroll
        for (int e = 1; e < 8; ++e) if (lg[e] > l0) { l0 = lg[e]; i0 = e; }
        int i1 = -1; float l1 = -INFINITY;
#pragma unroll
        for (int e = 0; e < 8; ++e) if (e != i0 && lg[e] > l1) { l1 = lg[e]; i1 = e; }
        const float g0 = 1.f / (1.f + expf(l1 - l0)), g1 = 1.f - g0;
        if (F.lane == 0) {
            const int r0 = (int)__hip_atomic_fetch_add((unsigned*)(F.ctl + CW_CNT + 16 * i0), 1u, RLX_AGENT), r1 = (int)__hip_atomic_fetch_add((unsigned*)(F.ctl + CW_CNT + 16 * i1), 1u, RLX_AGENT);
            toke[t] = i0; toke[MLAT + t] = i1; tokg[t] = g0; tokg[MLAT + t] = g1; tokr[t] = r0; tokr[MLAT + t] = r1;
        }
    }
}
__device__ __forceinline__ void ph_permute(const Args& A, Frame& F) {
    int* toke = (int*)(A.ws + WS_TOKE); int* tokr = (int*)(A.ws + WS_TOKR); int* meta = (int*)(A.ws + WS_META); bf16* HP = (bf16*)(A.ws + WS_HP);
    int off[8]; int tot = 0;
#pragma unroll
    for (int e = 0; e < 8; ++e) { const int c = (int)__hip_atomic_load((unsigned*)(F.ctl + CW_CNT + 16 * e), RLX_AGENT); off[e] = tot; tot += ((c + 255) >> 8) << 8; }
    if (blockIdx.x == 0 && F.tid < MOE_MAXT + 8) { int e = 0;
#pragma unroll
        for (int k = 1; k < 8; ++k) if (F.tid * 256 >= off[k]) e = k;
        meta[F.tid] = e; if (F.tid == 0) meta[256] = tot >> 8; }
    const int gw = F.vcu * NWAVES + F.wave, NGW = F.G * NWAVES;
    for (int t = gw; t < MLAT; t += NGW) {
        const float* md = (const float*)(A.ws + WS_MOD) + (3 + (t >> 13)) * 6144;
        f32x4 v[4]; norm_mod_regs(A.out + (size_t)t * DM, A.in[19], md + 4 * 1024, md + 3 * 1024, F.lane, v);
        const int e0 = toke[t], e1 = toke[MLAT + t]; int s0 = tokr[t], s1 = tokr[MLAT + t];
        int o0 = 0, o1 = 0;
#pragma unroll
        for (int k = 0; k < 8; ++k) { if (k == e0) o0 = off[k]; if (k == e1) o1 = off[k]; }
        s0 += o0; s1 += o1;
        GAS v2u* p0 = (GAS v2u*)(HP + (size_t)s0 * DM) + F.lane; GAS v2u* p1 = (GAS v2u*)(HP + (size_t)s1 * DM) + F.lane;
#pragma unroll
        for (int j = 0; j < 4; ++j) { v2u w; w.x = pk2(v[j][0], v[j][1]); w.y = pk2(v[j][2], v[j][3]); p0[64 * j] = w; p1[64 * j] = w; }
        if (F.lane == 0) { tokr[t] = s0; tokr[MLAT + t] = s1; }
    }
}
__device__ __forceinline__ void ph_combine(const Args& A, Frame& F) {
    const float* tokg = (const float*)(A.ws + WS_TOKG); const int* tokr = (const int*)(A.ws + WS_TOKR); const bf16* YD = (const bf16*)(A.ws + WS_YD); const float* fn = A.in[33];
    const int gw = F.vcu * NWAVES + F.wave, NGW = F.G * NWAVES;
    for (int t = gw; t < MLAT; t += NGW) {
        const float* g2 = (const float*)(A.ws + WS_MOD) + (3 + (t >> 13)) * 6144 + 5 * 1024;
        const int s0 = tokr[t], s1 = tokr[MLAT + t]; const float g0 = tokg[t], g1 = tokg[MLAT + t];
        f32x4* xr = (f32x4*)(A.out + (size_t)t * DM) + F.lane; const v2u* y0 = (const v2u*)(YD + (size_t)s0 * DM) + F.lane; const v2u* y1 = (const v2u*)(YD + (size_t)s1 * DM) + F.lane;
        f32x4 z[4]; float ss = 0.f;
#pragma unroll
        for (int j = 0; j < 4; ++j) { const f32x4 x = xr[64 * j], g = ((const f32x4*)g2)[F.lane + 64 * j]; const v2u a = y0[64 * j], b = y1[64 * j];
            f32x4 m; m[0] = g0 * bflo(a.x) + g1 * bflo(b.x); m[1] = g0 * bfhi(a.x) + g1 * bfhi(b.x); m[2] = g0 * bflo(a.y) + g1 * bflo(b.y); m[3] = g0 * bfhi(a.y) + g1 * bfhi(b.y);
            z[j] = x + g * m; ss += (z[j][0] * z[j][0] + z[j][1] * z[j][1]) + (z[j][2] * z[j][2] + z[j][3] * z[j][3]); }
        const float rstd = 1.f / sqrtf(wave_sum(ss) * (1.f / DM) + EPS);
#pragma unroll
        for (int j = 0; j < 4; ++j) xr[64 * j] = z[j] * rstd * ((const f32x4*)fn)[F.lane + 64 * j];
    }
}

__global__ void __launch_bounds__(NTHR, 2) fwd_kernel(Args A) {
    extern __shared__ __attribute__((aligned(16))) unsigned char lds[];
    Frame F;
    F.lds = (LAS unsigned char*)lds; F.MISC = (volatile LAS unsigned*)(F.lds + MISC_OFF);
    F.tid = threadIdx.x; F.lane = F.tid & 63; F.wave = __builtin_amdgcn_readfirstlane(F.tid >> 6);
    F.G = gridDim.x; { const int bx = blockIdx.x; F.vcu = (F.G % 8 == 0) ? (bx % 8) * (F.G / 8) + bx / 8 : bx; }
    unsigned char* ws = A.ws;
    F.ctl = (gu32*)(ws + WS_CTL);
    for (int u = F.tid; u < (LDS_BYTES - LDSCTL_OFF) / 4; u += NTHR) ((LAS unsigned*)(F.lds + LDSCTL_OFF))[u] = 0u;
    __syncthreads();
    XcdBarrier bar; bar.bar = (unsigned*)(F.ctl + CW_BAR); bar.x = 0; bar.st = nullptr;
    if (MK_ONE_LAUNCH) bar = xcd_barrier_post((unsigned*)(F.ctl + CW_BAR), F.MISC + 8);
    const int lo = A.ph_lo, hi = A.ph_hi;
#define IN(k) (lo <= (k) && (k) < hi)
#define SEAM(k) do { if (IN(k) && IN((k) + 1)) xcd_barrier(bar); } while (0)
    const float* mod = (const float*)(ws + WS_MOD);
    bf16* Hb = (bf16*)(ws + WS_H); float* XC = (float*)(ws + WS_XC);

    if (IN(PH_PRO)) { ph_prologue(A, F); __syncthreads(); } SEAM(PH_PRO);
    if (IN(PH_NORM1E)) ph_norm(F, A.in[0], A.in[2], A.in[6], mod, 0, 1, Hb, MTOT); SEAM(PH_NORM1E);
    if (IN(PH_GIN_E)) {
        pg8::Gemm g{Hb, (const bf16*)(ws + WS_WINE), MTOT, NIN_E, DM}; pg8::StaticOrder S; S.init(MTOT, NIN_E, F.G, (int)blockIdx.x);
        EpiInEven E{(bf16*)(ws + WS_G1), (const float*)(ws + WS_ROPE)};
        pg8::gemm_phase<EpiInEven, pg8::StaticOrder, true, true>(F.lds, g, S, E);
    } SEAM(PH_GIN_E);
    if (IN(PH_MIX_E)) { ph_attn_simple(A, F); __syncthreads(); ph_sgu_simple(A, F); } SEAM(PH_MIX_E);
    if (IN(PH_GOUT_E)) {
        pg8::Gemm g{(const bf16*)(ws + WS_MIX), (const bf16*)(ws + WS_WOUTE), MTOT, DM, DM}; pg8::StaticOrder S; S.init(MTOT, DM, F.G, (int)blockIdx.x);
        EpiResid E{A.in[0], A.in[2], A.out, XC, mod + 2 * 1024};
        pg8::gemm_phase<EpiResid, pg8::StaticOrder, true, true>(F.lds, g, S, E);
    } SEAM(PH_GOUT_E);
    if (IN(PH_NORM2E)) ph_norm(F, A.out, XC, A.in[7], mod, 3, 4, Hb, MTOT); SEAM(PH_NORM2E);
    if (IN(PH_FFN_UP)) {
        pg8::Gemm g{Hb, (const bf16*)(ws + WS_FFN13), MTOT, NFF2, DM}; pg8::StaticOrder S; S.init(MTOT, NFF2, F.G, (int)blockIdx.x);
        EpiSwiGLU E{(bf16*)(ws + WS_FH), NFF2 / 256};
        pg8::gemm_phase<EpiSwiGLU, pg8::StaticOrder, true, true>(F.lds, g, S, E);
    } SEAM(PH_FFN_UP);
    if (IN(PH_FFN_DN)) {
        pg8::Gemm g{(const bf16*)(ws + WS_FH), (const bf16*)(ws + WS_FFN2), MTOT, DM, DFF}; pg8::StaticOrder S; S.init(MTOT, DM, F.G, (int)blockIdx.x);
        EpiResid E{A.out, XC, A.out, XC, mod + 5 * 1024};
        pg8::gemm_phase<EpiResid, pg8::StaticOrder, true, true>(F.lds, g, S, E);
    } SEAM(PH_FFN_DN);
    if (IN(PH_NORM1O)) ph_norm(F, A.out, XC, A.in[18], mod + 3 * 6144, 0, 1, Hb, MTOT); SEAM(PH_NORM1O);
    if (IN(PH_GIN_O)) {
        pg8::Gemm g{Hb, (const bf16*)(ws + WS_WINO), MTOT, NIN_O, DM}; pg8::StaticOrder S; S.init(MTOT, NIN_O, F.G, (int)blockIdx.x);
        EpiStore E{(bf16*)(ws + WS_G2), NIN_O, NIN_O / 256, 5};
        pg8::gemm_phase<EpiStore, pg8::StaticOrder, true, true>(F.lds, g, S, E);
    } SEAM(PH_GIN_O);
    if (IN(PH_LRU_G)) ph_lru_gates_simple(A, F); SEAM(PH_LRU_G);
    if (IN(PH_LRU_S)) ph_lru_scan_simple(A, F); SEAM(PH_LRU_S);
    if (IN(PH_GOUT_O)) {
        pg8::Gemm g{(const bf16*)(ws + WS_Y1), (const bf16*)(ws + WS_WOUTO), MLAT, DM, DRNN}; pg8::StaticOrder S; S.init(MLAT, DM, F.G, (int)blockIdx.x);
        EpiResid E{A.out, XC, A.out, XC, mod + 3 * 6144 + 2 * 1024};
        pg8::gemm_phase<EpiResid, pg8::StaticOrder, true, true>(F.lds, g, S, E);
    } SEAM(PH_GOUT_O);
    if (IN(PH_ROUTE)) { ph_route(A, F); __syncthreads(); } SEAM(PH_ROUTE);
    if (IN(PH_CVT_MOE)) ph_convert_moe(A, F); SEAM(PH_CVT_MOE);
    if (IN(PH_PERM)) ph_permute(A, F); SEAM(PH_PERM);
    if (IN(PH_MOE_UP)) {
        const int* meta = (const int*)(ws + WS_META); const int nt = __builtin_amdgcn_readfirstlane(ld_i32_agent(meta + 256));
        pg8::Gemm g{(const bf16*)(ws + WS_HP), (const bf16*)(ws + WS_MOE13), MOE_ROWS, NFF2, DM}; MoeOrder S{meta, nt, NFF2 / 256, F.G, (int)blockIdx.x};
        EpiSwiGLU E{(bf16*)(ws + WS_MH), NFF2 / 256};
        pg8::gemm_phase<EpiSwiGLU, MoeOrder, true, true>(F.lds, g, S, E);
    } SEAM(PH_MOE_UP);
    if (IN(PH_MOE_DN)) {
        const int* meta = (const int*)(ws + WS_META); const int nt = __builtin_amdgcn_readfirstlane(ld_i32_agent(meta + 256));
        pg8::Gemm g{(const bf16*)(ws + WS_MH), (const bf16*)(ws + WS_MOE2), MOE_ROWS, DM, DFF}; MoeOrder S{meta, nt, DM / 256, F.G, (int)blockIdx.x};
        EpiStore E{(bf16*)(ws + WS_YD), DM, DM / 256, 0};
        pg8::gemm_phase<EpiStore, MoeOrder, true, true>(F.lds, g, S, E);
    } SEAM(PH_MOE_DN);
    if (IN(PH_COMB)) ph_combine(A, F);
#undef IN
#undef SEAM
}

extern "C" void kernel_launch(void* const* d_in, const int* in_sizes, int n_in, void* d_out, int out_size, void* d_ws, size_t ws_size, hipStream_t stream) {
    static int grid = 0;
    if (grid == 0) {
        if (n_in != 34 || in_sizes[0] != MLAT * DM || out_size != MLAT * DM || ws_size < WS_NEED) { fprintf(stderr, "kernel_launch: unexpected shapes (n_in %d, out %d, ws %zu)\n", n_in, out_size, ws_size); grid = -1; return; }
        int dev = 0, cus = 0, per_cu = 0;
        if (hipGetDevice(&dev) != hipSuccess || hipDeviceGetAttribute(&cus, hipDeviceAttributeMultiprocessorCount, dev) != hipSuccess) { grid = -1; return; }
        if (hipFuncSetAttribute((const void*)fwd_kernel, hipFuncAttributeMaxDynamicSharedMemorySize, LDS_BYTES) != hipSuccess) { grid = -1; return; }
        if (hipOccupancyMaxActiveBlocksPerMultiprocessor(&per_cu, (const void*)fwd_kernel, NTHR, LDS_BYTES) != hipSuccess || per_cu < 1) { fprintf(stderr, "kernel_launch: occupancy query says %d\n", per_cu); }
        (void)hipGetLastError();
        grid = cus;
    }
    if (grid < 0) return;
    (void)hipMemsetAsync((char*)d_ws + WS_CTL, 0, CTL_ZERO_BYTES, stream);
    Args a{};
    for (int i = 0; i < 34; ++i) a.in[i] = (const float*)d_in[i];
    a.out = (float*)d_out; a.ws = (unsigned char*)d_ws;
#if MK_ONE_LAUNCH
    a.ph_lo = 0; a.ph_hi = NPH;
    hipLaunchKernelGGL(fwd_kernel, dim3(grid), dim3(NTHR), LDS_BYTES, stream, a);
#else
    for (int p = 0; p < NPH; ++p) { a.ph_lo = p; a.ph_hi = p + 1; hipLaunchKernelGGL(fwd_kernel, dim3(grid), dim3(NTHR), LDS_BYTES, stream, a); }
#endif
}
```

```cpp
#include <hip/hip_runtime.h>
#include <cstdio>
#include <cstdint>
namespace pg8 {
#define PG8_LAS __attribute__((address_space(3)))
typedef unsigned short bf16_t;
typedef short bf16x8 __attribute__((ext_vector_type(8)));
typedef float f32x4 __attribute__((ext_vector_type(4)));
typedef unsigned u32x4 __attribute__((ext_vector_type(4)));
constexpr int BM = 256, BK = 64, HALF = 128, HTB = HALF * BK * 2  , STAGE_BYTES = 8 * HTB, NXCD = 8, WGM = 8;

__host__ __device__ __forceinline__ int lds_byte(int r, int c) { const int st = (r >> 4) * 2 + (c >> 5), rr = r & 15, cc = c & 31, ob = rr * 64 + cc * 2; return st * 1024 + (ob ^ (((ob >> 9) & 1) << 5)); }
__host__ __device__ __forceinline__ void stage_rc(int b, int& R, int& C) { const int st = b / 1024, sb = b % 1024, swz = sb ^ (((sb >> 9) & 1) << 5); R = (st >> 1) * 16 + swz / 64; C = (st & 1) * 32 + (swz % 64) / 2; }
__host__ __device__ __forceinline__ int perm32(int rho) { const int n = rho >> 4, i = rho & 15; return 8 * (i >> 2) + 4 * n + (i & 3); }

struct Unit { int pm, pn; };
struct Gemm { const bf16_t* A; const bf16_t* Bt; int M, N, K; };

struct StaticOrder {
    int nM, nN, nwg, G, c;
    __host__ __device__ void init(int M, int N, int G_, int c_) { nM = M / BM; nN = N / BM; nwg = nM * nN; G = G_; c = c_; }
    __host__ __device__ bool next(int i, Unit& u) const {
        const long L = (long)i * G + c; if (L >= nwg) return false;
        int wgid = (int)L; { const int q = nwg / NXCD, r = nwg % NXCD, xcd = wgid % NXCD, off = wgid / NXCD; wgid = (xcd < r ? xcd * (q + 1) : r * (q + 1) + (xcd - r) * q) + off; }
        const int nig = WGM * nN, gid = wgid / nig, fm = gid * WGM, gsz = (nM - fm) < WGM ? (nM - fm) : WGM;
        u.pm = fm + ((wgid % nig) % gsz); u.pn = (wgid % nig) / gsz; return true;
    }
    __device__ __forceinline__ void a_ready(const Unit&) const {}
    __device__ __forceinline__ void done(const Unit&) const {}
};

__device__ __forceinline__ unsigned cvt_pk_bf16(float lo, float hi) { unsigned r; asm volatile("v_cvt_pk_bf16_f32 %0, %1, %2" : "=v"(r) : "v"(lo), "v"(hi)); return r; }
typedef float f32x2 __attribute__((ext_vector_type(2)));
template <class Epi, class Sched, bool ALIGN_EPI = false, bool SP2 = false>
__device__ __forceinline__ void gemm_phase(PG8_LAS unsigned char* lds, const Gemm g, const Sched& S, const Epi& E) {
    const int tid = threadIdx.x, wid = __builtin_amdgcn_readfirstlane(tid >> 6), lane = tid & 63, wr = wid >> 2, wc = wid & 3, fr = lane & 15, fq = lane >> 4;
    const int K = g.K, nt = K / BK;
    unsigned voffA[2], voffB[2];
#pragma unroll
    for (int i = 0; i < 2; ++i) { int R, C; stage_rc(tid * 16 + i * 8192, R, C); const int Rb = Epi::PERM ? ((R & ~31) + perm32(R & 31)) : R;
        voffA[i] = (unsigned)(R * K + C) * 2u; voffB[i] = (unsigned)(Rb * K + C) * 2u; }
    const size_t kstep = (size_t)(BK * 2);
    const size_t hstep = (size_t)HALF * K * 2;
    const size_t tstep = 2 * hstep;
    const unsigned ldsw = (unsigned)wid * 1024u;
    const int aoff = lds_byte(wr * 64 + fr, fq * 8), boff = lds_byte(wc * 32 + fr, fq * 8);
#define PG8_SA(b, h) (((b) * 2 + (h)) * HTB)
#define PG8_SB(b, h) ((4 + (b) * 2 + (h)) * HTB)
#define PG8_STAGE(bufoff, gbase, voff) do { _Pragma("unroll") for (int _i = 0; _i < 2; ++_i) \
        __builtin_amdgcn_global_load_lds((const unsigned*)((const char*)(gbase) + (voff)[_i]), (PG8_LAS unsigned*)(lds + (bufoff) + ldsw + _i * 8192), 16, 0, 0); } while (0)
#define PG8_LDA(dst, b, h) do { _Pragma("unroll") for (int m = 0; m < 4; ++m) _Pragma("unroll") for (int k = 0; k < 2; ++k) dst[m][k] = *(const PG8_LAS bf16x8*)(lds + PG8_SA(b, h) + aoff + m * 2048 + k * 1024); } while (0)
#define PG8_LDB(dst, b, h) do { _Pragma("unroll") for (int n = 0; n < 2; ++n) _Pragma("unroll") for (int k = 0; k < 2; ++k) dst[n][k] = *(const PG8_LAS bf16x8*)(lds + PG8_SB(b, h) + boff + n * 2048 + k * 1024); } while (0)
#define PG8_MMA(ai, bj, At, Bt) do { __builtin_amdgcn_s_setprio(1); _Pragma("unroll") for (int m = 0; m < 4; ++m) _Pragma("unroll") for (int n = 0; n < 2; ++n) _Pragma("unroll") for (int k = 0; k < 2; ++k) \
        acc[ai][bj][m][n] = __builtin_amdgcn_mfma_f32_16x16x32_bf16(Bt[n][k], At[m][k], acc[ai][bj][m][n], 0, 0, 0); __builtin_amdgcn_s_setprio(0); } while (0)
#define PG8_WAIT_V(n) asm volatile("s_waitcnt vmcnt(" #n ")" ::: "memory")
#define PG8_WAIT_L(n) asm volatile("s_waitcnt lgkmcnt(" #n ")" ::: "memory")
#define PG8_BAR __builtin_amdgcn_s_barrier()
#define PG8_SCHED __builtin_amdgcn_sched_barrier(0)
    Unit cur, nxt; int ui = 0;
    if (!S.next(0, cur)) return;
    f32x4 acc[2][2][4][2];
#pragma unroll
    for (int a = 0; a < 2; ++a)
#pragma unroll
        for (int b = 0; b < 2; ++b)
#pragma unroll
            for (int m = 0; m < 4; ++m)
#pragma unroll
                for (int n = 0; n < 2; ++n) acc[a][b][m][n] = (f32x4){0.f, 0.f, 0.f, 0.f};
    bf16x8 At[4][2], B0[2][2], B1[2][2];
    const char* cA = (const char*)g.A + (size_t)cur.pm * tstep; const char* cB = (const char*)g.Bt + (size_t)cur.pn * tstep;
    S.a_ready(cur);
    if constexpr (SP2) {
        PG8_STAGE(PG8_SB(0, 0), cB, voffB); PG8_STAGE(PG8_SB(0, 1), cB + hstep, voffB); PG8_STAGE(PG8_SA(0, 0), cA, voffA); PG8_STAGE(PG8_SA(0, 1), cA + hstep, voffA);
        if (wr == 1) PG8_BAR;
        PG8_WAIT_V(2); PG8_BAR;
        PG8_STAGE(PG8_SB(1, 0), cB + kstep, voffB); PG8_STAGE(PG8_SA(1, 0), cA + kstep, voffA); PG8_STAGE(PG8_SB(1, 1), cB + hstep + kstep, voffB);
        PG8_WAIT_V(6); PG8_BAR;
    } else {
        PG8_STAGE(PG8_SB(0, 0), cB, voffB); PG8_STAGE(PG8_SA(0, 0), cA, voffA); PG8_STAGE(PG8_SB(0, 1), cB + hstep, voffB); PG8_STAGE(PG8_SA(0, 1), cA + hstep, voffA);
        if (wr == 1) PG8_BAR;
        PG8_WAIT_V(4); PG8_BAR;
        PG8_STAGE(PG8_SB(1, 0), cB + kstep, voffB); PG8_STAGE(PG8_SA(1, 0), cA + kstep, voffA); PG8_STAGE(PG8_SB(1, 1), cB + hstep + kstep, voffB);
        PG8_WAIT_V(6); PG8_BAR;
    }
    for (;;) {
        const bool has_next = S.next(ui + 1, nxt);
        const char* nA = has_next ? (const char*)g.A + (size_t)nxt.pm * tstep : cA; const char* nB = has_next ? (const char*)g.Bt + (size_t)nxt.pn * tstep : cB;
        for (int t = 0; t < nt; t += 2) {
            const bool last = (t == nt - 2);
            const char* a1 = cA + (size_t)(t + 1) * kstep;
            const char* a2 = last ? nA : cA + (size_t)(t + 2) * kstep; const char* b2 = last ? nB : cB + (size_t)(t + 2) * kstep;
            const char* a3 = a2 + kstep; const char* b3 = b2 + kstep;
            if (last && has_next) S.a_ready(nxt);
            if constexpr (SP2) {
            PG8_LDB(B0, 0, 0); PG8_LDB(B1, 0, 1); PG8_SCHED; PG8_LDA(At, 0, 0); PG8_STAGE(PG8_SA(1, 1), a1 + hstep, voffA);
            PG8_WAIT_V(8); PG8_WAIT_L(0); PG8_BAR; PG8_MMA(0, 0, At, B0); PG8_MMA(0, 1, At, B1); PG8_BAR; PG8_SCHED;
            PG8_LDA(At, 0, 1); PG8_STAGE(PG8_SB(0, 0), b2, voffB); PG8_STAGE(PG8_SB(0, 1), b2 + hstep, voffB); PG8_STAGE(PG8_SA(0, 0), a2, voffA);
            PG8_WAIT_V(8); PG8_WAIT_L(0); PG8_BAR; PG8_MMA(1, 0, At, B0); PG8_MMA(1, 1, At, B1); PG8_BAR; PG8_SCHED;
            PG8_LDB(B0, 1, 0); PG8_LDB(B1, 1, 1); PG8_SCHED; PG8_LDA(At, 1, 0); PG8_STAGE(PG8_SA(0, 1), a2 + hstep, voffA);
            PG8_WAIT_V(8); PG8_WAIT_L(0); PG8_BAR; PG8_MMA(0, 0, At, B0); PG8_MMA(0, 1, At, B1); PG8_BAR; PG8_SCHED;
            PG8_LDA(At, 1, 1); PG8_STAGE(PG8_SB(1, 0), b3, voffB); PG8_STAGE(PG8_SB(1, 1), b3 + hstep, voffB); PG8_STAGE(PG8_SA(1, 0), a3, voffA);
            PG8_WAIT_V(8); PG8_WAIT_L(0); PG8_BAR; PG8_MMA(1, 0, At, B0); PG8_MMA(1, 1, At, B1); PG8_BAR; PG8_SCHED;
            } else {
            PG8_LDB(B0, 0, 0); PG8_SCHED; PG8_LDA(At, 0, 0); PG8_STAGE(PG8_SA(1, 1), a1 + hstep, voffA);
            PG8_WAIT_L(8); PG8_BAR; PG8_WAIT_L(0); PG8_MMA(0, 0, At, B0); PG8_BAR; PG8_SCHED;
            PG8_LDB(B1, 0, 1); PG8_STAGE(PG8_SB(0, 0), b2, voffB);
            PG8_BAR; PG8_WAIT_L(0); PG8_MMA(0, 1, At, B1); PG8_BAR;
            PG8_LDA(At, 0, 1); PG8_STAGE(PG8_SA(0, 0), a2, voffA);
            PG8_BAR; PG8_WAIT_L(0); PG8_MMA(1, 0, At, B0); PG8_BAR; PG8_SCHED;
            PG8_STAGE(PG8_SB(0, 1), b2 + hstep, voffB);
            PG8_WAIT_V(6); PG8_BAR; PG8_MMA(1, 1, At, B1); PG8_BAR;
            PG8_LDB(B0, 1, 0); PG8_SCHED; PG8_LDA(At, 1, 0); PG8_STAGE(PG8_SA(0, 1), a2 + hstep, voffA);
            PG8_WAIT_L(8); PG8_BAR; PG8_WAIT_L(0); PG8_MMA(0, 0, At, B0); PG8_BAR; PG8_SCHED;
            PG8_LDB(B1, 1, 1); PG8_STAGE(PG8_SB(1, 0), b3, voffB);
            PG8_BAR; PG8_WAIT_L(0); PG8_MMA(0, 1, At, B1); PG8_BAR;
            PG8_LDA(At, 1, 1); PG8_STAGE(PG8_SA(1, 0), a3, voffA);
            PG8_BAR; PG8_WAIT_L(0); PG8_MMA(1, 0, At, B0); PG8_BAR; PG8_SCHED;
            PG8_STAGE(PG8_SB(1, 1), b3 + hstep, voffB);
            PG8_WAIT_V(6); PG8_BAR; PG8_MMA(1, 1, At, B1); PG8_BAR;
            }
        }
        if constexpr (ALIGN_EPI) { if (wr == 0) PG8_BAR; }
        if constexpr (!Epi::AFTER_DRAIN) { E(acc, cur, wr, wc, fr, fq); S.done(cur); }
        if (!has_next) break;
#pragma unroll
        for (int a = 0; a < 2; ++a)
#pragma unroll
            for (int b = 0; b < 2; ++b)
#pragma unroll
                for (int m = 0; m < 4; ++m)
#pragma unroll
                    for (int n = 0; n < 2; ++n) acc[a][b][m][n] = (f32x4){0.f, 0.f, 0.f, 0.f};
        cur = nxt; cA = nA; cB = nB; ++ui;
        if constexpr (ALIGN_EPI) { if (wr == 1) PG8_BAR; }
    }
    PG8_WAIT_V(0);
    if constexpr (!ALIGN_EPI) { if (wr == 0) PG8_BAR; }
    PG8_BAR;
    if constexpr (Epi::AFTER_DRAIN) { E.fused(acc, cur, wr, wc, fr, fq, lds, wid, lane); S.done(cur); }
#undef PG8_SA
#undef PG8_SB
#undef PG8_STAGE
#undef PG8_LDA
#undef PG8_LDB
#undef PG8_MMA
#undef PG8_WAIT_V
#undef PG8_WAIT_L
#undef PG8_BAR
#undef PG8_SCHED
}
}

constexpr int DM = 1024, NB = 2, SEQ = 8192, CTXL = 256;
constexpr int MLAT = NB * SEQ, MCTX = NB * CTXL, MTOT = MLAT + MCTX;
constexpr int NIN_E = 1792, NIN_O = 2560, DRNN = 1280, DFF = 2816, NEXP = 8, NFF2 = 2 * DFF;
constexpr int COL_V = 512, COL_Q = 1024, COL_K = 1536, COL_VAL = 1664;
constexpr float EPS = 1e-6f, LOG2E = 1.4426950408889634f, QSCALE = 0.125f * LOG2E;
constexpr int MOE_MAXT = 136;
constexpr int MOE_ROWS = MOE_MAXT * 256;

typedef unsigned short bf16;
typedef unsigned v4u __attribute__((ext_vector_type(4)));
typedef unsigned v2u __attribute__((ext_vector_type(2)));
typedef float f32x4 __attribute__((ext_vector_type(4)));
typedef float f32x2 __attribute__((ext_vector_type(2)));
#define GAS __attribute__((address_space(1)))
#define LAS __attribute__((address_space(3)))
typedef GAS unsigned gu32;
#define RLX_AGENT __ATOMIC_RELAXED, __HIP_MEMORY_SCOPE_AGENT
#define LDS_WAIT() asm volatile("s_waitcnt lgkmcnt(0)" ::: "memory")
#define VM_WAIT() asm volatile("s_waitcnt vmcnt(0)" ::: "memory")

__device__ __forceinline__ float bf2f(unsigned short u) { return __builtin_bit_cast(float, (unsigned)u << 16); }
__device__ __forceinline__ float bflo(unsigned u) { return __builtin_bit_cast(float, u << 16); }
__device__ __forceinline__ float bfhi(unsigned u) { return __builtin_bit_cast(float, u & 0xffff0000u); }
__device__ __forceinline__ unsigned pk2(float lo, float hi) { return pg8::cvt_pk_bf16(lo, hi); }
__device__ __forceinline__ unsigned short f2bf1(float x) { return (unsigned short)(pg8::cvt_pk_bf16(x, 0.f) & 0xffffu); }
__device__ __forceinline__ float fexp2(float x) { return __builtin_amdgcn_exp2f(x); }
__device__ __forceinline__ float frcp(float x) { return __builtin_amdgcn_rcpf(x); }
__device__ __forceinline__ float sigmoid_f(float x) { return frcp(1.f + fexp2(-LOG2E * x)); }
__device__ __forceinline__ float silu_f(float x) { return x * sigmoid_f(x); }
__device__ __forceinline__ float gelu_f(float x) { const float u = x * (1.f + 0.044715f * x * x); return x * frcp(1.f + fexp2((-2.f * 0.7978845608028654f * LOG2E) * u)); }
__device__ __forceinline__ f32x4 gelu4(f32x4 v) { return (f32x4){gelu_f(v[0]), gelu_f(v[1]), gelu_f(v[2]), gelu_f(v[3])}; }
__device__ __forceinline__ int ld_i32_agent(const int* p) { return __hip_atomic_load(p, RLX_AGENT); }
__device__ __forceinline__ float wave_sum(float v) {
#pragma unroll
    for (int o = 1; o < 64; o <<= 1) v += __shfl_xor(v, o);
    return v;
}
__device__ __forceinline__ float wave_max(float v) {
#pragma unroll
    for (int o = 1; o < 64; o <<= 1) v = fmaxf(v, __shfl_xor(v, o));
    return v;
}
__device__ __forceinline__ int mod_of_tile(int pm) { return pm < 32 ? 0 : (pm < 64 ? 1 : 2); }
__device__ __forceinline__ int mod_of_row(int r) { return r < SEQ ? 0 : (r < MLAT ? 1 : 2); }

struct EpiInEven {
    static constexpr bool PERM = true, AFTER_DRAIN = false;
    bf16* G1; const float* rope;
    __device__ __forceinline__ void operator()(const pg8::f32x4 (&acc)[2][2][4][2], const pg8::Unit& u, int wr, int wc, int fr, int fq) const {
        const int pn = u.pn; const bool lat = u.pm < 64;
#pragma unroll
        for (int ai = 0; ai < 2; ++ai)
#pragma unroll
            for (int m = 0; m < 4; ++m) {
                const int row = u.pm * 256 + ai * 128 + wr * 64 + m * 16 + fr;
                bf16* rowp = G1 + (size_t)row * NIN_E + pn * 256 + wc * 32 + 8 * fq;
                const int t = row & (SEQ - 1);
#pragma unroll
                for (int bj = 0; bj < 2; ++bj) {
                    f32x4 v0 = acc[ai][bj][m][0], v1 = acc[ai][bj][m][1];
                    if (pn < 4) { v0 = gelu4(v0); v1 = gelu4(v1); }
                    else if (pn < 6 || bj == 0) {
                        if (lat) {
                            const int pos = (wc & 1) ? (t & 63) : (t >> 6);
                            const f32x4* tp = (const f32x4*)(rope + (pos * 16 + 4 * fq) * 2);
                            const f32x4 c0 = tp[0], c1 = tp[1];
                            f32x4 w0, w1;
                            w0[0] = v0[0] * c0[0] - v0[1] * c0[1]; w0[1] = v0[1] * c0[0] + v0[0] * c0[1];
                            w0[2] = v0[2] * c0[2] - v0[3] * c0[3]; w0[3] = v0[3] * c0[2] + v0[2] * c0[3];
                            w1[0] = v1[0] * c1[0] - v1[1] * c1[1]; w1[1] = v1[1] * c1[0] + v1[0] * c1[1];
                            w1[2] = v1[2] * c1[2] - v1[3] * c1[3]; w1[3] = v1[3] * c1[2] + v1[2] * c1[3];
                            v0 = w0; v1 = w1;
                        }
                        if (pn < 6) { v0 = v0 * QSCALE; v1 = v1 * QSCALE; }
                    }
                    v4u w; w.x = pk2(v0[0], v0[1]); w.y = pk2(v0[2], v0[3]); w.z = pk2(v1[0], v1[1]); w.w = pk2(v1[2], v1[3]);
                    *(v4u*)(rowp + bj * 128) = w;
                }
            }
    }
};
struct EpiResid {
    static constexpr bool PERM = true, AFTER_DRAIN = false;
    const float* rin_lat; const float* rin_ctx; float* out_lat; float* out_ctx; const float* gate;
    __device__ __forceinline__ void operator()(const pg8::f32x4 (&acc)[2][2][4][2], const pg8::Unit& u, int wr, int wc, int fr, int fq) const {
        const bool lat = u.pm < 64; const float* g = gate + mod_of_tile(u.pm) * 6144;
        const float* rb = lat ? rin_lat : rin_ctx - (size_t)MLAT * DM; float* ob = lat ? out_lat : out_ctx - (size_t)MLAT * DM;
        const int col0 = u.pn * 256 + wc * 32 + 8 * fq;
        f32x4 gv[2][2];
#pragma unroll
        for (int bj = 0; bj < 2; ++bj)
#pragma unroll
            for (int n = 0; n < 2; ++n) gv[bj][n] = *(const f32x4*)(g + col0 + bj * 128 + 4 * n);
#pragma unroll
        for (int ai = 0; ai < 2; ++ai)
#pragma unroll
            for (int m = 0; m < 4; ++m) {
                const size_t p = (size_t)(u.pm * 256 + ai * 128 + wr * 64 + m * 16 + fr) * DM + col0;
#pragma unroll
                for (int bj = 0; bj < 2; ++bj) {
                    const f32x4 r0 = *(const f32x4*)(rb + p + bj * 128), r1 = *(const f32x4*)(rb + p + bj * 128 + 4);
                    *(f32x4*)(ob + p + bj * 128) = r0 + gv[bj][0] * acc[ai][bj][m][0];
                    *(f32x4*)(ob + p + bj * 128 + 4) = r1 + gv[bj][1] * acc[ai][bj][m][1];
                }
            }
    }
};
struct EpiSwiGLU {
    static constexpr bool PERM = true, AFTER_DRAIN = false;
    bf16* H; int nN;
    __device__ __forceinline__ void operator()(const pg8::f32x4 (&acc)[2][2][4][2], const pg8::Unit& u, int wr, int wc, int fr, int fq) const {
        const int pnl = u.pn % nN, col0 = pnl * 128 + wc * 32 + 8 * fq;
#pragma unroll
        for (int ai = 0; ai < 2; ++ai)
#pragma unroll
            for (int m = 0; m < 4; ++m) {
                const size_t row = (size_t)(u.pm * 256 + ai * 128 + wr * 64 + m * 16 + fr);
                const f32x4 a0 = acc[ai][0][m][0], a1 = acc[ai][0][m][1], b0 = acc[ai][1][m][0], b1 = acc[ai][1][m][1];
                v4u w;
                w.x = pk2(silu_f(a0[0]) * b0[0], silu_f(a0[1]) * b0[1]); w.y = pk2(silu_f(a0[2]) * b0[2], silu_f(a0[3]) * b0[3]);
                w.z = pk2(silu_f(a1[0]) * b1[0], silu_f(a1[1]) * b1[1]); w.w = pk2(silu_f(a1[2]) * b1[2], silu_f(a1[3]) * b1[3]);
                *(v4u*)(H + row * DFF + col0) = w;
            }
    }
};
struct EpiStore {
    static constexpr bool PERM = true, AFTER_DRAIN = false;
    bf16* O; int ldc; int nN; int ngelu;
    __device__ __forceinline__ void operator()(const pg8::f32x4 (&acc)[2][2][4][2], const pg8::Unit& u, int wr, int wc, int fr, int fq) const {
        const int pnl = u.pn % nN, col0 = pnl * 256 + wc * 32 + 8 * fq; const bool g = pnl < ngelu;
#pragma unroll
        for (int ai = 0; ai < 2; ++ai)
#pragma unroll
            for (int m = 0; m < 4; ++m) {
                bf16* rowp = O + (size_t)(u.pm * 256 + ai * 128 + wr * 64 + m * 16 + fr) * ldc + col0;
#pragma unroll
                for (int bj = 0; bj < 2; ++bj) {
                    f32x4 v0 = acc[ai][bj][m][0], v1 = acc[ai][bj][m][1];
                    if (g) { v0 = gelu4(v0); v1 = gelu4(v1); }
                    v4u w; w.x = pk2(v0[0], v0[1]); w.y = pk2(v0[2], v0[3]); w.z = pk2(v1[0], v1[1]); w.w = pk2(v1[2], v1[3]);
                    *(v4u*)(rowp + bj * 128) = w;
                }
            }
    }
};
struct MoeOrder {
    const int* tile_e; int ntiles, nN, G, c;
    __device__ __forceinline__ bool next(int i, pg8::Unit& u) const {
        const long L = (long)i * G + c; if (L >= (long)ntiles * nN) return false;
        const int pm = (int)(L / nN), pn = (int)(L % nN);
        u.pm = pm; u.pn = __builtin_amdgcn_readfirstlane(ld_i32_agent(tile_e + pm)) * nN + pn; return true;
    }
    __device__ __forceinline__ void a_ready(const pg8::Unit&) const {}
    __device__ __forceinline__ void done(const pg8::Unit&) const {}
};
#define XB_TMO      128
#define XB_XCNT(j)  (256  + 64 * (j))
#define XB_XSUB(j)  (1280 + 64 * (j))
#define XB_XGEN(j)  (2304 + 64 * (j))
#define XB_TOP      3328
#define XB_TOPGEN   3392
#define XCD_BAR_WORDS 3456
#define XB_SPIN_CAP (1u << 18)

__device__ __forceinline__ unsigned xb_ld(unsigned* p)              { return __hip_atomic_load(p, __ATOMIC_RELAXED, __HIP_MEMORY_SCOPE_AGENT); }
__device__ __forceinline__ unsigned xb_add(unsigned* p, unsigned v) { return __hip_atomic_fetch_add(p, v, __ATOMIC_RELAXED, __HIP_MEMORY_SCOPE_AGENT); }
__device__ __forceinline__ unsigned xb_xcc_id() { return (unsigned)__builtin_amdgcn_s_getreg((3 << 11) | 20) & 0xFu; }
#define XB_SPIN(cond, bar) do { unsigned _sp = 0; while (cond) { __builtin_amdgcn_s_sleep(1); \
    if ((++_sp & 255u) == 0u) { if (xb_ld(&(bar)[XB_TMO])) break; if (_sp > XB_SPIN_CAP) { atomicAdd(&(bar)[XB_TMO], 1u); break; } } } } while (0)

struct XcdBarrier {
    unsigned* bar; unsigned x;
    volatile LAS unsigned* st;
};

__device__ __forceinline__ XcdBarrier xcd_barrier_post(unsigned* bar, volatile LAS unsigned* st) {
    XcdBarrier b; b.bar = bar; b.x = xb_xcc_id(); b.st = st;
    if (threadIdx.x == 0) (void)xb_add(&bar[XB_XCNT(b.x)], 1u);
    return b;
}
__device__ __forceinline__ void xcd_barrier_complete(unsigned* bar, unsigned x, unsigned& nloc, unsigned& nx) {
    const unsigned G = gridDim.x * gridDim.y * gridDim.z;
    unsigned sum, cnt, mine, sp = 0u;
    for (;;) {
        sum = 0u; cnt = 0u; mine = 0u;
#pragma unroll
        for (unsigned j = 0; j < 16; ++j) { const unsigned c = xb_ld(&bar[XB_XCNT(j)]); sum += c; cnt += (c > 0u) ? 1u : 0u; mine = (j == x) ? c : mine; }
        if (sum == G) break;
        __builtin_amdgcn_s_sleep(1);
        if ((++sp & 255u) == 0u) { if (xb_ld(&bar[XB_TMO])) break; if (sp > XB_SPIN_CAP) { atomicAdd(&bar[XB_TMO], 1u); break; } }
    }
    nloc = mine > 0u ? mine : 1u; nx = cnt > 0u ? cnt : 1u;
}

__device__ __forceinline__ void xcd_barrier(const XcdBarrier& b) {
    asm volatile("s_waitcnt vmcnt(0)" ::: "memory");
    __syncthreads();
    if (threadIdx.x == 0) {
        unsigned* bar = b.bar;
        __builtin_amdgcn_s_waitcnt(0);
        unsigned nloc = b.st[0], nx = b.st[1];
        if (nloc == 0u) { xcd_barrier_complete(bar, b.x, nloc, nx); b.st[0] = nloc; b.st[1] = nx; }
        const unsigned old = xb_add(&bar[XB_XSUB(b.x)], 1u);
        const unsigned gen = old / nloc;
        if (old + 1u == (gen + 1u) * nloc) {
            __builtin_amdgcn_fence(__ATOMIC_RELEASE, "agent");
            asm volatile("s_waitcnt vmcnt(0)" ::: "memory");
            const unsigned og = xb_add(&bar[XB_TOP], 1u);
            const unsigned tg = og / nx;
            if (og + 1u == (tg + 1u) * nx) xb_add(&bar[XB_TOPGEN], 1u);
            else XB_SPIN(xb_ld(&bar[XB_TOPGEN]) == tg, bar);
            __builtin_amdgcn_fence(__ATOMIC_ACQUIRE, "agent");
            xb_add(&bar[XB_XGEN(b.x)], 1u);
            asm volatile("s_waitcnt vmcnt(0)" ::: "memory");
        } else {
            XB_SPIN(xb_ld(&bar[XB_XGEN(b.x)]) == gen, bar);
            __builtin_amdgcn_fence(__ATOMIC_ACQUIRE, "agent");
            asm volatile("s_waitcnt vmcnt(0)" ::: "memory");
        }
    }
    __syncthreads();
}

constexpr size_t MiB = 1u << 20;
constexpr size_t WS_CTL = 0, CTL_ZERO_BYTES = 1 * MiB;
constexpr size_t WS_MOD = 1 * MiB;
constexpr size_t WS_ROPE = 1 * MiB + 256 * 1024;
constexpr size_t WS_TOKE = 1 * MiB + 512 * 1024;
constexpr size_t WS_TOKG = WS_TOKE + 128 * 1024;
constexpr size_t WS_TOKR = WS_TOKG + 128 * 1024;
constexpr size_t WS_META = 2 * MiB;
constexpr size_t WS_SA = 2 * MiB + 256 * 1024, WS_SH = 3 * MiB;
constexpr size_t WS_LW = 34 * MiB + 512 * 1024;
constexpr size_t WS_WINE = 4 * MiB, WS_WOUTE = 8 * MiB, WS_FFN13 = 10 * MiB, WS_FFN2 = 21 * MiB, WS_WINO = 27 * MiB, WS_WOUTO = 32 * MiB;
constexpr size_t WS_MOE13 = 36 * MiB, WS_MOE2 = 124 * MiB;
constexpr size_t WS_H = 168 * MiB;
constexpr size_t WS_G1 = 201 * MiB;
constexpr size_t WS_MIX = 259 * MiB;
constexpr size_t WS_XC = 292 * MiB;
constexpr size_t WS_FH = 294 * MiB;
constexpr size_t WS_G2 = 201 * MiB;
constexpr size_t WS_Y1 = 284 * MiB;
constexpr size_t WS_LAF = 36 * MiB, WS_BBF = 78 * MiB, WS_LAB = 120 * MiB, WS_BBB = 324 * MiB, WS_HF = 366 * MiB;
constexpr size_t WS_HP = 168 * MiB;
constexpr size_t WS_MH = 236 * MiB;
constexpr size_t WS_YD = 36 * MiB;
constexpr size_t WS_NEED = 424 * MiB;
constexpr int CW_CNT = 64;
constexpr int CW_BAR = 4096;

constexpr int RING_BYTES = 143360, LDSCTL_OFF = RING_BYTES, MISC_OFF = LDSCTL_OFF + 320, LDS_BYTES = 147456;
constexpr int NWAVES = 8, NTHR = 512;

enum Phase { PH_PRO = 0, PH_NORM1E, PH_GIN_E, PH_MIX_E, PH_GOUT_E, PH_NORM2E, PH_FFN_UP, PH_FFN_DN, PH_NORM1O, PH_GIN_O, PH_LRU_G, PH_LRU_S, PH_GOUT_O, PH_ROUTE, PH_CVT_MOE, PH_PERM,
             PH_MOE_UP, PH_MOE_DN, PH_COMB, NPH };
#ifndef MK_ONE_LAUNCH
#define MK_ONE_LAUNCH 1
#endif

struct Args { const float* in[34]; float* out; unsigned char* ws; int ph_lo, ph_hi; };
struct Frame {
    LAS unsigned char* lds; volatile LAS unsigned* MISC; gu32* ctl;
    int tid, lane, wave, vcu, G;
};

struct MapId { __device__ __forceinline__ int operator()(int n) const { return n; } };
struct MapRope {
    __device__ __forceinline__ int operator()(int n) const {
        if (n < COL_Q || n >= COL_VAL) return n;
        const int base = n < COL_K ? COL_Q : COL_K, r = n - base, h = r >> 6, d = r & 63;
        return base + h * 64 + (d & 32) + 2 * (d & 15) + ((d >> 4) & 1);
    }
};
struct MapGLU { int off; __device__ __forceinline__ int operator()(int n) const { return (n >> 7) * 256 + off + (n & 127); } };

template <class RowMap>
__device__ __forceinline__ void tr_item(const float* W, int K, int N, bf16* WT, LAS float* scr, int item, int lane, RowMap rm) {
    const int nblk = N / 32, kb = item / nblk, nb = item % nblk, k0 = 64 * kb, n0 = 32 * nb;
#pragma unroll 8
    for (int i = 0; i < 32; ++i) { const int kk = 2 * i + (lane >> 5); scr[kk * 33 + (lane & 31)] = W[(size_t)(k0 + kk) * N + n0 + (lane & 31)]; }
    LDS_WAIT(); asm volatile("" ::: "memory");
    const int c = lane & 7;
#pragma unroll
    for (int j = 0; j < 4; ++j) { const int n = (lane >> 3) + 8 * j; const LAS float* s = scr + (8 * c) * 33 + n;
        v4u o; o.x = pk2(s[0 * 33], s[1 * 33]); o.y = pk2(s[2 * 33], s[3 * 33]); o.z = pk2(s[4 * 33], s[5 * 33]); o.w = pk2(s[6 * 33], s[7 * 33]);
        *(GAS v4u*)(WT + (size_t)rm(n0 + n) * K + k0 + 8 * c) = o; }
    LDS_WAIT(); asm volatile("" ::: "memory");
}

__device__ __forceinline__ void ph_prologue(const Args& A, Frame& F) {
    unsigned char* ws = A.ws;
    LAS float* sact = (LAS float*)F.lds;
    LAS float* red = sact + 3 * 1024;
    for (int t = F.tid; t < 3 * 1024; t += NTHR) { const int v = t >> 10, k = t & 1023; const float x = v < 2 ? A.in[1][v * 1024 + k] : A.in[3][k]; sact[t] = silu_f(x); }
    __syncthreads();
    float* mod = (float*)(ws + WS_MOD);
    for (int item = blockIdx.x; item < 256; item += F.G) {
        const int L = item >> 7, ch = item & 127; const float* W = (L ? A.in[16] : A.in[4]) + ch * 48; const float* bias = (L ? A.in[17] : A.in[5]);
        if (F.tid < 504) {
            const int c4 = F.tid % 12, ks = F.tid / 12; f32x4 a0 = {0.f, 0.f, 0.f, 0.f}, a1 = a0, a2 = a0;
            for (int k = ks; k < 1024; k += 42) { const f32x4 w = *(const f32x4*)(W + (size_t)k * 6144 + c4 * 4); a0 += sact[k] * w; a1 += sact[1024 + k] * w; a2 += sact[2048 + k] * w; }
            LAS float* r = red + ks * 144 + c4 * 4;
#pragma unroll
            for (int j = 0; j < 4; ++j) { r[j] = a0[j]; r[48 + j] = a1[j]; r[96 + j] = a2[j]; }
        }
        __syncthreads();
        if (F.tid < 144) { const int v = F.tid / 48, cc = F.tid % 48, n = ch * 48 + cc; float s = 0.f; for (int ks = 0; ks < 42; ++ks) s += red[ks * 144 + F.tid]; mod[(L * 3 + v) * 6144 + n] = s + bias[n]; }
        __syncthreads();
    }
    { const int idx = blockIdx.x * NTHR + F.tid; if (idx < 128 * 16) { const int pos = idx >> 4, f = idx & 15; const float freq = fexp2(-(float)f * (13.287712379549449f / 16.f)); const float rev = (float)pos * freq * 0.15915494309189535f;
        float* rp = (float*)(ws + WS_ROPE) + idx * 2; rp[0] = __builtin_amdgcn_cosf(rev); rp[1] = __builtin_amdgcn_sinf(rev); } }
    LAS float* scr = (LAS float*)(F.lds + F.wave * 16384);
    const int gw = F.vcu * NWAVES + F.wave, NGW = F.G * NWAVES;
    constexpr int I_WINE = 16 * 56, I_WOUTE = 16 * 32, I_F1 = 16 * 88, I_F2 = 44 * 32, I_WINO = 16 * 80, I_WOUTO = 20 * 32;
    constexpr int I_LW = 2 * 20 * 8;
    constexpr int NITEMS = I_WINE + I_WOUTE + 2 * I_F1 + I_F2 + I_WINO + I_WOUTO + I_LW;
    for (int it = gw; it < NITEMS; it += NGW) {
        int r = it;
        if (r < I_WINE) { tr_item(A.in[8], DM, NIN_E, (bf16*)(ws + WS_WINE), scr, r, F.lane, MapRope{}); continue; } r -= I_WINE;
        if (r < I_WOUTE) { tr_item(A.in[12], DM, DM, (bf16*)(ws + WS_WOUTE), scr, r, F.lane, MapId{}); continue; } r -= I_WOUTE;
        if (r < I_F1) { tr_item(A.in[13], DM, DFF, (bf16*)(ws + WS_FFN13), scr, r, F.lane, MapGLU{0}); continue; } r -= I_F1;
        if (r < I_F1) { tr_item(A.in[14], DM, DFF, (bf16*)(ws + WS_FFN13), scr, r, F.lane, MapGLU{128}); continue; } r -= I_F1;
        if (r < I_F2) { tr_item(A.in[15], DFF, DM, (bf16*)(ws + WS_FFN2), scr, r, F.lane, MapId{}); continue; } r -= I_F2;
        if (r < I_WINO) { tr_item(A.in[20], DM, NIN_O, (bf16*)(ws + WS_WINO), scr, r, F.lane, MapId{}); continue; } r -= I_WINO;
        if (r < I_WOUTO) { tr_item(A.in[28], DRNN, DM, (bf16*)(ws + WS_WOUTO), scr, r, F.lane, MapId{}); continue; } r -= I_WOUTO;
        { const int g = r / 160, mi = (r % 160) / 8, item = r % 8, dd = mi / 10, blk = mi % 10;
          tr_item(A.in[g ? 25 : 23] + (size_t)mi * 16384, 128, 128, (bf16*)(ws + WS_LW) + (size_t)((dd * 2 + g) * 10 + blk) * 16384, scr, item, F.lane, MapId{}); }
    }
}
__device__ __forceinline__ void ph_convert_moe(const Args& A, Frame& F) {
    unsigned char* ws = A.ws;
    LAS float* scr = (LAS float*)(F.lds + F.wave * 16384);
    const int gw = F.vcu * NWAVES + F.wave, NGW = F.G * NWAVES;
    constexpr int I_F1 = 16 * 88, I_F2 = 44 * 32, PER_E = 2 * I_F1 + I_F2;
    for (int it = gw; it < NEXP * PER_E; it += NGW) {
        const int e = it / PER_E; int r = it % PER_E;
        bf16* w13 = (bf16*)(ws + WS_MOE13) + (size_t)e * NFF2 * DM; bf16* w2 = (bf16*)(ws + WS_MOE2) + (size_t)e * DM * DFF;
        if (r < I_F1) { tr_item(A.in[30] + (size_t)e * DM * DFF, DM, DFF, w13, scr, r, F.lane, MapGLU{0}); continue; } r -= I_F1;
        if (r < I_F1) { tr_item(A.in[31] + (size_t)e * DM * DFF, DM, DFF, w13, scr, r, F.lane, MapGLU{128}); continue; } r -= I_F1;
        tr_item(A.in[32] + (size_t)e * DFF * DM, DFF, DM, w2, scr, r, F.lane, MapId{});
    }
}

__device__ __forceinline__ void norm_mod_regs(const float* xrow, const float* gain, const float* scale, const float* shift, int lane, f32x4 (&v)[4]) {
    const f32x4* xr = (const f32x4*)xrow + lane; float ss = 0.f;
#pragma unroll
    for (int j = 0; j < 4; ++j) { v[j] = xr[64 * j]; ss += (v[j][0] * v[j][0] + v[j][1] * v[j][1]) + (v[j][2] * v[j][2] + v[j][3] * v[j][3]); }
    const float rstd = 1.f / sqrtf(wave_sum(ss) * (1.f / DM) + EPS);
#pragma unroll
    for (int j = 0; j < 4; ++j) { const f32x4 g = ((const f32x4*)gain)[lane + 64 * j], sc = ((const f32x4*)scale)[lane + 64 * j], sh = ((const f32x4*)shift)[lane + 64 * j];
        v[j] = v[j] * rstd * g * (1.f + sc) + sh; }
}
__device__ __forceinline__ void ph_norm(Frame& F, const float* xl, const float* xc, const float* gain, const float* modL, int p_shift, int p_scale, bf16* H, int nrows) {
    const int gw = F.vcu * NWAVES + F.wave, NGW = F.G * NWAVES;
    for (int r = gw; r < nrows; r += NGW) {
        const float* md = modL + mod_of_row(r) * 6144; const float* xrow = r < MLAT ? xl + (size_t)r * DM : xc + (size_t)(r - MLAT) * DM;
        f32x4 v[4]; norm_mod_regs(xrow, gain, md + p_scale * 1024, md + p_shift * 1024, F.lane, v);
        GAS v2u* o = (GAS v2u*)(H + (size_t)r * DM) + F.lane;
#pragma unroll
        for (int j = 0; j < 4; ++j) { v2u w; w.x = pk2(v[j][0], v[j][1]); w.y = pk2(v[j][2], v[j][3]); o[64 * j] = w; }
    }
}

__device__ __forceinline__ void ph_attn_simple(const Args& A, Frame& F) {
    const bf16* G1 = (const bf16*)(A.ws + WS_G1); bf16* MIX = (bf16*)(A.ws + WS_MIX); const float* sink = A.in[11];
    LAS float* wq = (LAS float*)(F.lds + F.wave * 4096); LAS float* wp = wq + 64;
    const int gw = F.vcu * NWAVES + F.wave, NGW = F.G * NWAVES, lane = F.lane;
    for (int it = gw; it < MTOT * 8; it += NGW) {
        const int row = it >> 3, h = it & 7, kvh = h >> 2; const bool lat = row < MLAT;
        const int b = lat ? (row >> 13) : ((row - MLAT) >> 8), t = row & (SEQ - 1);
        wq[lane] = bf2f(G1[(size_t)row * NIN_E + COL_Q + h * 64 + lane]);
        LDS_WAIT();
        const float sk = sink[h] * LOG2E;
        float sc[9]; float mx = sk;
#pragma unroll
        for (int i = 0; i < 9; ++i) {
            const int s = lane + 64 * i; bool valid; int krow;
            if (lat) { if (s < 257) { const int j = t - 128 + s; valid = (j >= 0) && (j < SEQ); krow = b * SEQ + j; } else { valid = s < 513; krow = MLAT + b * CTXL + (s - 257); } }
            else { valid = s < CTXL; krow = MLAT + b * CTXL + s; }
            float d = -INFINITY;
            if (valid) { const v4u* kp = (const v4u*)(G1 + (size_t)krow * NIN_E + COL_K + kvh * 64); d = 0.f;
#pragma unroll
                for (int c = 0; c < 8; ++c) { const v4u kk = kp[c]; const LAS float* q = wq + 8 * c;
                    d += bflo(kk.x) * q[0] + bfhi(kk.x) * q[1] + bflo(kk.y) * q[2] + bfhi(kk.y) * q[3] + bflo(kk.z) * q[4] + bfhi(kk.z) * q[5] + bflo(kk.w) * q[6] + bfhi(kk.w) * q[7]; } }
            sc[i] = d; mx = fmaxf(mx, d);
        }
        mx = wave_max(mx);
        float sum = 0.f;
#pragma unroll
        for (int i = 0; i < 9; ++i) { const float p = fexp2(sc[i] - mx); wp[lane + 64 * i] = p; sum += p; }
        sum = wave_sum(sum) + fexp2(sk - mx);
        LDS_WAIT();
        float o = 0.f;
        const bf16* vb = G1 + COL_VAL + kvh * 64 + lane;
        if (lat) {
            const int s_lo = (128 - t) > 0 ? (128 - t) : 0, s_hi = (SEQ - 1 - t + 128) < 256 ? (SEQ - 1 - t + 128) : 256;
#pragma unroll 8
            for (int s = s_lo; s <= s_hi; ++s) o += wp[s] * bf2f(vb[(size_t)(b * SEQ + t - 128 + s) * NIN_E]);
#pragma unroll 8
            for (int s = 0; s < CTXL; ++s) o += wp[257 + s] * bf2f(vb[(size_t)(MLAT + b * CTXL + s) * NIN_E]);
        } else {
#pragma unroll 8
            for (int s = 0; s < CTXL; ++s) o += wp[s] * bf2f(vb[(size_t)(MLAT + b * CTXL + s) * NIN_E]);
        }
        MIX[(size_t)row * DM + 512 + h * 64 + lane] = f2bf1(o / sum);
        LDS_WAIT();
    }
}
__device__ __forceinline__ void ph_sgu_simple(const Args& A, Frame& F) {
    const bf16* G1 = (const bf16*)(A.ws + WS_G1); bf16* MIX = (bf16*)(A.ws + WS_MIX); const float* sgw = A.in[9]; const float* sgb = A.in[10];
    LAS float* vn = (LAS float*)F.lds;
    for (int item = blockIdx.x; item < (MTOT / 128) * 4; item += F.G) {
        const int chunk = item >> 2, g = item & 3, row0 = chunk * 128;
        for (int i = 0; i < 16; ++i) { const int q = F.wave * 16 + i;
            const unsigned u = ((const unsigned*)(G1 + (size_t)(row0 + q) * NIN_E + COL_V + g * 128))[F.lane];
            const float x0 = bflo(u), x1 = bfhi(u); const float mean = wave_sum(x0 + x1) * (1.f / 128.f); const float d0 = x0 - mean, d1 = x1 - mean;
            const float var = wave_sum(d0 * d0 + d1 * d1) * (1.f / 128.f); const float rs = 1.f / sqrtf(var + EPS);
            vn[q * 128 + 2 * F.lane] = d0 * rs; vn[q * 128 + 2 * F.lane + 1] = d1 * rs; }
        __syncthreads();
        const int c = F.tid & 127, pb = F.tid >> 7;
        for (int i = 0; i < 32; ++i) { const int p = pb + 4 * i; const float* wrow = sgw + (size_t)(g * 128 + p) * 128; float acc = 0.f;
#pragma unroll 8
            for (int q = 0; q < 128; ++q) acc += wrow[q] * vn[q * 128 + c];
            const float uu = bf2f(G1[(size_t)(row0 + p) * NIN_E + g * 128 + c]);
            MIX[(size_t)(row0 + p) * DM + g * 128 + c] = f2bf1(uu * (acc + sgb[g * 128 + p])); }
        __syncthreads();
    }
}
__device__ __forceinline__ void route_row(const Args& A, Frame& F, const LAS float* rw, int t, f32x4 (&v)[4], float (&lg)[8]) {
    const float* md = (const float*)(A.ws + WS_MOD) + (3 + (t >> 13)) * 6144;
    norm_mod_regs(A.out + (size_t)t * DM, A.in[19], md + 4 * 1024, md + 3 * 1024, F.lane, v);
#pragma unroll
    for (int e = 0; e < 8; ++e) lg[e] = 0.f;
#pragma unroll
    for (int j = 0; j < 4; ++j)
#pragma unroll
        for (int i = 0; i < 4; ++i) { const int k = 4 * (F.lane + 64 * j) + i; const f32x4 w0 = *(const LAS f32x4*)(rw + k * 8), w1 = *(const LAS f32x4*)(rw + k * 8 + 4); const float x = v[j][i];
            lg[0] += x * w0[0]; lg[1] += x * w0[1]; lg[2] += x * w0[2]; lg[3] += x * w0[3]; lg[4] += x * w1[0]; lg[5] += x * w1[1]; lg[6] += x * w1[2]; lg[7] += x * w1[3]; }
#pragma unroll
    for (int e = 0; e < 8; ++e) lg[e] = wave_sum(lg[e]);
}
__device__ __forceinline__ void ph_route(const Args& A, Frame& F) {
    LAS float* rw = (LAS float*)F.lds;
    for (int i = F.tid; i < DM * 8; i += NTHR) rw[i] = A.in[29][i];
    __syncthreads();
    int* toke = (int*)(A.ws + WS_TOKE); float* tokg = (float*)(A.ws + WS_TOKG); int* tokr = (int*)(A.ws + WS_TOKR);
    const int gw = F.vcu * NWAVES + F.wave, NGW = F.G * NWAVES;
    for (int t = gw; t < MLAT; t += NGW) {
        f32x4 v[4]; float lg[8]; route_row(A, F, rw, t, v, lg);
        int i0 = 0; float l0 = lg[0];
#pragma unroll
        for (int e = 1; e < 8; ++e) if (lg[e] > l0) { l0 = lg[e]; i0 = e; }
        int i1 = -1; float l1 = -INFINITY;
#pragma unroll
        for (int e = 0; e < 8; ++e) if (e != i0 && lg[e] > l1) { l1 = lg[e]; i1 = e; }
        const float g0 = 1.f / (1.f + expf(l1 - l0)), g1 = 1.f - g0;
        if (F.lane == 0) {
            const int r0 = (int)__hip_atomic_fetch_add((unsigned*)(F.ctl + CW_CNT + 16 * i0), 1u, RLX_AGENT), r1 = (int)__hip_atomic_fetch_add((unsigned*)(F.ctl + CW_CNT + 16 * i1), 1u, RLX_AGENT);
            toke[t] = i0; toke[MLAT + t] = i1; tokg[t] = g0; tokg[MLAT + t] = g1; tokr[t] = r0; tokr[MLAT + t] = r1;
        }
    }
}
__device__ __forceinline__ void ph_permute(const Args& A, Frame& F) {
    int* toke = (int*)(A.ws + WS_TOKE); int* tokr = (int*)(A.ws + WS_TOKR); int* meta = (int*)(A.ws + WS_META); bf16* HP = (bf16*)(A.ws + WS_HP);
    int off[8]; int tot = 0;
#pragma unroll
    for (int e = 0; e < 8; ++e) { const int c = (int)__hip_atomic_load((unsigned*)(F.ctl + CW_CNT + 16 * e), RLX_AGENT); off[e] = tot; tot += ((c + 255) >> 8) << 8; }
    if (blockIdx.x == 0 && F.tid < MOE_MAXT + 8) { int e = 0;
#pragma unroll
        for (int k = 1; k < 8; ++k) if (F.tid * 256 >= off[k]) e = k;
        meta[F.tid] = e; if (F.tid == 0) meta[256] = tot >> 8; }
    const int gw = F.vcu * NWAVES + F.wave, NGW = F.G * NWAVES;
    for (int t = gw; t < MLAT; t += NGW) {
        const float* md = (const float*)(A.ws + WS_MOD) + (3 + (t >> 13)) * 6144;
        f32x4 v[4]; norm_mod_regs(A.out + (size_t)t * DM, A.in[19], md + 4 * 1024, md + 3 * 1024, F.lane, v);
        const int e0 = toke[t], e1 = toke[MLAT + t]; int s0 = tokr[t], s1 = tokr[MLAT + t];
        int o0 = 0, o1 = 0;
#pragma unroll
        for (int k = 0; k < 8; ++k) { if (k == e0) o0 = off[k]; if (k == e1) o1 = off[k]; }
        s0 += o0; s1 += o1;
        GAS v2u* p0 = (GAS v2u*)(HP + (size_t)s0 * DM) + F.lane; GAS v2u* p1 = (GAS v2u*)(HP + (size_t)s1 * DM) + F.lane;
#pragma unroll
        for (int j = 0; j < 4; ++j) { v2u w; w.x = pk2(v[j][0], v[j][1]); w.y = pk2(v[j][2], v[j][3]); p0[64 * j] = w; p1[64 * j] = w; }
        if (F.lane == 0) { tokr[t] = s0; tokr[MLAT + t] = s1; }
    }
}
__device__ __forceinline__ void ph_combine(const Args& A, Frame& F) {
    const float* tokg = (const float*)(A.ws + WS_TOKG); const int* tokr = (const int*)(A.ws + WS_TOKR); const bf16* YD = (const bf16*)(A.ws + WS_YD); const float* fn = A.in[33];
    const int gw = F.vcu * NWAVES + F.wave, NGW = F.G * NWAVES;
    for (int t = gw; t < MLAT; t += NGW) {
        const float* g2 = (const float*)(A.ws + WS_MOD) + (3 + (t >> 13)) * 6144 + 5 * 1024;
        const int s0 = tokr[t], s1 = tokr[MLAT + t]; const float g0 = tokg[t], g1 = tokg[MLAT + t];
        f32x4* xr = (f32x4*)(A.out + (size_t)t * DM) + F.lane; const v2u* y0 = (const v2u*)(YD + (size_t)s0 * DM) + F.lane; const v2u* y1 = (const v2u*)(YD + (size_t)s1 * DM) + F.lane;
        f32x4 z[4]; float ss = 0.f;
#pragma unroll
        for (int j = 0; j < 4; ++j) { const f32x4 x = xr[64 * j], g = ((const f32x4*)g2)[F.lane + 64 * j]; const v2u a = y0[64 * j], b = y1[64 * j];
            f32x4 m; m[0] = g0 * bflo(a.x) + g1 * bflo(b.x); m[1] = g0 * bfhi(a.x) + g1 * bfhi(b.x); m[2] = g0 * bflo(a.y) + g1 * bflo(b.y); m[3] = g0 * bfhi(a.y) + g1 * bfhi(b.y);
            z[j] = x + g * m; ss += (z[j][0] * z[j][0] + z[j][1] * z[j][1]) + (z[j][2] * z[j][2] + z[j][3] * z[j][3]); }
        const float rstd = 1.f / sqrtf(wave_sum(ss) * (1.f / DM) + EPS);
#pragma unroll
        for (int j = 0; j < 4; ++j) xr[64 * j] = z[j] * rstd * ((const f32x4*)fn)[F.lane + 64 * j];
    }
}

constexpr int RCP = 272, HFL_OFF = 256 * RCP;
__device__ __forceinline__ void lru_ab(float rp, float ip, float rcv, float nba, float nbx, float kc, float& a, float& b) {
    const float rg = frcp(1.f + fexp2(fmaf(rp, -LOG2E, nba)));
    const float ig = frcp(1.f + fexp2(fmaf(ip, -LOG2E, nbx)));
    const float la = kc * rg;
    a = fexp2(la * LOG2E);
    const float x = 2.f * la;
    const float om = -x * (1.f + x * (0.5f + x * (0.16666667f + x * (0.041666668f + x * (0.008333334f + x * 0.0013888889f)))));
    b = __builtin_amdgcn_sqrtf(om) * (ig * rcv);
}
template <bool PASS3>
__device__ __forceinline__ void lru_unit(const Args& A, Frame& F, int pm, int blk) {
    const bf16* G2 = (const bf16*)(A.ws + WS_G2);
    LAS unsigned char* rcT = F.lds;
    const int r0 = pm * 256, lane = F.lane, w = F.wave, c = lane & 15, q = lane >> 4;
    int seg_lo, seg_hi; if (pm < 64) { seg_lo = (pm >> 5) * SEQ; seg_hi = seg_lo + SEQ; } else { seg_lo = r0; seg_hi = r0 + 256; }
    {
        const int c8 = F.tid & 15, rgp = F.tid >> 4, ch0 = blk * 128 + c8 * 8;
        const float* cw = A.in[21]; const float* cb = A.in[22];
        f32x4 wj[4][2], cbv[2];
#pragma unroll
        for (int j = 0; j < 4; ++j) { wj[j][0] = *(const f32x4*)(cw + j * DRNN + ch0); wj[j][1] = *(const f32x4*)(cw + j * DRNN + ch0 + 4); }
        cbv[0] = *(const f32x4*)(cb + ch0); cbv[1] = *(const f32x4*)(cb + ch0 + 4);
        v4u x[11];
#pragma unroll
        for (int i = 0; i < 11; ++i) { const int grow = r0 + rgp * 8 + i - 2; const bool ok = (grow >= seg_lo) && (grow < seg_hi); const int gc = grow < seg_lo ? seg_lo : (grow >= seg_hi ? seg_hi - 1 : grow);
            const v4u t = *(const v4u*)(G2 + (size_t)gc * NIN_O + DRNN + ch0); x[i].x = ok ? t.x : 0u; x[i].y = ok ? t.y : 0u; x[i].z = ok ? t.z : 0u; x[i].w = ok ? t.w : 0u; }
#pragma unroll
        for (int r = 0; r < 8; ++r) { f32x4 o0 = cbv[0], o1 = cbv[1];
#pragma unroll
            for (int j = 0; j < 4; ++j) { const v4u t = x[r + j]; o0 += wj[j][0] * (f32x4){bflo(t.x), bfhi(t.x), bflo(t.y), bfhi(t.y)}; o1 += wj[j][1] * (f32x4){bflo(t.z), bfhi(t.z), bflo(t.w), bfhi(t.w)}; }
            v4u pk; pk.x = pk2(o0[0], o0[1]); pk.y = pk2(o0[2], o0[3]); pk.z = pk2(o1[0], o1[1]); pk.w = pk2(o1[2], o1[3]);
            *(LAS v4u*)(rcT + (rgp * 8 + r) * RCP + c8 * 16) = pk; }
    }
    __syncthreads();
    const int ch = blk * 128 + 16 * w + c;
    float* SA = (float*)(A.ws + WS_SA); float* SH = (float*)(A.ws + WS_SH);
    pg8::bf16x8 Bid;
#pragma unroll
    for (int e = 0; e < 8; ++e) Bid[e] = (8 * q + e == (w & 1) * 16 + c) ? (short)0x3F80 : (short)0;
    float cin = 0.f;
    if (PASS3) {
        const int d = (lane >> 4) & 1, b = pm >> 5; const int chc = blk * 128 + 16 * w + (lane & 15);
#pragma unroll 11
        for (int s = 0; s < 33; ++s) {
            int T; bool ok;
            if (s == 0) { T = 64 + b; ok = true; } else if (d == 0) { T = 32 * b + s - 1; ok = T < pm; } else { T = 32 * b + 32 - s; ok = T > pm; }
            const int Tc = ok ? T : pm;
            const float av = SA[(size_t)(Tc * 2 + d) * DRNN + chc], hv = SH[(size_t)(Tc * 2 + d) * DRNN + chc];
            if (ok) cin = av * cin + hv;
        }
    }
    LAS unsigned* hfl = (LAS unsigned*)(F.lds + HFL_OFF + w * 8192) + lane;
    bf16* Y1 = (bf16*)(A.ws + WS_Y1);
#pragma unroll
    for (int d = 0; d < 2; ++d) {
        const float nba = -LOG2E * A.in[24][d * DRNN + ch], nbx = -LOG2E * A.in[26][d * DRNN + ch], kc = -8.f * log1pf(expf(-A.in[27][d * DRNN + ch]));
        pg8::bf16x8 Bw[2][4];
        { const bf16* LW = (const bf16*)(A.ws + WS_LW);
#pragma unroll
          for (int g = 0; g < 2; ++g)
#pragma unroll
            for (int ks = 0; ks < 4; ++ks) Bw[g][ks] = *(const pg8::bf16x8*)(LW + (size_t)((d * 2 + g) * 10 + blk) * 16384 + (16 * w + c) * 128 + ks * 32 + 8 * q); }
        float a_run = 1.f, h_run = PASS3 ? __shfl(cin, d * 16 + c) : 0.f;
#pragma unroll 1
        for (int gi = 0; gi < 4; ++gi) {
            const int g4 = d == 0 ? gi : 3 - gi;
            float gt[4][4];
            if (PASS3 && d == 1) {
#pragma unroll
                for (int mm = 0; mm < 4; ++mm)
#pragma unroll
                    for (int r = 0; r < 4; ++r) gt[mm][r] = bf2f(G2[(size_t)(r0 + (g4 * 4 + mm) * 16 + 4 * q + r) * NIN_O + ch]);
            }
            pg8::f32x4 acc[2][4], rcv[4];
#pragma unroll
            for (int mm = 0; mm < 4; ++mm) { acc[0][mm] = (pg8::f32x4){0.f, 0.f, 0.f, 0.f}; acc[1][mm] = acc[0][mm]; rcv[mm] = acc[0][mm]; }
#pragma unroll
            for (int mm = 0; mm < 4; ++mm)
#pragma unroll
                for (int ks = 0; ks < 4; ++ks) {
                    const pg8::bf16x8 af = *(const LAS pg8::bf16x8*)(rcT + ((g4 * 4 + mm) * 16 + c) * RCP + ks * 64 + q * 16);
                    acc[0][mm] = __builtin_amdgcn_mfma_f32_16x16x32_bf16(af, Bw[0][ks], acc[0][mm], 0, 0, 0);
                    acc[1][mm] = __builtin_amdgcn_mfma_f32_16x16x32_bf16(af, Bw[1][ks], acc[1][mm], 0, 0, 0);
                    if (ks == (w >> 1)) rcv[mm] = __builtin_amdgcn_mfma_f32_16x16x32_bf16(af, Bid, rcv[mm], 0, 0, 0);
                }
#pragma unroll
            for (int mmi = 0; mmi < 4; ++mmi) {
                const int mm = d == 0 ? mmi : 3 - mmi, m = g4 * 4 + mm;
                float av[4], bv[4];
#pragma unroll
                for (int r = 0; r < 4; ++r) lru_ab(acc[0][mm][r], acc[1][mm][r], rcv[mm][r], nba, nbx, kc, av[r], bv[r]);
                float A4, B4;
                if (d == 0) { A4 = av[0] * av[1] * av[2] * av[3]; B4 = ((bv[0] * av[1] + bv[1]) * av[2] + bv[2]) * av[3] + bv[3]; }
                else        { A4 = av[0] * av[1] * av[2] * av[3]; B4 = ((bv[3] * av[2] + bv[2]) * av[1] + bv[1]) * av[0] + bv[0]; }
                float TA[4], TB[4];
#pragma unroll
                for (int k = 0; k < 4; ++k) { TA[k] = __shfl(A4, c + 16 * k); TB[k] = __shfl(B4, c + 16 * k); }
                float EA = 1.f, EB = 0.f, PA = 1.f, PB = 0.f;
#pragma unroll
                for (int k = 0; k < 4; ++k) { const int kk = d == 0 ? k : 3 - k; if (kk == q) { EA = PA; EB = PB; } PB = TA[kk] * PB + TB[kk]; PA = PA * TA[kk]; }
                if (PASS3) {
                    float h = EA * h_run + EB; float hv[4];
#pragma unroll
                    for (int ri = 0; ri < 4; ++ri) { const int r = d == 0 ? ri : 3 - ri; h = av[r] * h + bv[r]; hv[r] = h; }
                    if (d == 0) { hfl[(m * 2 + 0) * 64] = pk2(hv[0], hv[1]); hfl[(m * 2 + 1) * 64] = pk2(hv[2], hv[3]); }
                    else { const unsigned f0 = hfl[(m * 2 + 0) * 64], f1 = hfl[(m * 2 + 1) * 64];
                        const size_t row = (size_t)(r0 + m * 16 + 4 * q);
                        Y1[(row + 0) * DRNN + ch] = f2bf1(gt[mm][0] * (bflo(f0) + hv[0])); Y1[(row + 1) * DRNN + ch] = f2bf1(gt[mm][1] * (bfhi(f0) + hv[1]));
                        Y1[(row + 2) * DRNN + ch] = f2bf1(gt[mm][2] * (bflo(f1) + hv[2])); Y1[(row + 3) * DRNN + ch] = f2bf1(gt[mm][3] * (bfhi(f1) + hv[3])); }
                }
                h_run = PA * h_run + PB; a_run *= PA;
            }
        }
        if (!PASS3) { if (q == 0) { SA[(size_t)(pm * 2 + d) * DRNN + ch] = a_run; SH[(size_t)(pm * 2 + d) * DRNN + ch] = h_run; } }
    }
    __syncthreads();
}
template <bool PASS3>
__device__ __forceinline__ void ph_lru(const Args& A, Frame& F) {
    const int ntile = PASS3 ? 64 : 66;
    for (int u = blockIdx.x; u < ntile * 10; u += F.G) lru_unit<PASS3>(A, F, u / 10, u % 10);
}

__global__ void __launch_bounds__(NTHR, 2) fwd_kernel(Args A) {
    extern __shared__ __attribute__((aligned(16))) unsigned char lds[];
    Frame F;
    F.lds = (LAS unsigned char*)lds; F.MISC = (volatile LAS unsigned*)(F.lds + MISC_OFF);
    F.tid = threadIdx.x; F.lane = F.tid & 63; F.wave = __builtin_amdgcn_readfirstlane(F.tid >> 6);
    F.G = gridDim.x; { const int bx = blockIdx.x; F.vcu = (F.G % 8 == 0) ? (bx % 8) * (F.G / 8) + bx / 8 : bx; }
    unsigned char* ws = A.ws;
    F.ctl = (gu32*)(ws + WS_CTL);
    for (int u = F.tid; u < (LDS_BYTES - LDSCTL_OFF) / 4; u += NTHR) ((LAS unsigned*)(F.lds + LDSCTL_OFF))[u] = 0u;
    __syncthreads();
    XcdBarrier bar; bar.bar = (unsigned*)(F.ctl + CW_BAR); bar.x = 0; bar.st = nullptr;
    if (MK_ONE_LAUNCH) bar = xcd_barrier_post((unsigned*)(F.ctl + CW_BAR), F.MISC + 8);
    const int lo = A.ph_lo, hi = A.ph_hi;
#define IN(k) (lo <= (k) && (k) < hi)
#define SEAM(k) do { if (IN(k) && IN((k) + 1)) xcd_barrier(bar); } while (0)
    const float* mod = (const float*)(ws + WS_MOD);
    bf16* Hb = (bf16*)(ws + WS_H); float* XC = (float*)(ws + WS_XC);

    if (IN(PH_PRO)) { ph_prologue(A, F); __syncthreads(); } SEAM(PH_PRO);
    if (IN(PH_NORM1E)) ph_norm(F, A.in[0], A.in[2], A.in[6], mod, 0, 1, Hb, MTOT); SEAM(PH_NORM1E);
    if (IN(PH_GIN_E)) {
        pg8::Gemm g{Hb, (const bf16*)(ws + WS_WINE), MTOT, NIN_E, DM}; pg8::StaticOrder S; S.init(MTOT, NIN_E, F.G, (int)blockIdx.x);
        EpiInEven E{(bf16*)(ws + WS_G1), (const float*)(ws + WS_ROPE)};
        pg8::gemm_phase<EpiInEven, pg8::StaticOrder, true, true>(F.lds, g, S, E);
    } SEAM(PH_GIN_E);
    if (IN(PH_MIX_E)) { ph_attn_simple(A, F); __syncthreads(); ph_sgu_simple(A, F); } SEAM(PH_MIX_E);
    if (IN(PH_GOUT_E)) {
        pg8::Gemm g{(const bf16*)(ws + WS_MIX), (const bf16*)(ws + WS_WOUTE), MTOT, DM, DM}; pg8::StaticOrder S; S.init(MTOT, DM, F.G, (int)blockIdx.x);
        EpiResid E{A.in[0], A.in[2], A.out, XC, mod + 2 * 1024};
        pg8::gemm_phase<EpiResid, pg8::StaticOrder, true, true>(F.lds, g, S, E);
    } SEAM(PH_GOUT_E);
    if (IN(PH_NORM2E)) ph_norm(F, A.out, XC, A.in[7], mod, 3, 4, Hb, MTOT); SEAM(PH_NORM2E);
    if (IN(PH_FFN_UP)) {
        pg8::Gemm g{Hb, (const bf16*)(ws + WS_FFN13), MTOT, NFF2, DM}; pg8::StaticOrder S; S.init(MTOT, NFF2, F.G, (int)blockIdx.x);
        EpiSwiGLU E{(bf16*)(ws + WS_FH), NFF2 / 256};
        pg8::gemm_phase<EpiSwiGLU, pg8::StaticOrder, true, true>(F.lds, g, S, E);
    } SEAM(PH_FFN_UP);
    if (IN(PH_FFN_DN)) {
        pg8::Gemm g{(const bf16*)(ws + WS_FH), (const bf16*)(ws + WS_FFN2), MTOT, DM, DFF}; pg8::StaticOrder S; S.init(MTOT, DM, F.G, (int)blockIdx.x);
        EpiResid E{A.out, XC, A.out, XC, mod + 5 * 1024};
        pg8::gemm_phase<EpiResid, pg8::StaticOrder, true, true>(F.lds, g, S, E);
    } SEAM(PH_FFN_DN);
    if (IN(PH_NORM1O)) ph_norm(F, A.out, XC, A.in[18], mod + 3 * 6144, 0, 1, Hb, MTOT); SEAM(PH_NORM1O);
    if (IN(PH_GIN_O)) {
        pg8::Gemm g{Hb, (const bf16*)(ws + WS_WINO), MTOT, NIN_O, DM}; pg8::StaticOrder S; S.init(MTOT, NIN_O, F.G, (int)blockIdx.x);
        EpiStore E{(bf16*)(ws + WS_G2), NIN_O, NIN_O / 256, 5};
        pg8::gemm_phase<EpiStore, pg8::StaticOrder, true, true>(F.lds, g, S, E);
    } SEAM(PH_GIN_O);
    if (IN(PH_LRU_G)) ph_lru<false>(A, F); SEAM(PH_LRU_G);
    if (IN(PH_LRU_S)) ph_lru<true>(A, F); SEAM(PH_LRU_S);
    if (IN(PH_GOUT_O)) {
        pg8::Gemm g{(const bf16*)(ws + WS_Y1), (const bf16*)(ws + WS_WOUTO), MLAT, DM, DRNN}; pg8::StaticOrder S; S.init(MLAT, DM, F.G, (int)blockIdx.x);
        EpiResid E{A.out, XC, A.out, XC, mod + 3 * 6144 + 2 * 1024};
        pg8::gemm_phase<EpiResid, pg8::StaticOrder, true, true>(F.lds, g, S, E);
    } SEAM(PH_GOUT_O);
    if (IN(PH_ROUTE)) { ph_route(A, F); __syncthreads(); } SEAM(PH_ROUTE);
    if (IN(PH_CVT_MOE)) ph_convert_moe(A, F); SEAM(PH_CVT_MOE);
    if (IN(PH_PERM)) ph_permute(A, F); SEAM(PH_PERM);
    if (IN(PH_MOE_UP)) {
        const int* meta = (const int*)(ws + WS_META); const int nt = __builtin_amdgcn_readfirstlane(ld_i32_agent(meta + 256));
        pg8::Gemm g{(const bf16*)(ws + WS_HP), (const bf16*)(ws + WS_MOE13), MOE_ROWS, NFF2, DM}; MoeOrder S{meta, nt, NFF2 / 256, F.G, (int)blockIdx.x};
        EpiSwiGLU E{(bf16*)(ws + WS_MH), NFF2 / 256};
        pg8::gemm_phase<EpiSwiGLU, MoeOrder, true, true>(F.lds, g, S, E);
    } SEAM(PH_MOE_UP);
    if (IN(PH_MOE_DN)) {
        const int* meta = (const int*)(ws + WS_META); const int nt = __builtin_amdgcn_readfirstlane(ld_i32_agent(meta + 256));
        pg8::Gemm g{(const bf16*)(ws + WS_MH), (const bf16*)(ws + WS_MOE2), MOE_ROWS, DM, DFF}; MoeOrder S{meta, nt, DM / 256, F.G, (int)blockIdx.x};
        EpiStore E{(bf16*)(ws + WS_YD), DM, DM / 256, 0};
        pg8::gemm_phase<EpiStore, MoeOrder, true, true>(F.lds, g, S, E);
    } SEAM(PH_MOE_DN);
    if (IN(PH_COMB)) ph_combine(A, F);
#undef IN
#undef SEAM
}

extern "C" void kernel_launch(void* const* d_in, const int* in_sizes, int n_in, void* d_out, int out_size, void* d_ws, size_t ws_size, hipStream_t stream) {
    static int grid = 0;
    if (grid == 0) {
        if (n_in != 34 || in_sizes[0] != MLAT * DM || out_size != MLAT * DM || ws_size < WS_NEED) { fprintf(stderr, "kernel_launch: unexpected shapes (n_in %d, out %d, ws %zu)\n", n_in, out_size, ws_size); grid = -1; return; }
        int dev = 0, cus = 0, per_cu = 0;
        if (hipGetDevice(&dev) != hipSuccess || hipDeviceGetAttribute(&cus, hipDeviceAttributeMultiprocessorCount, dev) != hipSuccess) { grid = -1; return; }
        if (hipFuncSetAttribute((const void*)fwd_kernel, hipFuncAttributeMaxDynamicSharedMemorySize, LDS_BYTES) != hipSuccess) { grid = -1; return; }
        if (hipOccupancyMaxActiveBlocksPerMultiprocessor(&per_cu, (const void*)fwd_kernel, NTHR, LDS_BYTES) != hipSuccess || per_cu < 1) { fprintf(stderr, "kernel_launch: occupancy query says %d\n", per_cu); }
        (void)hipGetLastError();
        grid = cus;
    }
    if (grid < 0) return;
    (void)hipMemsetAsync((char*)d_ws + WS_CTL, 0, CTL_ZERO_BYTES, stream);
    Args a{};
    for (int i = 0; i < 34; ++i) a.in[i] = (const float*)d_in[i];
    a.out = (float*)d_out; a.ws = (unsigned char*)d_ws;
#if MK_ONE_LAUNCH
    a.ph_lo = 0; a.ph_hi = NPH;
    hipLaunchKernelGGL(fwd_kernel, dim3(grid), dim3(NTHR), LDS_BYTES, stream, a);
#else
    for (int p = 0; p < NPH; ++p) { a.ph_lo = p; a.ph_hi = p + 1; hipLaunchKernelGGL(fwd_kernel, dim3(grid), dim3(NTHR), LDS_BYTES, stream, a); }
#endif
}
```

```cpp
#include <hip/hip_runtime.h>
#include <cstdio>
#include <cstdint>
namespace pg8 {
#define PG8_LAS __attribute__((address_space(3)))
typedef unsigned short bf16_t;
typedef short bf16x8 __attribute__((ext_vector_type(8)));
typedef float f32x4 __attribute__((ext_vector_type(4)));
typedef unsigned u32x4 __attribute__((ext_vector_type(4)));
constexpr int BM = 256, BK = 64, HALF = 128, HTB = HALF * BK * 2  , STAGE_BYTES = 8 * HTB, NXCD = 8, WGM = 8;

__host__ __device__ __forceinline__ int lds_byte(int r, int c) { const int st = (r >> 4) * 2 + (c >> 5), rr = r & 15, cc = c & 31, ob = rr * 64 + cc * 2; return st * 1024 + (ob ^ (((ob >> 9) & 1) << 5)); }
__host__ __device__ __forceinline__ void stage_rc(int b, int& R, int& C) { const int st = b / 1024, sb = b % 1024, swz = sb ^ (((sb >> 9) & 1) << 5); R = (st >> 1) * 16 + swz / 64; C = (st & 1) * 32 + (swz % 64) / 2; }
__host__ __device__ __forceinline__ int perm32(int rho) { const int n = rho >> 4, i = rho & 15; return 8 * (i >> 2) + 4 * n + (i & 3); }

struct Unit { int pm, pn; };
struct Gemm { const bf16_t* A; const bf16_t* Bt; int M, N, K; };

struct StaticOrder {
    int nM, nN, nwg, G, c;
    __host__ __device__ void init(int M, int N, int G_, int c_) { nM = M / BM; nN = N / BM; nwg = nM * nN; G = G_; c = c_; }
    __host__ __device__ bool next(int i, Unit& u) const {
        const long L = (long)i * G + c; if (L >= nwg) return false;
        int wgid = (int)L; { const int q = nwg / NXCD, r = nwg % NXCD, xcd = wgid % NXCD, off = wgid / NXCD; wgid = (xcd < r ? xcd * (q + 1) : r * (q + 1) + (xcd - r) * q) + off; }
        const int nig = WGM * nN, gid = wgid / nig, fm = gid * WGM, gsz = (nM - fm) < WGM ? (nM - fm) : WGM;
        u.pm = fm + ((wgid % nig) % gsz); u.pn = (wgid % nig) / gsz; return true;
    }
    __device__ __forceinline__ void a_ready(const Unit&) const {}
    __device__ __forceinline__ void done(const Unit&) const {}
};

__device__ __forceinline__ unsigned cvt_pk_bf16(float lo, float hi) { unsigned r; asm volatile("v_cvt_pk_bf16_f32 %0, %1, %2" : "=v"(r) : "v"(lo), "v"(hi)); return r; }
typedef float f32x2 __attribute__((ext_vector_type(2)));
template <class Epi, class Sched, bool ALIGN_EPI = false, bool SP2 = false>
__device__ __forceinline__ void gemm_phase(PG8_LAS unsigned char* lds, const Gemm g, const Sched& S, const Epi& E, const int wid) {
    int lane_; asm volatile("v_mbcnt_lo_u32_b32 %0, -1, 0\n\tv_mbcnt_hi_u32_b32 %0, -1, %0" : "=v"(lane_));
    const int lane = lane_, tid = wid * 64 + lane, wr = wid >> 2, wc = wid & 3, fr = lane & 15, fq = lane >> 4;
    const int K = g.K, nt = K / BK;
    unsigned voffA[2], voffB[2];
#pragma unroll
    for (int i = 0; i < 2; ++i) { int R, C; stage_rc(tid * 16 + i * 8192, R, C); const int Rb = Epi::PERM ? ((R & ~31) + perm32(R & 31)) : R;
        voffA[i] = (unsigned)(R * K + C) * 2u; voffB[i] = (unsigned)(Rb * K + C) * 2u; }
    const size_t kstep = (size_t)(BK * 2);
    const size_t hstep = (size_t)HALF * K * 2;
    const size_t tstep = 2 * hstep;
    const unsigned ldsw = (unsigned)wid * 1024u;
    const int aoff = lds_byte(wr * 64 + fr, fq * 8), boff = lds_byte(wc * 32 + fr, fq * 8);
#define PG8_SA(b, h) (((b) * 2 + (h)) * HTB)
#define PG8_SB(b, h) ((4 + (b) * 2 + (h)) * HTB)
#define PG8_STAGE(bufoff, gbase, voff) do { _Pragma("unroll") for (int _i = 0; _i < 2; ++_i) \
        __builtin_amdgcn_global_load_lds((const unsigned*)((const char*)(gbase) + (voff)[_i]), (PG8_LAS unsigned*)(lds + (bufoff) + ldsw + _i * 8192), 16, 0, 0); } while (0)
#define PG8_LDA(dst, b, h) do { _Pragma("unroll") for (int m = 0; m < 4; ++m) _Pragma("unroll") for (int k = 0; k < 2; ++k) dst[m][k] = *(const PG8_LAS bf16x8*)(lds + PG8_SA(b, h) + aoff + m * 2048 + k * 1024); } while (0)
#define PG8_LDB(dst, b, h) do { _Pragma("unroll") for (int n = 0; n < 2; ++n) _Pragma("unroll") for (int k = 0; k < 2; ++k) dst[n][k] = *(const PG8_LAS bf16x8*)(lds + PG8_SB(b, h) + boff + n * 2048 + k * 1024); } while (0)
#define PG8_MMA(ai, bj, At, Bt) do { __builtin_amdgcn_s_setprio(1); _Pragma("unroll") for (int m = 0; m < 4; ++m) _Pragma("unroll") for (int n = 0; n < 2; ++n) _Pragma("unroll") for (int k = 0; k < 2; ++k) \
        acc[ai][bj][m][n] = __builtin_amdgcn_mfma_f32_16x16x32_bf16(Bt[n][k], At[m][k], acc[ai][bj][m][n], 0, 0, 0); __builtin_amdgcn_s_setprio(0); } while (0)
#define PG8_WAIT_V(n) asm volatile("s_waitcnt vmcnt(" #n ")" ::: "memory")
#define PG8_WAIT_L(n) asm volatile("s_waitcnt lgkmcnt(" #n ")" ::: "memory")
#define PG8_BAR __builtin_amdgcn_s_barrier()
#define PG8_SCHED __builtin_amdgcn_sched_barrier(0)
    Unit cur, nxt; int ui = 0;
    if (!S.next(0, cur)) return;
    f32x4 acc[2][2][4][2];
#pragma unroll
    for (int a = 0; a < 2; ++a)
#pragma unroll
        for (int b = 0; b < 2; ++b)
#pragma unroll
            for (int m = 0; m < 4; ++m)
#pragma unroll
                for (int n = 0; n < 2; ++n) acc[a][b][m][n] = (f32x4){0.f, 0.f, 0.f, 0.f};
    bf16x8 At[4][2], B0[2][2], B1[2][2];
    const char* cA = (const char*)g.A + (size_t)cur.pm * tstep; const char* cB = (const char*)g.Bt + (size_t)cur.pn * tstep;
    S.a_ready(cur);
    if constexpr (SP2) {
        PG8_STAGE(PG8_SB(0, 0), cB, voffB); PG8_STAGE(PG8_SB(0, 1), cB + hstep, voffB); PG8_STAGE(PG8_SA(0, 0), cA, voffA); PG8_STAGE(PG8_SA(0, 1), cA + hstep, voffA);
        if (wr == 1) PG8_BAR;
        PG8_WAIT_V(2); PG8_BAR;
        PG8_STAGE(PG8_SB(1, 0), cB + kstep, voffB); PG8_STAGE(PG8_SA(1, 0), cA + kstep, voffA); PG8_STAGE(PG8_SB(1, 1), cB + hstep + kstep, voffB);
        PG8_WAIT_V(6); PG8_BAR;
    } else {
        PG8_STAGE(PG8_SB(0, 0), cB, voffB); PG8_STAGE(PG8_SA(0, 0), cA, voffA); PG8_STAGE(PG8_SB(0, 1), cB + hstep, voffB); PG8_STAGE(PG8_SA(0, 1), cA + hstep, voffA);
        if (wr == 1) PG8_BAR;
        PG8_WAIT_V(4); PG8_BAR;
        PG8_STAGE(PG8_SB(1, 0), cB + kstep, voffB); PG8_STAGE(PG8_SA(1, 0), cA + kstep, voffA); PG8_STAGE(PG8_SB(1, 1), cB + hstep + kstep, voffB);
        PG8_WAIT_V(6); PG8_BAR;
    }
    for (;;) {
        const bool has_next = S.next(ui + 1, nxt);
        const char* nA = has_next ? (const char*)g.A + (size_t)nxt.pm * tstep : cA; const char* nB = has_next ? (const char*)g.Bt + (size_t)nxt.pn * tstep : cB;
        for (int t = 0; t < nt; t += 2) {
            const bool last = (t == nt - 2);
            const char* a1 = cA + (size_t)(t + 1) * kstep;
            const char* a2 = last ? nA : cA + (size_t)(t + 2) * kstep; const char* b2 = last ? nB : cB + (size_t)(t + 2) * kstep;
            const char* a3 = a2 + kstep; const char* b3 = b2 + kstep;
            if (last && has_next) S.a_ready(nxt);
            if constexpr (SP2) {
            PG8_LDB(B0, 0, 0); PG8_LDB(B1, 0, 1); PG8_SCHED; PG8_LDA(At, 0, 0); PG8_STAGE(PG8_SA(1, 1), a1 + hstep, voffA);
            PG8_WAIT_V(8); PG8_WAIT_L(0); PG8_BAR; PG8_MMA(0, 0, At, B0); PG8_MMA(0, 1, At, B1); PG8_BAR; PG8_SCHED;
            PG8_LDA(At, 0, 1); PG8_STAGE(PG8_SB(0, 0), b2, voffB); PG8_STAGE(PG8_SB(0, 1), b2 + hstep, voffB); PG8_STAGE(PG8_SA(0, 0), a2, voffA);
            PG8_WAIT_V(8); PG8_WAIT_L(0); PG8_BAR; PG8_MMA(1, 0, At, B0); PG8_MMA(1, 1, At, B1); PG8_BAR; PG8_SCHED;
            PG8_LDB(B0, 1, 0); PG8_LDB(B1, 1, 1); PG8_SCHED; PG8_LDA(At, 1, 0); PG8_STAGE(PG8_SA(0, 1), a2 + hstep, voffA);
            PG8_WAIT_V(8); PG8_WAIT_L(0); PG8_BAR; PG8_MMA(0, 0, At, B0); PG8_MMA(0, 1, At, B1); PG8_BAR; PG8_SCHED;
            PG8_LDA(At, 1, 1); PG8_STAGE(PG8_SB(1, 0), b3, voffB); PG8_STAGE(PG8_SB(1, 1), b3 + hstep, voffB); PG8_STAGE(PG8_SA(1, 0), a3, voffA);
            PG8_WAIT_V(8); PG8_WAIT_L(0); PG8_BAR; PG8_MMA(1, 0, At, B0); PG8_MMA(1, 1, At, B1); PG8_BAR; PG8_SCHED;
            } else {
            PG8_LDB(B0, 0, 0); PG8_SCHED; PG8_LDA(At, 0, 0); PG8_STAGE(PG8_SA(1, 1), a1 + hstep, voffA);
            PG8_WAIT_L(8); PG8_BAR; PG8_WAIT_L(0); PG8_MMA(0, 0, At, B0); PG8_BAR; PG8_SCHED;
            PG8_LDB(B1, 0, 1); PG8_STAGE(PG8_SB(0, 0), b2, voffB);
            PG8_BAR; PG8_WAIT_L(0); PG8_MMA(0, 1, At, B1); PG8_BAR;
            PG8_LDA(At, 0, 1); PG8_STAGE(PG8_SA(0, 0), a2, voffA);
            PG8_BAR; PG8_WAIT_L(0); PG8_MMA(1, 0, At, B0); PG8_BAR; PG8_SCHED;
            PG8_STAGE(PG8_SB(0, 1), b2 + hstep, voffB);
            PG8_WAIT_V(6); PG8_BAR; PG8_MMA(1, 1, At, B1); PG8_BAR;
            PG8_LDB(B0, 1, 0); PG8_SCHED; PG8_LDA(At, 1, 0); PG8_STAGE(PG8_SA(0, 1), a2 + hstep, voffA);
            PG8_WAIT_L(8); PG8_BAR; PG8_WAIT_L(0); PG8_MMA(0, 0, At, B0); PG8_BAR; PG8_SCHED;
            PG8_LDB(B1, 1, 1); PG8_STAGE(PG8_SB(1, 0), b3, voffB);
            PG8_BAR; PG8_WAIT_L(0); PG8_MMA(0, 1, At, B1); PG8_BAR;
            PG8_LDA(At, 1, 1); PG8_STAGE(PG8_SA(1, 0), a3, voffA);
            PG8_BAR; PG8_WAIT_L(0); PG8_MMA(1, 0, At, B0); PG8_BAR; PG8_SCHED;
            PG8_STAGE(PG8_SB(1, 1), b3 + hstep, voffB);
            PG8_WAIT_V(6); PG8_BAR; PG8_MMA(1, 1, At, B1); PG8_BAR;
            }
        }
        if constexpr (ALIGN_EPI) { if (wr == 0) PG8_BAR; }
        if constexpr (!Epi::AFTER_DRAIN) { E(acc, cur, wr, wc, fr, fq); S.done(cur); }
        if (!has_next) break;
#pragma unroll
        for (int a = 0; a < 2; ++a)
#pragma unroll
            for (int b = 0; b < 2; ++b)
#pragma unroll
                for (int m = 0; m < 4; ++m)
#pragma unroll
                    for (int n = 0; n < 2; ++n) acc[a][b][m][n] = (f32x4){0.f, 0.f, 0.f, 0.f};
        cur = nxt; cA = nA; cB = nB; ++ui;
        if constexpr (ALIGN_EPI) { if (wr == 1) PG8_BAR; }
    }
    PG8_WAIT_V(0);
    if constexpr (!ALIGN_EPI) { if (wr == 0) PG8_BAR; }
    PG8_BAR;
    if constexpr (Epi::AFTER_DRAIN) { E.fused(acc, cur, wr, wc, fr, fq, lds, wid, lane); S.done(cur); }
#undef PG8_SA
#undef PG8_SB
#undef PG8_STAGE
#undef PG8_LDA
#undef PG8_LDB
#undef PG8_MMA
#undef PG8_WAIT_V
#undef PG8_WAIT_L
#undef PG8_BAR
#undef PG8_SCHED
}
}

constexpr int DM = 1024, NB = 2, SEQ = 8192, CTXL = 256;
constexpr int MLAT = NB * SEQ, MCTX = NB * CTXL, MTOT = MLAT + MCTX;
constexpr int NIN_E = 1792, NIN_O = 2560, DRNN = 1280, DFF = 2816, NEXP = 8, NFF2 = 2 * DFF;
constexpr int COL_V = 512, COL_Q = 1024, COL_K = 1536, COL_VAL = 1664;
constexpr float EPS = 1e-6f, LOG2E = 1.4426950408889634f, QSCALE = 0.125f * LOG2E;
constexpr int MOE_MAXT = 136;
constexpr int MOE_ROWS = MOE_MAXT * 256;

typedef unsigned short bf16;
typedef unsigned v4u __attribute__((ext_vector_type(4)));
typedef unsigned v2u __attribute__((ext_vector_type(2)));
typedef float f32x4 __attribute__((ext_vector_type(4)));
typedef float f32x2 __attribute__((ext_vector_type(2)));
#define GAS __attribute__((address_space(1)))
#define LAS __attribute__((address_space(3)))
typedef GAS unsigned gu32;
#define RLX_AGENT __ATOMIC_RELAXED, __HIP_MEMORY_SCOPE_AGENT
#define LDS_WAIT() asm volatile("s_waitcnt lgkmcnt(0)" ::: "memory")
#define VM_WAIT() asm volatile("s_waitcnt vmcnt(0)" ::: "memory")

__device__ __forceinline__ float bf2f(unsigned short u) { return __builtin_bit_cast(float, (unsigned)u << 16); }
__device__ __forceinline__ float bflo(unsigned u) { return __builtin_bit_cast(float, u << 16); }
__device__ __forceinline__ float bfhi(unsigned u) { return __builtin_bit_cast(float, u & 0xffff0000u); }
__device__ __forceinline__ unsigned pk2(float lo, float hi) { return pg8::cvt_pk_bf16(lo, hi); }
__device__ __forceinline__ unsigned short f2bf1(float x) { return (unsigned short)(pg8::cvt_pk_bf16(x, 0.f) & 0xffffu); }
__device__ __forceinline__ float fexp2(float x) { return __builtin_amdgcn_exp2f(x); }
__device__ __forceinline__ float frcp(float x) { return __builtin_amdgcn_rcpf(x); }
__device__ __forceinline__ float sigmoid_f(float x) { return frcp(1.f + fexp2(-LOG2E * x)); }
__device__ __forceinline__ float silu_f(float x) { return x * sigmoid_f(x); }
__device__ __forceinline__ float gelu_f(float x) { const float u = x * (1.f + 0.044715f * x * x); return x * frcp(1.f + fexp2((-2.f * 0.7978845608028654f * LOG2E) * u)); }
__device__ __forceinline__ f32x4 gelu4(f32x4 v) { return (f32x4){gelu_f(v[0]), gelu_f(v[1]), gelu_f(v[2]), gelu_f(v[3])}; }
__device__ __forceinline__ int ld_i32_agent(const int* p) { return __hip_atomic_load(p, RLX_AGENT); }
__device__ __forceinline__ float wave_sum(float v) {
#pragma unroll
    for (int o = 1; o < 64; o <<= 1) v += __shfl_xor(v, o);
    return v;
}
__device__ __forceinline__ float wave_max(float v) {
#pragma unroll
    for (int o = 1; o < 64; o <<= 1) v = fmaxf(v, __shfl_xor(v, o));
    return v;
}
__device__ __forceinline__ int lane_id_asm() { int l; asm volatile("v_mbcnt_lo_u32_b32 %0, -1, 0\n\tv_mbcnt_hi_u32_b32 %0, -1, %0" : "=v"(l)); return l; }
#define FRESH_TID() (F.wave * 64 + lane_id_asm())
__device__ __forceinline__ int mod_of_tile(int pm) { return pm < 32 ? 0 : (pm < 64 ? 1 : 2); }
__device__ __forceinline__ int mod_of_row(int r) { return r < SEQ ? 0 : (r < MLAT ? 1 : 2); }

struct EpiInEven {
    static constexpr bool PERM = true, AFTER_DRAIN = false;
    bf16* G1; const float* rope;
    __device__ __forceinline__ void operator()(const pg8::f32x4 (&acc)[2][2][4][2], const pg8::Unit& u, int wr, int wc, int fr, int fq) const {
        const int pn = u.pn; const bool lat = u.pm < 64;
#pragma unroll
        for (int ai = 0; ai < 2; ++ai)
#pragma unroll
            for (int m = 0; m < 4; ++m) {
                const int row = u.pm * 256 + ai * 128 + wr * 64 + m * 16 + fr;
                bf16* rowp = G1 + (size_t)row * NIN_E + pn * 256 + wc * 32 + 8 * fq;
                const int t = row & (SEQ - 1);
#pragma unroll
                for (int bj = 0; bj < 2; ++bj) {
                    f32x4 v0 = acc[ai][bj][m][0], v1 = acc[ai][bj][m][1];
                    if (pn < 4) { v0 = gelu4(v0); v1 = gelu4(v1); }
                    else if (pn < 6 || bj == 0) {
                        if (lat) {
                            const int pos = (wc & 1) ? (t & 63) : (t >> 6);
                            const f32x4* tp = (const f32x4*)(rope + (pos * 16 + 4 * fq) * 2);
                            const f32x4 c0 = tp[0], c1 = tp[1];
                            f32x4 w0, w1;
                            w0[0] = v0[0] * c0[0] - v0[1] * c0[1]; w0[1] = v0[1] * c0[0] + v0[0] * c0[1];
                            w0[2] = v0[2] * c0[2] - v0[3] * c0[3]; w0[3] = v0[3] * c0[2] + v0[2] * c0[3];
                            w1[0] = v1[0] * c1[0] - v1[1] * c1[1]; w1[1] = v1[1] * c1[0] + v1[0] * c1[1];
                            w1[2] = v1[2] * c1[2] - v1[3] * c1[3]; w1[3] = v1[3] * c1[2] + v1[2] * c1[3];
                            v0 = w0; v1 = w1;
                        }
                        if (pn < 6) { v0 = v0 * QSCALE; v1 = v1 * QSCALE; }
                    }
                    v4u w; w.x = pk2(v0[0], v0[1]); w.y = pk2(v0[2], v0[3]); w.z = pk2(v1[0], v1[1]); w.w = pk2(v1[2], v1[3]);
                    *(v4u*)(rowp + bj * 128) = w;
                }
            }
    }
};
struct EpiResid {
    static constexpr bool PERM = true, AFTER_DRAIN = false;
    const float* rin_lat; const float* rin_ctx; float* out_lat; float* out_ctx; const float* gate;
    __device__ __forceinline__ void operator()(const pg8::f32x4 (&acc)[2][2][4][2], const pg8::Unit& u, int wr, int wc, int fr, int fq) const {
        const bool lat = u.pm < 64; const float* g = gate + mod_of_tile(u.pm) * 6144;
        const float* rb = lat ? rin_lat : rin_ctx - (size_t)MLAT * DM; float* ob = lat ? out_lat : out_ctx - (size_t)MLAT * DM;
        const int col0 = u.pn * 256 + wc * 32 + 8 * fq;
        f32x4 gv[2][2];
#pragma unroll
        for (int bj = 0; bj < 2; ++bj)
#pragma unroll
            for (int n = 0; n < 2; ++n) gv[bj][n] = *(const f32x4*)(g + col0 + bj * 128 + 4 * n);
#pragma unroll
        for (int ai = 0; ai < 2; ++ai)
#pragma unroll
            for (int m = 0; m < 4; ++m) {
                const size_t p = (size_t)(u.pm * 256 + ai * 128 + wr * 64 + m * 16 + fr) * DM + col0;
#pragma unroll
                for (int bj = 0; bj < 2; ++bj) {
                    const f32x4 r0 = *(const f32x4*)(rb + p + bj * 128), r1 = *(const f32x4*)(rb + p + bj * 128 + 4);
                    *(f32x4*)(ob + p + bj * 128) = r0 + gv[bj][0] * acc[ai][bj][m][0];
                    *(f32x4*)(ob + p + bj * 128 + 4) = r1 + gv[bj][1] * acc[ai][bj][m][1];
                }
            }
    }
};
struct EpiSwiGLU {
    static constexpr bool PERM = true, AFTER_DRAIN = false;
    bf16* H; int nN;
    __device__ __forceinline__ void operator()(const pg8::f32x4 (&acc)[2][2][4][2], const pg8::Unit& u, int wr, int wc, int fr, int fq) const {
        const int pnl = u.pn % nN, col0 = pnl * 128 + wc * 32 + 8 * fq;
#pragma unroll
        for (int ai = 0; ai < 2; ++ai)
#pragma unroll
            for (int m = 0; m < 4; ++m) {
                const size_t row = (size_t)(u.pm * 256 + ai * 128 + wr * 64 + m * 16 + fr);
                const f32x4 a0 = acc[ai][0][m][0], a1 = acc[ai][0][m][1], b0 = acc[ai][1][m][0], b1 = acc[ai][1][m][1];
                v4u w;
                w.x = pk2(silu_f(a0[0]) * b0[0], silu_f(a0[1]) * b0[1]); w.y = pk2(silu_f(a0[2]) * b0[2], silu_f(a0[3]) * b0[3]);
                w.z = pk2(silu_f(a1[0]) * b1[0], silu_f(a1[1]) * b1[1]); w.w = pk2(silu_f(a1[2]) * b1[2], silu_f(a1[3]) * b1[3]);
                *(v4u*)(H + row * DFF + col0) = w;
            }
    }
};
struct EpiStore {
    static constexpr bool PERM = true, AFTER_DRAIN = false;
    bf16* O; int ldc; int nN; int ngelu;
    __device__ __forceinline__ void operator()(const pg8::f32x4 (&acc)[2][2][4][2], const pg8::Unit& u, int wr, int wc, int fr, int fq) const {
        const int pnl = u.pn % nN, col0 = pnl * 256 + wc * 32 + 8 * fq; const bool g = pnl < ngelu;
#pragma unroll
        for (int ai = 0; ai < 2; ++ai)
#pragma unroll
            for (int m = 0; m < 4; ++m) {
                bf16* rowp = O + (size_t)(u.pm * 256 + ai * 128 + wr * 64 + m * 16 + fr) * ldc + col0;
#pragma unroll
                for (int bj = 0; bj < 2; ++bj) {
                    f32x4 v0 = acc[ai][bj][m][0], v1 = acc[ai][bj][m][1];
                    if (g) { v0 = gelu4(v0); v1 = gelu4(v1); }
                    v4u w; w.x = pk2(v0[0], v0[1]); w.y = pk2(v0[2], v0[3]); w.z = pk2(v1[0], v1[1]); w.w = pk2(v1[2], v1[3]);
                    *(v4u*)(rowp + bj * 128) = w;
                }
            }
    }
};
struct MoeOrder {
    const int* tile_e; int ntiles, nN, G, c;
    __device__ __forceinline__ bool next(int i, pg8::Unit& u) const {
        const long L = (long)i * G + c; if (L >= (long)ntiles * nN) return false;
        const int pm = (int)(L / nN), pn = (int)(L % nN);
        u.pm = pm; u.pn = __builtin_amdgcn_readfirstlane(ld_i32_agent(tile_e + pm)) * nN + pn; return true;
    }
    __device__ __forceinline__ void a_ready(const pg8::Unit&) const {}
    __device__ __forceinline__ void done(const pg8::Unit&) const {}
};
#define XB_TMO      128
#define XB_XCNT(j)  (256  + 64 * (j))
#define XB_XSUB(j)  (1280 + 64 * (j))
#define XB_XGEN(j)  (2304 + 64 * (j))
#define XB_TOP      3328
#define XB_TOPGEN   3392
#define XCD_BAR_WORDS 3456
#define XB_SPIN_CAP (1u << 18)

__device__ __forceinline__ unsigned xb_ld(unsigned* p)              { return __hip_atomic_load(p, __ATOMIC_RELAXED, __HIP_MEMORY_SCOPE_AGENT); }
__device__ __forceinline__ unsigned xb_add(unsigned* p, unsigned v) { return __hip_atomic_fetch_add(p, v, __ATOMIC_RELAXED, __HIP_MEMORY_SCOPE_AGENT); }
__device__ __forceinline__ unsigned xb_xcc_id() { return (unsigned)__builtin_amdgcn_s_getreg((3 << 11) | 20) & 0xFu; }
#define XB_SPIN(cond, bar) do { unsigned _sp = 0; while (cond) { __builtin_amdgcn_s_sleep(1); \
    if ((++_sp & 255u) == 0u) { if (xb_ld(&(bar)[XB_TMO])) break; if (_sp > XB_SPIN_CAP) { atomicAdd(&(bar)[XB_TMO], 1u); break; } } } } while (0)

struct XcdBarrier {
    unsigned* bar; unsigned x;
    volatile LAS unsigned* st;
};

__device__ __forceinline__ XcdBarrier xcd_barrier_post(unsigned* bar, volatile LAS unsigned* st, const bool t0) {
    XcdBarrier b; b.bar = bar; b.x = xb_xcc_id(); b.st = st;
    if (t0) (void)xb_add(&bar[XB_XCNT(b.x)], 1u);
    return b;
}
__device__ __forceinline__ void xcd_barrier_complete(unsigned* bar, unsigned x, unsigned& nloc, unsigned& nx) {
    const unsigned G = gridDim.x * gridDim.y * gridDim.z;
    unsigned sum, cnt, mine, sp = 0u;
    for (;;) {
        sum = 0u; cnt = 0u; mine = 0u;
#pragma unroll
        for (unsigned j = 0; j < 16; ++j) { const unsigned c = xb_ld(&bar[XB_XCNT(j)]); sum += c; cnt += (c > 0u) ? 1u : 0u; mine = (j == x) ? c : mine; }
        if (sum == G) break;
        __builtin_amdgcn_s_sleep(1);
        if ((++sp & 255u) == 0u) { if (xb_ld(&bar[XB_TMO])) break; if (sp > XB_SPIN_CAP) { atomicAdd(&bar[XB_TMO], 1u); break; } }
    }
    nloc = mine > 0u ? mine : 1u; nx = cnt > 0u ? cnt : 1u;
}

__device__ __forceinline__ void xcd_barrier(const XcdBarrier& b, const bool t0) {
    asm volatile("s_waitcnt vmcnt(0)" ::: "memory");
    __syncthreads();
    if (t0) {
        unsigned* bar = b.bar;
        __builtin_amdgcn_s_waitcnt(0);
        unsigned nloc = b.st[0], nx = b.st[1];
        if (nloc == 0u) { xcd_barrier_complete(bar, b.x, nloc, nx); b.st[0] = nloc; b.st[1] = nx; }
        const unsigned old = xb_add(&bar[XB_XSUB(b.x)], 1u);
        const unsigned gen = old / nloc;
        if (old + 1u == (gen + 1u) * nloc) {
            __builtin_amdgcn_fence(__ATOMIC_RELEASE, "agent");
            asm volatile("s_waitcnt vmcnt(0)" ::: "memory");
            const unsigned og = xb_add(&bar[XB_TOP], 1u);
            const unsigned tg = og / nx;
            if (og + 1u == (tg + 1u) * nx) xb_add(&bar[XB_TOPGEN], 1u);
            else XB_SPIN(xb_ld(&bar[XB_TOPGEN]) == tg, bar);
            __builtin_amdgcn_fence(__ATOMIC_ACQUIRE, "agent");
            xb_add(&bar[XB_XGEN(b.x)], 1u);
            asm volatile("s_waitcnt vmcnt(0)" ::: "memory");
        } else {
            XB_SPIN(xb_ld(&bar[XB_XGEN(b.x)]) == gen, bar);
            __builtin_amdgcn_fence(__ATOMIC_ACQUIRE, "agent");
            asm volatile("s_waitcnt vmcnt(0)" ::: "memory");
        }
    }
    __syncthreads();
}

constexpr size_t MiB = 1u << 20;
constexpr size_t WS_CTL = 0, CTL_ZERO_BYTES = 1 * MiB;
constexpr size_t WS_MOD = 1 * MiB;
constexpr size_t WS_ROPE = 1 * MiB + 256 * 1024;
constexpr size_t WS_TOKE = 1 * MiB + 512 * 1024;
constexpr size_t WS_TOKG = WS_TOKE + 128 * 1024;
constexpr size_t WS_TOKR = WS_TOKG + 128 * 1024;
constexpr size_t WS_META = 2 * MiB;
constexpr size_t WS_SA = 2 * MiB + 256 * 1024, WS_SH = 3 * MiB;
constexpr size_t WS_SGW = 35 * MiB + 768 * 1024;
constexpr size_t WS_LW = 34 * MiB + 512 * 1024;
constexpr size_t WS_WINE = 4 * MiB, WS_WOUTE = 8 * MiB, WS_FFN13 = 10 * MiB, WS_FFN2 = 21 * MiB, WS_WINO = 27 * MiB, WS_WOUTO = 32 * MiB;
constexpr size_t WS_MOE13 = 36 * MiB, WS_MOE2 = 124 * MiB;
constexpr size_t WS_H = 168 * MiB;
constexpr size_t WS_G1 = 201 * MiB;
constexpr size_t WS_MIX = 259 * MiB;
constexpr size_t WS_XC = 292 * MiB;
constexpr size_t WS_FH = 294 * MiB;
constexpr size_t WS_G2 = 201 * MiB;
constexpr size_t WS_Y1 = 284 * MiB;
constexpr size_t WS_LAF = 36 * MiB, WS_BBF = 78 * MiB, WS_LAB = 120 * MiB, WS_BBB = 324 * MiB, WS_HF = 366 * MiB;
constexpr size_t WS_HP = 168 * MiB;
constexpr size_t WS_MH = 236 * MiB;
constexpr size_t WS_YD = 36 * MiB;
constexpr size_t WS_NEED = 424 * MiB;
constexpr int CW_CNT = 64;
constexpr int CW_BAR = 4096;

constexpr int RING_BYTES = 143360, LDSCTL_OFF = RING_BYTES, MISC_OFF = LDSCTL_OFF + 320, LDS_BYTES = 147456;
constexpr int NWAVES = 8, NTHR = 512;

enum Phase { PH_PRO = 0, PH_NORM1E, PH_GIN_E, PH_MIX_E, PH_GOUT_E, PH_NORM2E, PH_FFN_UP, PH_FFN_DN, PH_NORM1O, PH_GIN_O, PH_LRU_G, PH_LRU_S, PH_GOUT_O, PH_ROUTE, PH_CVT_MOE, PH_PERM,
             PH_MOE_UP, PH_MOE_DN, PH_COMB, NPH };
#ifndef MK_ONE_LAUNCH
#define MK_ONE_LAUNCH 1
#endif

struct Args { const float* in[34]; float* out; unsigned char* ws; int ph_lo, ph_hi; };
struct Frame {
    LAS unsigned char* lds; volatile LAS unsigned* MISC; gu32* ctl;
    int wave, vcu, G;
};

struct MapId { __device__ __forceinline__ int operator()(int n) const { return n; } };
struct MapRope {
    __device__ __forceinline__ int operator()(int n) const {
        if (n < COL_Q || n >= COL_VAL) return n;
        const int base = n < COL_K ? COL_Q : COL_K, r = n - base, h = r >> 6, d = r & 63;
        return base + h * 64 + (d & 32) + 2 * (d & 15) + ((d >> 4) & 1);
    }
};
struct MapGLU { int off; __device__ __forceinline__ int operator()(int n) const { return (n >> 7) * 256 + off + (n & 127); } };

template <class RowMap>
__device__ __forceinline__ void tr_item(const float* W, int K, int N, bf16* WT, LAS float* scr, int item, int lane, RowMap rm) {
    const int nblk = N / 32, kb = item / nblk, nb = item % nblk, k0 = 64 * kb, n0 = 32 * nb;
#pragma unroll 8
    for (int i = 0; i < 32; ++i) { const int kk = 2 * i + (lane >> 5); scr[kk * 33 + (lane & 31)] = W[(size_t)(k0 + kk) * N + n0 + (lane & 31)]; }
    LDS_WAIT(); asm volatile("" ::: "memory");
    const int c = lane & 7;
#pragma unroll
    for (int j = 0; j < 4; ++j) { const int n = (lane >> 3) + 8 * j; const LAS float* s = scr + (8 * c) * 33 + n;
        v4u o; o.x = pk2(s[0 * 33], s[1 * 33]); o.y = pk2(s[2 * 33], s[3 * 33]); o.z = pk2(s[4 * 33], s[5 * 33]); o.w = pk2(s[6 * 33], s[7 * 33]);
        *(GAS v4u*)(WT + (size_t)rm(n0 + n) * K + k0 + 8 * c) = o; }
    LDS_WAIT(); asm volatile("" ::: "memory");
}

__device__ __forceinline__ void ph_prologue(const Args& A, Frame& F) {
    const int lane = lane_id_asm(), tid = F.wave * 64 + lane; (void)tid;
    unsigned char* ws = A.ws;
    LAS float* sact = (LAS float*)F.lds;
    LAS float* red = sact + 3 * 1024;
    for (int t = tid; t < 3 * 1024; t += NTHR) { const int v = t >> 10, k = t & 1023; const float x = v < 2 ? A.in[1][v * 1024 + k] : A.in[3][k]; sact[t] = silu_f(x); }
    __syncthreads();
    float* mod = (float*)(ws + WS_MOD);
    for (int item = blockIdx.x; item < 256; item += F.G) {
        const int L = item >> 7, ch = item & 127; const float* W = (L ? A.in[16] : A.in[4]) + ch * 48; const float* bias = (L ? A.in[17] : A.in[5]);
        if (tid < 504) {
            const int c4 = tid % 12, ks = tid / 12; f32x4 a0 = {0.f, 0.f, 0.f, 0.f}, a1 = a0, a2 = a0;
            for (int k = ks; k < 1024; k += 42) { const f32x4 w = *(const f32x4*)(W + (size_t)k * 6144 + c4 * 4); a0 += sact[k] * w; a1 += sact[1024 + k] * w; a2 += sact[2048 + k] * w; }
            LAS float* r = red + ks * 144 + c4 * 4;
#pragma unroll
            for (int j = 0; j < 4; ++j) { r[j] = a0[j]; r[48 + j] = a1[j]; r[96 + j] = a2[j]; }
        }
        __syncthreads();
        if (tid < 144) { const int v = tid / 48, cc = tid % 48, n = ch * 48 + cc; float s = 0.f; for (int ks = 0; ks < 42; ++ks) s += red[ks * 144 + tid]; mod[(L * 3 + v) * 6144 + n] = s + bias[n]; }
        __syncthreads();
    }
    { const int idx = blockIdx.x * NTHR + tid; if (idx < 128 * 16) { const int pos = idx >> 4, f = idx & 15; const float freq = fexp2(-(float)f * (13.287712379549449f / 16.f)); const float rev = (float)pos * freq * 0.15915494309189535f;
        float* rp = (float*)(ws + WS_ROPE) + idx * 2; rp[0] = __builtin_amdgcn_cosf(rev); rp[1] = __builtin_amdgcn_sinf(rev); } }
    { const int idx = blockIdx.x * NTHR + tid; if (idx < 4 * 128 * 128 / 4) { const f32x4 v = ((const f32x4*)A.in[9])[idx]; v2u o; o.x = pk2(v[0], v[1]); o.y = pk2(v[2], v[3]); ((v2u*)(ws + WS_SGW))[idx] = o; } }
    LAS float* scr = (LAS float*)(F.lds + F.wave * 16384);
    const int gw = F.vcu * NWAVES + F.wave, NGW = F.G * NWAVES;
    constexpr int I_WINE = 16 * 56, I_WOUTE = 16 * 32, I_F1 = 16 * 88, I_F2 = 44 * 32, I_WINO = 16 * 80, I_WOUTO = 20 * 32;
    constexpr int I_LW = 2 * 20 * 8;
    constexpr int NITEMS = I_WINE + I_WOUTE + 2 * I_F1 + I_F2 + I_WINO + I_WOUTO + I_LW;
    for (int it = gw; it < NITEMS; it += NGW) {
        int r = it;
        if (r < I_WINE) { tr_item(A.in[8], DM, NIN_E, (bf16*)(ws + WS_WINE), scr, r, lane, MapRope{}); continue; } r -= I_WINE;
        if (r < I_WOUTE) { tr_item(A.in[12], DM, DM, (bf16*)(ws + WS_WOUTE), scr, r, lane, MapId{}); continue; } r -= I_WOUTE;
        if (r < I_F1) { tr_item(A.in[13], DM, DFF, (bf16*)(ws + WS_FFN13), scr, r, lane, MapGLU{0}); continue; } r -= I_F1;
        if (r < I_F1) { tr_item(A.in[14], DM, DFF, (bf16*)(ws + WS_FFN13), scr, r, lane, MapGLU{128}); continue; } r -= I_F1;
        if (r < I_F2) { tr_item(A.in[15], DFF, DM, (bf16*)(ws + WS_FFN2), scr, r, lane, MapId{}); continue; } r -= I_F2;
        if (r < I_WINO) { tr_item(A.in[20], DM, NIN_O, (bf16*)(ws + WS_WINO), scr, r, lane, MapId{}); continue; } r -= I_WINO;
        if (r < I_WOUTO) { tr_item(A.in[28], DRNN, DM, (bf16*)(ws + WS_WOUTO), scr, r, lane, MapId{}); continue; } r -= I_WOUTO;
        { const int g = r / 160, mi = (r % 160) / 8, item = r % 8, dd = mi / 10, blk = mi % 10;
          tr_item(A.in[g ? 25 : 23] + (size_t)mi * 16384, 128, 128, (bf16*)(ws + WS_LW) + (size_t)((dd * 2 + g) * 10 + blk) * 16384, scr, item, lane, MapId{}); }
    }
}
__device__ __forceinline__ void ph_convert_moe(const Args& A, Frame& F) {
    const int lane = lane_id_asm(), tid = F.wave * 64 + lane; (void)tid;
    unsigned char* ws = A.ws;
    LAS float* scr = (LAS float*)(F.lds + F.wave * 16384);
    const int gw = F.vcu * NWAVES + F.wave, NGW = F.G * NWAVES;
    constexpr int I_F1 = 16 * 88, I_F2 = 44 * 32, PER_E = 2 * I_F1 + I_F2;
    for (int it = gw; it < NEXP * PER_E; it += NGW) {
        const int e = it / PER_E; int r = it % PER_E;
        bf16* w13 = (bf16*)(ws + WS_MOE13) + (size_t)e * NFF2 * DM; bf16* w2 = (bf16*)(ws + WS_MOE2) + (size_t)e * DM * DFF;
        if (r < I_F1) { tr_item(A.in[30] + (size_t)e * DM * DFF, DM, DFF, w13, scr, r, lane, MapGLU{0}); continue; } r -= I_F1;
        if (r < I_F1) { tr_item(A.in[31] + (size_t)e * DM * DFF, DM, DFF, w13, scr, r, lane, MapGLU{128}); continue; } r -= I_F1;
        tr_item(A.in[32] + (size_t)e * DFF * DM, DFF, DM, w2, scr, r, lane, MapId{});
    }
}

__device__ __forceinline__ void norm_mod_regs(const float* xrow, const float* gain, const float* scale, const float* shift, int lane, f32x4 (&v)[4]) {
    const f32x4* xr = (const f32x4*)xrow + lane; float ss = 0.f;
#pragma unroll
    for (int j = 0; j < 4; ++j) { v[j] = xr[64 * j]; ss += (v[j][0] * v[j][0] + v[j][1] * v[j][1]) + (v[j][2] * v[j][2] + v[j][3] * v[j][3]); }
    const float rstd = 1.f / sqrtf(wave_sum(ss) * (1.f / DM) + EPS);
#pragma unroll
    for (int j = 0; j < 4; ++j) { const f32x4 g = ((const f32x4*)gain)[lane + 64 * j], sc = ((const f32x4*)scale)[lane + 64 * j], sh = ((const f32x4*)shift)[lane + 64 * j];
        v[j] = v[j] * rstd * g * (1.f + sc) + sh; }
}
__device__ __forceinline__ void ph_norm(Frame& F, const float* xl, const float* xc, const float* gain, const float* modL, int p_shift, int p_scale, bf16* H, int nrows) {
    const int lane = lane_id_asm(), tid = F.wave * 64 + lane; (void)tid;
    const int gw = F.vcu * NWAVES + F.wave, NGW = F.G * NWAVES;
    for (int r = gw; r < nrows; r += NGW) {
        const float* md = modL + mod_of_row(r) * 6144; const float* xrow = r < MLAT ? xl + (size_t)r * DM : xc + (size_t)(r - MLAT) * DM;
        f32x4 v[4]; norm_mod_regs(xrow, gain, md + p_scale * 1024, md + p_shift * 1024, lane, v);
        GAS v2u* o = (GAS v2u*)(H + (size_t)r * DM) + lane;
#pragma unroll
        for (int j = 0; j < 4; ++j) { v2u w; w.x = pk2(v[j][0], v[j][1]); w.y = pk2(v[j][2], v[j][3]); o[64 * j] = w; }
    }
}

__device__ __forceinline__ void route_row(const Args& A, Frame& F, const LAS float* rw, int t, f32x4 (&v)[4], float (&lg)[8]) {
    const int lane = lane_id_asm(), tid = F.wave * 64 + lane; (void)tid;
    const float* md = (const float*)(A.ws + WS_MOD) + (3 + (t >> 13)) * 6144;
    norm_mod_regs(A.out + (size_t)t * DM, A.in[19], md + 4 * 1024, md + 3 * 1024, lane, v);
#pragma unroll
    for (int e = 0; e < 8; ++e) lg[e] = 0.f;
#pragma unroll
    for (int j = 0; j < 4; ++j)
#pragma unroll
        for (int i = 0; i < 4; ++i) { const int k = 4 * (lane + 64 * j) + i; const f32x4 w0 = *(const LAS f32x4*)(rw + k * 8), w1 = *(const LAS f32x4*)(rw + k * 8 + 4); const float x = v[j][i];
            lg[0] += x * w0[0]; lg[1] += x * w0[1]; lg[2] += x * w0[2]; lg[3] += x * w0[3]; lg[4] += x * w1[0]; lg[5] += x * w1[1]; lg[6] += x * w1[2]; lg[7] += x * w1[3]; }
#pragma unroll
    for (int e = 0; e < 8; ++e) lg[e] = wave_sum(lg[e]);
}
__device__ __forceinline__ void ph_route(const Args& A, Frame& F) {
    const int lane = lane_id_asm(), tid = F.wave * 64 + lane; (void)tid;
    LAS float* rw = (LAS float*)F.lds;
    for (int i = tid; i < DM * 8; i += NTHR) rw[i] = A.in[29][i];
    __syncthreads();
    int* toke = (int*)(A.ws + WS_TOKE); float* tokg = (float*)(A.ws + WS_TOKG); int* tokr = (int*)(A.ws + WS_TOKR);
    const int gw = F.vcu * NWAVES + F.wave, NGW = F.G * NWAVES;
    for (int t = gw; t < MLAT; t += NGW) {
        f32x4 v[4]; float lg[8]; route_row(A, F, rw, t, v, lg);
        int i0 = 0; float l0 = lg[0];
#pragma unroll
        for (int e = 1; e < 8; ++e) if (lg[e] > l0) { l0 = lg[e]; i0 = e; }
        int i1 = -1; float l1 = -INFINITY;
#pragma unroll
        for (int e = 0; e < 8; ++e) if (e != i0 && lg[e] > l1) { l1 = lg[e]; i1 = e; }
        const float g0 = 1.f / (1.f + expf(l1 - l0)), g1 = 1.f - g0;
        if (lane == 0) {
            const int r0 = (int)__hip_atomic_fetch_add((unsigned*)(F.ctl + CW_CNT + 16 * i0), 1u, RLX_AGENT), r1 = (int)__hip_atomic_fetch_add((unsigned*)(F.ctl + CW_CNT + 16 * i1), 1u, RLX_AGENT);
            toke[t] = i0; toke[MLAT + t] = i1; tokg[t] = g0; tokg[MLAT + t] = g1; tokr[t] = r0; tokr[MLAT + t] = r1;
        }
    }
}
__device__ __forceinline__ void ph_permute(const Args& A, Frame& F) {
    const int lane = lane_id_asm(), tid = F.wave * 64 + lane; (void)tid;
    int* toke = (int*)(A.ws + WS_TOKE); int* tokr = (int*)(A.ws + WS_TOKR); int* meta = (int*)(A.ws + WS_META); bf16* HP = (bf16*)(A.ws + WS_HP);
    int off[8]; int tot = 0;
#pragma unroll
    for (int e = 0; e < 8; ++e) { const int c = (int)__hip_atomic_load((unsigned*)(F.ctl + CW_CNT + 16 * e), RLX_AGENT); off[e] = tot; tot += ((c + 255) >> 8) << 8; }
    if (blockIdx.x == 0 && tid < MOE_MAXT + 8) { int e = 0;
#pragma unroll
        for (int k = 1; k < 8; ++k) if (tid * 256 >= off[k]) e = k;
        meta[tid] = e; if (tid == 0) meta[256] = tot >> 8; }
    const int gw = F.vcu * NWAVES + F.wave, NGW = F.G * NWAVES;
    for (int t = gw; t < MLAT; t += NGW) {
        const float* md = (const float*)(A.ws + WS_MOD) + (3 + (t >> 13)) * 6144;
        f32x4 v[4]; norm_mod_regs(A.out + (size_t)t * DM, A.in[19], md + 4 * 1024, md + 3 * 1024, lane, v);
        const int e0 = toke[t], e1 = toke[MLAT + t]; int s0 = tokr[t], s1 = tokr[MLAT + t];
        int o0 = 0, o1 = 0;
#pragma unroll
        for (int k = 0; k < 8; ++k) { if (k == e0) o0 = off[k]; if (k == e1) o1 = off[k]; }
        s0 += o0; s1 += o1;
        GAS v2u* p0 = (GAS v2u*)(HP + (size_t)s0 * DM) + lane; GAS v2u* p1 = (GAS v2u*)(HP + (size_t)s1 * DM) + lane;
#pragma unroll
        for (int j = 0; j < 4; ++j) { v2u w; w.x = pk2(v[j][0], v[j][1]); w.y = pk2(v[j][2], v[j][3]); p0[64 * j] = w; p1[64 * j] = w; }
        if (lane == 0) { tokr[t] = s0; tokr[MLAT + t] = s1; }
    }
}
__device__ __forceinline__ void ph_combine(const Args& A, Frame& F) {
    const int lane = lane_id_asm(), tid = F.wave * 64 + lane; (void)tid;
    const float* tokg = (const float*)(A.ws + WS_TOKG); const int* tokr = (const int*)(A.ws + WS_TOKR); const bf16* YD = (const bf16*)(A.ws + WS_YD); const float* fn = A.in[33];
    const int gw = F.vcu * NWAVES + F.wave, NGW = F.G * NWAVES;
    for (int t = gw; t < MLAT; t += NGW) {
        const float* g2 = (const float*)(A.ws + WS_MOD) + (3 + (t >> 13)) * 6144 + 5 * 1024;
        const int s0 = tokr[t], s1 = tokr[MLAT + t]; const float g0 = tokg[t], g1 = tokg[MLAT + t];
        f32x4* xr = (f32x4*)(A.out + (size_t)t * DM) + lane; const v2u* y0 = (const v2u*)(YD + (size_t)s0 * DM) + lane; const v2u* y1 = (const v2u*)(YD + (size_t)s1 * DM) + lane;
        f32x4 z[4]; float ss = 0.f;
#pragma unroll
        for (int j = 0; j < 4; ++j) { const f32x4 x = xr[64 * j], g = ((const f32x4*)g2)[lane + 64 * j]; const v2u a = y0[64 * j], b = y1[64 * j];
            f32x4 m; m[0] = g0 * bflo(a.x) + g1 * bflo(b.x); m[1] = g0 * bfhi(a.x) + g1 * bfhi(b.x); m[2] = g0 * bflo(a.y) + g1 * bflo(b.y); m[3] = g0 * bfhi(a.y) + g1 * bfhi(b.y);
            z[j] = x + g * m; ss += (z[j][0] * z[j][0] + z[j][1] * z[j][1]) + (z[j][2] * z[j][2] + z[j][3] * z[j][3]); }
        const float rstd = 1.f / sqrtf(wave_sum(ss) * (1.f / DM) + EPS);
#pragma unroll
        for (int j = 0; j < 4; ++j) xr[64 * j] = z[j] * rstd * ((const f32x4*)fn)[lane + 64 * j];
    }
}

constexpr int RCP = 272, HFL_OFF = 256 * RCP;
__device__ __forceinline__ void lru_ab(float rp, float ip, float rcv, float nba, float nbx, float kc, float& a, float& b) {
    const float rg = frcp(1.f + fexp2(fmaf(rp, -LOG2E, nba)));
    const float ig = frcp(1.f + fexp2(fmaf(ip, -LOG2E, nbx)));
    const float la = kc * rg;
    a = fexp2(la * LOG2E);
    const float x = 2.f * la;
    const float om = -x * (1.f + x * (0.5f + x * (0.16666667f + x * (0.041666668f + x * (0.008333334f + x * 0.0013888889f)))));
    b = __builtin_amdgcn_sqrtf(om) * (ig * rcv);
}
template <bool PASS3>
__device__ __forceinline__ void lru_unit(const Args& A, Frame& F, int pm, int blk) {
    const bf16* G2 = (const bf16*)(A.ws + WS_G2);
    LAS unsigned char* rcT = F.lds;
    const int lane = lane_id_asm(), tid = F.wave * 64 + lane, r0 = pm * 256, w = F.wave, c = lane & 15, q = lane >> 4;
    int seg_lo, seg_hi; if (pm < 64) { seg_lo = (pm >> 5) * SEQ; seg_hi = seg_lo + SEQ; } else { seg_lo = r0; seg_hi = r0 + 256; }
    {
        const int c8 = tid & 15, rgp = tid >> 4, ch0 = blk * 128 + c8 * 8;
        const float* cw = A.in[21]; const float* cb = A.in[22];
        f32x4 wj[4][2], cbv[2];
#pragma unroll
        for (int j = 0; j < 4; ++j) { wj[j][0] = *(const f32x4*)(cw + j * DRNN + ch0); wj[j][1] = *(const f32x4*)(cw + j * DRNN + ch0 + 4); }
        cbv[0] = *(const f32x4*)(cb + ch0); cbv[1] = *(const f32x4*)(cb + ch0 + 4);
        v4u x[11];
#pragma unroll
        for (int i = 0; i < 11; ++i) { const int grow = r0 + rgp * 8 + i - 2; const bool ok = (grow >= seg_lo) && (grow < seg_hi); const int gc = grow < seg_lo ? seg_lo : (grow >= seg_hi ? seg_hi - 1 : grow);
            const v4u t = *(const v4u*)(G2 + (size_t)gc * NIN_O + DRNN + ch0); x[i].x = ok ? t.x : 0u; x[i].y = ok ? t.y : 0u; x[i].z = ok ? t.z : 0u; x[i].w = ok ? t.w : 0u; }
#pragma unroll
        for (int r = 0; r < 8; ++r) { f32x4 o0 = cbv[0], o1 = cbv[1];
#pragma unroll
            for (int j = 0; j < 4; ++j) { const v4u t = x[r + j]; o0 += wj[j][0] * (f32x4){bflo(t.x), bfhi(t.x), bflo(t.y), bfhi(t.y)}; o1 += wj[j][1] * (f32x4){bflo(t.z), bfhi(t.z), bflo(t.w), bfhi(t.w)}; }
            v4u pk; pk.x = pk2(o0[0], o0[1]); pk.y = pk2(o0[2], o0[3]); pk.z = pk2(o1[0], o1[1]); pk.w = pk2(o1[2], o1[3]);
            *(LAS v4u*)(rcT + (rgp * 8 + r) * RCP + c8 * 16) = pk; }
    }
    __syncthreads();
    const int ch = blk * 128 + 16 * w + c;
    float* SA = (float*)(A.ws + WS_SA); float* SH = (float*)(A.ws + WS_SH);
    pg8::bf16x8 Bid;
#pragma unroll
    for (int e = 0; e < 8; ++e) Bid[e] = (8 * q + e == (w & 1) * 16 + c) ? (short)0x3F80 : (short)0;
    float cin = 0.f;
    if (PASS3) {
        const int d = (lane >> 4) & 1, b = pm >> 5; const int chc = blk * 128 + 16 * w + (lane & 15);
#pragma unroll 11
        for (int s = 0; s < 33; ++s) {
            int T; bool ok;
            if (s == 0) { T = 64 + b; ok = true; } else if (d == 0) { T = 32 * b + s - 1; ok = T < pm; } else { T = 32 * b + 32 - s; ok = T > pm; }
            const int Tc = ok ? T : pm;
            const float av = SA[(size_t)(Tc * 2 + d) * DRNN + chc], hv = SH[(size_t)(Tc * 2 + d) * DRNN + chc];
            if (ok) cin = av * cin + hv;
        }
    }
    LAS unsigned* hfl = (LAS unsigned*)(F.lds + HFL_OFF + w * 8192) + lane;
    bf16* Y1 = (bf16*)(A.ws + WS_Y1);
#pragma unroll
    for (int d = 0; d < 2; ++d) {
        const float nba = -LOG2E * A.in[24][d * DRNN + ch], nbx = -LOG2E * A.in[26][d * DRNN + ch], kc = -8.f * log1pf(expf(-A.in[27][d * DRNN + ch]));
        pg8::bf16x8 Bw[2][4];
        { const bf16* LW = (const bf16*)(A.ws + WS_LW);
#pragma unroll
          for (int g = 0; g < 2; ++g)
#pragma unroll
            for (int ks = 0; ks < 4; ++ks) Bw[g][ks] = *(const pg8::bf16x8*)(LW + (size_t)((d * 2 + g) * 10 + blk) * 16384 + (16 * w + c) * 128 + ks * 32 + 8 * q); }
        float a_run = 1.f, h_run = PASS3 ? __shfl(cin, d * 16 + c) : 0.f;
#pragma unroll 1
        for (int gi = 0; gi < 4; ++gi) {
            const int g4 = d == 0 ? gi : 3 - gi;
            float gt[4][4];
            if (PASS3 && d == 1) {
#pragma unroll
                for (int mm = 0; mm < 4; ++mm)
#pragma unroll
                    for (int r = 0; r < 4; ++r) gt[mm][r] = bf2f(G2[(size_t)(r0 + (g4 * 4 + mm) * 16 + 4 * q + r) * NIN_O + ch]);
            }
            pg8::f32x4 acc[2][4], rcv[4];
#pragma unroll
            for (int mm = 0; mm < 4; ++mm) { acc[0][mm] = (pg8::f32x4){0.f, 0.f, 0.f, 0.f}; acc[1][mm] = acc[0][mm]; rcv[mm] = acc[0][mm]; }
#pragma unroll
            for (int mm = 0; mm < 4; ++mm)
#pragma unroll
                for (int ks = 0; ks < 4; ++ks) {
                    const pg8::bf16x8 af = *(const LAS pg8::bf16x8*)(rcT + ((g4 * 4 + mm) * 16 + c) * RCP + ks * 64 + q * 16);
                    acc[0][mm] = __builtin_amdgcn_mfma_f32_16x16x32_bf16(af, Bw[0][ks], acc[0][mm], 0, 0, 0);
                    acc[1][mm] = __builtin_amdgcn_mfma_f32_16x16x32_bf16(af, Bw[1][ks], acc[1][mm], 0, 0, 0);
                    if (ks == (w >> 1)) rcv[mm] = __builtin_amdgcn_mfma_f32_16x16x32_bf16(af, Bid, rcv[mm], 0, 0, 0);
                }
#pragma unroll
            for (int mmi = 0; mmi < 4; ++mmi) {
                const int mm = d == 0 ? mmi : 3 - mmi, m = g4 * 4 + mm;
                float av[4], bv[4];
#pragma unroll
                for (int r = 0; r < 4; ++r) lru_ab(acc[0][mm][r], acc[1][mm][r], rcv[mm][r], nba, nbx, kc, av[r], bv[r]);
                float A4, B4;
                if (d == 0) { A4 = av[0] * av[1] * av[2] * av[3]; B4 = ((bv[0] * av[1] + bv[1]) * av[2] + bv[2]) * av[3] + bv[3]; }
                else        { A4 = av[0] * av[1] * av[2] * av[3]; B4 = ((bv[3] * av[2] + bv[2]) * av[1] + bv[1]) * av[0] + bv[0]; }
                float TA[4], TB[4];
#pragma unroll
                for (int k = 0; k < 4; ++k) { TA[k] = __shfl(A4, c + 16 * k); TB[k] = __shfl(B4, c + 16 * k); }
                float EA = 1.f, EB = 0.f, PA = 1.f, PB = 0.f;
#pragma unroll
                for (int k = 0; k < 4; ++k) { const int kk = d == 0 ? k : 3 - k; if (kk == q) { EA = PA; EB = PB; } PB = TA[kk] * PB + TB[kk]; PA = PA * TA[kk]; }
                if (PASS3) {
                    float h = EA * h_run + EB; float hv[4];
#pragma unroll
                    for (int ri = 0; ri < 4; ++ri) { const int r = d == 0 ? ri : 3 - ri; h = av[r] * h + bv[r]; hv[r] = h; }
                    if (d == 0) { hfl[(m * 2 + 0) * 64] = pk2(hv[0], hv[1]); hfl[(m * 2 + 1) * 64] = pk2(hv[2], hv[3]); }
                    else { const unsigned f0 = hfl[(m * 2 + 0) * 64], f1 = hfl[(m * 2 + 1) * 64];
                        const size_t row = (size_t)(r0 + m * 16 + 4 * q);
                        Y1[(row + 0) * DRNN + ch] = f2bf1(gt[mm][0] * (bflo(f0) + hv[0])); Y1[(row + 1) * DRNN + ch] = f2bf1(gt[mm][1] * (bfhi(f0) + hv[1]));
                        Y1[(row + 2) * DRNN + ch] = f2bf1(gt[mm][2] * (bflo(f1) + hv[2])); Y1[(row + 3) * DRNN + ch] = f2bf1(gt[mm][3] * (bfhi(f1) + hv[3])); }
                }
                h_run = PA * h_run + PB; a_run *= PA;
            }
        }
        if (!PASS3) { if (q == 0) { SA[(size_t)(pm * 2 + d) * DRNN + ch] = a_run; SH[(size_t)(pm * 2 + d) * DRNN + ch] = h_run; } }
    }
    __syncthreads();
}
template <bool PASS3>
__device__ __forceinline__ void ph_lru(const Args& A, Frame& F) {
    const int ntile = PASS3 ? 64 : 66;
    for (int u = blockIdx.x; u < ntile * 10; u += F.G) lru_unit<PASS3>(A, F, u / 10, u % 10);
}

typedef short s16x4 __attribute__((ext_vector_type(4)));
__device__ __forceinline__ s16x4 lds_tr16(const LAS unsigned char* p) { return __builtin_bit_cast(s16x4, __builtin_amdgcn_ds_read_tr16_b64_v4i16((LAS s16x4*)p)); }
constexpr int KP = 144, VP = 160;
constexpr int ATT_KOFF = 0, ATT_VOFF = 2 * 64 * KP, ATT_QOFF = ATT_VOFF + 2 * 64 * VP;
__device__ __forceinline__ void attn_unit(const Args& A, Frame& F, int b, int kvh, int qb, bool ctxq) {
    const bf16* G1 = (const bf16*)(A.ws + WS_G1); bf16* MIX = (bf16*)(A.ws + WS_MIX);
    const int lane = lane_id_asm(), tid = F.wave * 64 + lane, w = F.wave, li = lane & 15, g = lane >> 4, hw = w & 1, h = kvh * 4 + (w >> 1);
    const int qrow0 = (ctxq ? MLAT + b * CTXL : b * SEQ) + qb * 128 + 64 * hw;
    LAS unsigned char* lQ = F.lds + ATT_QOFF + w * (64 * KP);
#pragma unroll
    for (int i = 0; i < 8; ++i) { const int ck = lane + 64 * i, row = ck >> 3, dc = ck & 7;
        *(LAS v4u*)(lQ + row * KP + dc * 16) = *(const v4u*)(G1 + (size_t)(qrow0 + row) * NIN_E + COL_Q + h * 64 + 8 * dc); }
    const float sk = A.in[11][h] * LOG2E;
    float mrun[4], lrun[4]; pg8::f32x4 O[4][4];
#pragma unroll
    for (int mt = 0; mt < 4; ++mt) { mrun[mt] = sk; lrun[mt] = (g == 0) ? 1.f : 0.f;
#pragma unroll
        for (int dt = 0; dt < 4; ++dt) O[dt][mt] = (pg8::f32x4){0.f, 0.f, 0.f, 0.f}; }
    const int t_first = ctxq ? 6 : (qb == 0 ? 2 : 0), t_hi = ctxq ? 6 : (qb == SEQ / 128 - 1 ? 4 : 6);
    const int skey = tid >> 3, sdc = tid & 7;
    LAS unsigned char* lK = F.lds + ATT_KOFF; LAS unsigned char* lV = F.lds + ATT_VOFF;
    int cur = t_first, buf = 0;
    { const size_t rowb = cur < 6 ? (size_t)b * SEQ + (qb - 1) * 128 + 64 * cur : (size_t)MLAT + b * CTXL + 64 * (cur - 6);
      const bf16* src = G1 + (rowb + skey) * NIN_E + kvh * 64 + 8 * sdc;
      const v4u kr = *(const v4u*)(src + COL_K), vr = *(const v4u*)(src + COL_VAL);
      *(LAS v4u*)(lK + skey * KP + sdc * 16) = kr; *(LAS v4u*)(lV + skey * VP + sdc * 16) = vr; }
    __syncthreads();
    for (;;) {
        const int nxt = (cur < 6 && cur + 1 == t_hi) ? 6 : cur + 1; const bool has = nxt < 10;
        v4u kr = {0u, 0u, 0u, 0u}, vr = {0u, 0u, 0u, 0u};
        if (has) { const size_t rowb = nxt < 6 ? (size_t)b * SEQ + (qb - 1) * 128 + 64 * nxt : (size_t)MLAT + b * CTXL + 64 * (nxt - 6);
            const bf16* src = G1 + (rowb + skey) * NIN_E + kvh * 64 + 8 * sdc; kr = *(const v4u*)(src + COL_K); vr = *(const v4u*)(src + COL_VAL); }
        const bool skip = (cur == 0 && hw == 1) || (cur == 5 && hw == 0);
        if (!skip) {
            const LAS unsigned char* kb = lK + buf * (64 * KP); const LAS unsigned char* vb = lV + buf * (64 * VP);
            pg8::bf16x8 Kf[4][2];
#pragma unroll
            for (int nt = 0; nt < 4; ++nt)
#pragma unroll
                for (int ks = 0; ks < 2; ++ks) Kf[nt][ks] = *(const LAS pg8::bf16x8*)(kb + (16 * nt + li) * KP + (32 * ks + 8 * g) * 2);
            const int kpos0 = (qb - 1) * 128 + 64 * cur;
            float alpha[4]; pg8::bf16x8 Pf[4][2];
#pragma unroll
            for (int mt = 0; mt < 4; ++mt) {
                pg8::f32x4 S[4];
#pragma unroll
                for (int nt = 0; nt < 4; ++nt) S[nt] = (pg8::f32x4){0.f, 0.f, 0.f, 0.f};
#pragma unroll
                for (int ks = 0; ks < 2; ++ks)
                    { const pg8::bf16x8 qf = *(const LAS pg8::bf16x8*)(lQ + (16 * mt + li) * KP + (32 * ks + 8 * g) * 2);
#pragma unroll
                    for (int nt = 0; nt < 4; ++nt) S[nt] = __builtin_amdgcn_mfma_f32_16x16x32_bf16(Kf[nt][ks], qf, S[nt], 0, 0, 0); }
                if (cur < 2 || cur == 4 || cur == 5) {
                    const int tq = qb * 128 + 64 * hw + 16 * mt + li;
#pragma unroll
                    for (int nt = 0; nt < 4; ++nt)
#pragma unroll
                        for (int r = 0; r < 4; ++r) { const int tk = kpos0 + 16 * nt + 4 * g + r; const int df = cur < 2 ? tq - tk : tk - tq; if (df > 128) S[nt][r] = -INFINITY; }
                }
                float mx = fmaxf(fmaxf(fmaxf(S[0][0], S[0][1]), fmaxf(S[0][2], S[0][3])), fmaxf(fmaxf(S[1][0], S[1][1]), fmaxf(S[1][2], S[1][3])));
                mx = fmaxf(mx, fmaxf(fmaxf(fmaxf(S[2][0], S[2][1]), fmaxf(S[2][2], S[2][3])), fmaxf(fmaxf(S[3][0], S[3][1]), fmaxf(S[3][2], S[3][3]))));
                mx = fmaxf(mx, __shfl_xor(mx, 16)); mx = fmaxf(mx, __shfl_xor(mx, 32));
                const float mnew = fmaxf(mrun[mt], mx); alpha[mt] = fexp2(mrun[mt] - mnew); mrun[mt] = mnew;
                float ls = 0.f;
#pragma unroll
                for (int nt = 0; nt < 4; ++nt)
#pragma unroll
                    for (int r = 0; r < 4; ++r) { const float p = fexp2(S[nt][r] - mnew); S[nt][r] = p; ls += p; }
                lrun[mt] = lrun[mt] * alpha[mt] + ls;
#pragma unroll
                for (int ks = 0; ks < 2; ++ks) { v4u pw; pw.x = pk2(S[2 * ks][0], S[2 * ks][1]); pw.y = pk2(S[2 * ks][2], S[2 * ks][3]); pw.z = pk2(S[2 * ks + 1][0], S[2 * ks + 1][1]); pw.w = pk2(S[2 * ks + 1][2], S[2 * ks + 1][3]);
                    Pf[mt][ks] = __builtin_bit_cast(pg8::bf16x8, pw); }
                if (mt == 1 && has) { LAS unsigned char* kd = lK + (buf ^ 1) * (64 * KP); LAS unsigned char* vd = lV + (buf ^ 1) * (64 * VP);
                    *(LAS v4u*)(kd + skey * KP + sdc * 16) = kr; *(LAS v4u*)(vd + skey * VP + sdc * 16) = vr; }
            }
#pragma unroll
            for (int dt = 0; dt < 4; ++dt) {
                pg8::bf16x8 Vf[2];
#pragma unroll
                for (int ks = 0; ks < 2; ++ks) {
                    const LAS unsigned char* p0 = vb + (32 * ks + 4 * g + (li >> 2)) * VP + (16 * dt + 4 * (li & 3)) * 2;
                    const s16x4 lo = lds_tr16(p0), hi = lds_tr16(p0 + 16 * VP);
                    Vf[ks] = (pg8::bf16x8){lo[0], lo[1], lo[2], lo[3], hi[0], hi[1], hi[2], hi[3]};
                }
#pragma unroll
                for (int mt = 0; mt < 4; ++mt) { O[dt][mt] = O[dt][mt] * alpha[mt];
#pragma unroll
                    for (int ks = 0; ks < 2; ++ks) O[dt][mt] = __builtin_amdgcn_mfma_f32_16x16x32_bf16(Vf[ks], Pf[mt][ks], O[dt][mt], 0, 0, 0); }
            }
        }
        if (skip && has) { LAS unsigned char* kd = lK + (buf ^ 1) * (64 * KP); LAS unsigned char* vd = lV + (buf ^ 1) * (64 * VP);
            *(LAS v4u*)(kd + skey * KP + sdc * 16) = kr; *(LAS v4u*)(vd + skey * VP + sdc * 16) = vr; }
        __syncthreads();
        if (!has) break;
        cur = nxt; buf ^= 1;
    }
#pragma unroll
    for (int mt = 0; mt < 4; ++mt) {
        float l = lrun[mt]; l += __shfl_xor(l, 16); l += __shfl_xor(l, 32); const float inv = 1.f / l;
        bf16* orow = MIX + (size_t)(qrow0 + 16 * mt + li) * DM + 512 + h * 64 + 4 * g;
#pragma unroll
        for (int dt = 0; dt < 4; ++dt) { v2u o; o.x = pk2(O[dt][mt][0] * inv, O[dt][mt][1] * inv); o.y = pk2(O[dt][mt][2] * inv, O[dt][mt][3] * inv); *(v2u*)(orow + 16 * dt) = o; }
    }
}
constexpr int SGP = 272;
__device__ __forceinline__ float red16(float v) { v += __shfl_xor(v, 1); v += __shfl_xor(v, 2); v += __shfl_xor(v, 4); v += __shfl_xor(v, 8); return v; }
__device__ __forceinline__ void sgu_unit(const Args& A, Frame& F, int chunk, int grp) {
    const bf16* G1 = (const bf16*)(A.ws + WS_G1); bf16* MIX = (bf16*)(A.ws + WS_MIX);
    const int lane = lane_id_asm(), tid = F.wave * 64 + lane, row0 = chunk * 128, w = F.wave, li = lane & 15, gq = lane >> 4;
    LAS unsigned char* vn = F.lds;
    { const int ck = tid & 15;
#pragma unroll
      for (int i = 0; i < 4; ++i) { const int row = (tid >> 4) + 32 * i;
        const v4u x = *(const v4u*)(G1 + (size_t)(row0 + row) * NIN_E + COL_V + grp * 128 + ck * 8);
        float f[8] = {bflo(x.x), bfhi(x.x), bflo(x.y), bfhi(x.y), bflo(x.z), bfhi(x.z), bflo(x.w), bfhi(x.w)};
        float s = ((f[0] + f[1]) + (f[2] + f[3])) + ((f[4] + f[5]) + (f[6] + f[7])); s = red16(s); const float mean = s * (1.f / 128.f);
        float ss = 0.f;
#pragma unroll
        for (int e = 0; e < 8; ++e) { f[e] -= mean; ss += f[e] * f[e]; }
        ss = red16(ss); const float rs = 1.f / sqrtf(ss * (1.f / 128.f) + EPS);
        v4u o; o.x = pk2(f[0] * rs, f[1] * rs); o.y = pk2(f[2] * rs, f[3] * rs); o.z = pk2(f[4] * rs, f[5] * rs); o.w = pk2(f[6] * rs, f[7] * rs);
        *(LAS v4u*)(vn + row * SGP + ck * 16) = o; } }
    __syncthreads();
    const bf16* Wb = (const bf16*)(A.ws + WS_SGW) + (size_t)(grp * 128 + 16 * w + li) * 128 + 8 * gq;
    pg8::bf16x8 Wf[4];
#pragma unroll
    for (int ks = 0; ks < 4; ++ks) Wf[ks] = *(const pg8::bf16x8*)(Wb + 32 * ks);
    pg8::f32x4 acc[8];
#pragma unroll
    for (int nt = 0; nt < 8; ++nt) acc[nt] = (pg8::f32x4){0.f, 0.f, 0.f, 0.f};
#pragma unroll
    for (int ks = 0; ks < 4; ++ks)
#pragma unroll
        for (int nt = 0; nt < 8; ++nt) {
            const LAS unsigned char* p0 = vn + (32 * ks + 8 * gq + (li >> 2)) * SGP + (16 * nt + 4 * (li & 3)) * 2;
            const s16x4 lo = lds_tr16(p0), hi = lds_tr16(p0 + 4 * SGP);
            const pg8::bf16x8 vf = (pg8::bf16x8){lo[0], lo[1], lo[2], lo[3], hi[0], hi[1], hi[2], hi[3]};
            acc[nt] = __builtin_amdgcn_mfma_f32_16x16x32_bf16(vf, Wf[ks], acc[nt], 0, 0, 0);
        }
    const float bias = A.in[10][grp * 128 + 16 * w + li];
    const size_t prow = (size_t)(row0 + 16 * w + li);
#pragma unroll
    for (int nt = 0; nt < 8; ++nt) {
        const v2u u = *(const v2u*)(G1 + prow * NIN_E + grp * 128 + 16 * nt + 4 * gq);
        v2u o; o.x = pk2(bflo(u.x) * (acc[nt][0] + bias), bfhi(u.x) * (acc[nt][1] + bias)); o.y = pk2(bflo(u.y) * (acc[nt][2] + bias), bfhi(u.y) * (acc[nt][3] + bias));
        *(v2u*)(MIX + prow * DM + grp * 128 + 16 * nt + 4 * gq) = o;
    }
    __syncthreads();
}
__device__ __forceinline__ void ph_mix(const Args& A, Frame& F) {
    constexpr int N_ATT = NB * (SEQ / 128) * 2, N_CATT = NB * (CTXL / 128) * 2, N_SGU = (MTOT / 128) * 4;
    for (int it = F.vcu; it < N_ATT + N_CATT + N_SGU; it += F.G) {
        if (it < N_ATT + N_CATT) {
            const bool cq = it >= N_ATT; const int j = cq ? it - N_ATT : it;
            const int b = cq ? (j >> 2) : (j >> 7), qb = cq ? ((j >> 1) & 1) : ((j >> 1) & 63), kvh = j & 1;
            attn_unit(A, F, b, kvh, qb, cq);
        } else { const int s = it - (N_ATT + N_CATT); sgu_unit(A, F, s >> 2, s & 3); }
    }
}

__global__ void __launch_bounds__(NTHR, 2) fwd_kernel(Args A) {
    extern __shared__ __attribute__((aligned(16))) unsigned char lds[];
    Frame F;
    F.lds = (LAS unsigned char*)lds; F.MISC = (volatile LAS unsigned*)(F.lds + MISC_OFF);
    F.wave = __builtin_amdgcn_readfirstlane((int)threadIdx.x >> 6);
    F.G = gridDim.x; { const int bx = blockIdx.x; F.vcu = (F.G % 8 == 0) ? (bx % 8) * (F.G / 8) + bx / 8 : bx; }
    unsigned char* ws = A.ws;
    F.ctl = (gu32*)(ws + WS_CTL);
    for (int u = threadIdx.x; u < (LDS_BYTES - LDSCTL_OFF) / 4; u += NTHR) ((LAS unsigned*)(F.lds + LDSCTL_OFF))[u] = 0u;
    __syncthreads();
    XcdBarrier bar; bar.bar = (unsigned*)(F.ctl + CW_BAR); bar.x = 0; bar.st = nullptr;
    if (MK_ONE_LAUNCH) bar = xcd_barrier_post((unsigned*)(F.ctl + CW_BAR), F.MISC + 8, threadIdx.x == 0);
    const int lo = A.ph_lo, hi = A.ph_hi;
#define IN(k) (lo <= (k) && (k) < hi)
#define SEAM(k) do { if (IN(k) && IN((k) + 1)) xcd_barrier(bar, F.wave == 0 && lane_id_asm() == 0); } while (0)
    const float* mod = (const float*)(ws + WS_MOD);
    bf16* Hb = (bf16*)(ws + WS_H); float* XC = (float*)(ws + WS_XC);

    if (IN(PH_PRO)) { ph_prologue(A, F); __syncthreads(); } SEAM(PH_PRO);
    if (IN(PH_NORM1E)) ph_norm(F, A.in[0], A.in[2], A.in[6], mod, 0, 1, Hb, MTOT); SEAM(PH_NORM1E);
    if (IN(PH_GIN_E)) {
        pg8::Gemm g{Hb, (const bf16*)(ws + WS_WINE), MTOT, NIN_E, DM}; pg8::StaticOrder S; S.init(MTOT, NIN_E, F.G, (int)blockIdx.x);
        EpiInEven E{(bf16*)(ws + WS_G1), (const float*)(ws + WS_ROPE)};
        pg8::gemm_phase<EpiInEven, pg8::StaticOrder, true, true>(F.lds, g, S, E, F.wave);
    } SEAM(PH_GIN_E);
    if (IN(PH_MIX_E)) ph_mix(A, F); SEAM(PH_MIX_E);
    if (IN(PH_GOUT_E)) {
        pg8::Gemm g{(const bf16*)(ws + WS_MIX), (const bf16*)(ws + WS_WOUTE), MTOT, DM, DM}; pg8::StaticOrder S; S.init(MTOT, DM, F.G, (int)blockIdx.x);
        EpiResid E{A.in[0], A.in[2], A.out, XC, mod + 2 * 1024};
        pg8::gemm_phase<EpiResid, pg8::StaticOrder, true, true>(F.lds, g, S, E, F.wave);
    } SEAM(PH_GOUT_E);
    if (IN(PH_NORM2E)) ph_norm(F, A.out, XC, A.in[7], mod, 3, 4, Hb, MTOT); SEAM(PH_NORM2E);
    if (IN(PH_FFN_UP)) {
        pg8::Gemm g{Hb, (const bf16*)(ws + WS_FFN13), MTOT, NFF2, DM}; pg8::StaticOrder S; S.init(MTOT, NFF2, F.G, (int)blockIdx.x);
        EpiSwiGLU E{(bf16*)(ws + WS_FH), NFF2 / 256};
        pg8::gemm_phase<EpiSwiGLU, pg8::StaticOrder, true, true>(F.lds, g, S, E, F.wave);
    } SEAM(PH_FFN_UP);
    if (IN(PH_FFN_DN)) {
        pg8::Gemm g{(const bf16*)(ws + WS_FH), (const bf16*)(ws + WS_FFN2), MTOT, DM, DFF}; pg8::StaticOrder S; S.init(MTOT, DM, F.G, (int)blockIdx.x);
        EpiResid E{A.out, XC, A.out, XC, mod + 5 * 1024};
        pg8::gemm_phase<EpiResid, pg8::StaticOrder, true, true>(F.lds, g, S, E, F.wave);
    } SEAM(PH_FFN_DN);
    if (IN(PH_NORM1O)) ph_norm(F, A.out, XC, A.in[18], mod + 3 * 6144, 0, 1, Hb, MTOT); SEAM(PH_NORM1O);
    if (IN(PH_GIN_O)) {
        pg8::Gemm g{Hb, (const bf16*)(ws + WS_WINO), MTOT, NIN_O, DM}; pg8::StaticOrder S; S.init(MTOT, NIN_O, F.G, (int)blockIdx.x);
        EpiStore E{(bf16*)(ws + WS_G2), NIN_O, NIN_O / 256, 5};
        pg8::gemm_phase<EpiStore, pg8::StaticOrder, true, true>(F.lds, g, S, E, F.wave);
    } SEAM(PH_GIN_O);
    if (IN(PH_LRU_G)) ph_lru<false>(A, F); SEAM(PH_LRU_G);
    if (IN(PH_LRU_S)) ph_lru<true>(A, F); SEAM(PH_LRU_S);
    if (IN(PH_GOUT_O)) {
        pg8::Gemm g{(const bf16*)(ws + WS_Y1), (const bf16*)(ws + WS_WOUTO), MLAT, DM, DRNN}; pg8::StaticOrder S; S.init(MLAT, DM, F.G, (int)blockIdx.x);
        EpiResid E{A.out, XC, A.out, XC, mod + 3 * 6144 + 2 * 1024};
        pg8::gemm_phase<EpiResid, pg8::StaticOrder, true, true>(F.lds, g, S, E, F.wave);
    } SEAM(PH_GOUT_O);
    if (IN(PH_ROUTE)) { ph_route(A, F); __syncthreads(); } SEAM(PH_ROUTE);
    if (IN(PH_CVT_MOE)) ph_convert_moe(A, F); SEAM(PH_CVT_MOE);
    if (IN(PH_PERM)) ph_permute(A, F); SEAM(PH_PERM);
    if (IN(PH_MOE_UP)) {
        const int* meta = (const int*)(ws + WS_META); const int nt = __builtin_amdgcn_readfirstlane(ld_i32_agent(meta + 256));
        pg8::Gemm g{(const bf16*)(ws + WS_HP), (const bf16*)(ws + WS_MOE13), MOE_ROWS, NFF2, DM}; MoeOrder S{meta, nt, NFF2 / 256, F.G, (int)blockIdx.x};
        EpiSwiGLU E{(bf16*)(ws + WS_MH), NFF2 / 256};
        pg8::gemm_phase<EpiSwiGLU, MoeOrder, true, true>(F.lds, g, S, E, F.wave);
    } SEAM(PH_MOE_UP);
    if (IN(PH_MOE_DN)) {
        const int* meta = (const int*)(ws + WS_META); const int nt = __builtin_amdgcn_readfirstlane(ld_i32_agent(meta + 256));
        pg8::Gemm g{(const bf16*)(ws + WS_MH), (const bf16*)(ws + WS_MOE2), MOE_ROWS, DM, DFF}; MoeOrder S{meta, nt, DM / 256, F.G, (int)blockIdx.x};
        EpiStore E{(bf16*)(ws + WS_YD), DM, DM / 256, 0};
        pg8::gemm_phase<EpiStore, MoeOrder, true, true>(F.lds, g, S, E, F.wave);
    } SEAM(PH_MOE_DN);
    if (IN(PH_COMB)) ph_combine(A, F);
#undef IN
#undef SEAM
}

extern "C" void kernel_launch(void* const* d_in, const int* in_sizes, int n_in, void* d_out, int out_size, void* d_ws, size_t ws_size, hipStream_t stream) {
    static int grid = 0;
    if (grid == 0) {
        if (n_in != 34 || in_sizes[0] != MLAT * DM || out_size != MLAT * DM || ws_size < WS_NEED) { fprintf(stderr, "kernel_launch: unexpected shapes (n_in %d, out %d, ws %zu)\n", n_in, out_size, ws_size); grid = -1; return; }
        int dev = 0, cus = 0, per_cu = 0;
        if (hipGetDevice(&dev) != hipSuccess || hipDeviceGetAttribute(&cus, hipDeviceAttributeMultiprocessorCount, dev) != hipSuccess) { grid = -1; return; }
        if (hipFuncSetAttribute((const void*)fwd_kernel, hipFuncAttributeMaxDynamicSharedMemorySize, LDS_BYTES) != hipSuccess) { grid = -1; return; }
        if (hipOccupancyMaxActiveBlocksPerMultiprocessor(&per_cu, (const void*)fwd_kernel, NTHR, LDS_BYTES) != hipSuccess || per_cu < 1) { fprintf(stderr, "kernel_launch: occupancy query says %d\n", per_cu); }
        (void)hipGetLastError();
        grid = cus;
    }
    if (grid < 0) return;
    (void)hipMemsetAsync((char*)d_ws + WS_CTL, 0, CTL_ZERO_BYTES, stream);
    Args a{};
    for (int i = 0; i < 34; ++i) a.in[i] = (const float*)d_in[i];
    a.out = (float*)d_out; a.ws = (unsigned char*)d_ws;
#if MK_ONE_LAUNCH
    a.ph_lo = 0; a.ph_hi = NPH;
    hipLaunchKernelGGL(fwd_kernel, dim3(grid), dim3(NTHR), LDS_BYTES, stream, a);
#else
    for (int p = 0; p < NPH; ++p) { a.ph_lo = p; a.ph_hi = p + 1; hipLaunchKernelGGL(fwd_kernel, dim3(grid), dim3(NTHR), LDS_BYTES, stream, a); }
#endif
}
```

```cpp
#include <hip/hip_runtime.h>
#include <cstdio>
#include <cstdint>
namespace pg8 {
#define PG8_LAS __attribute__((address_space(3)))
typedef unsigned short bf16_t;
typedef short bf16x8 __attribute__((ext_vector_type(8)));
typedef float f32x4 __attribute__((ext_vector_type(4)));
typedef unsigned u32x4 __attribute__((ext_vector_type(4)));
constexpr int BM = 256, BK = 64, HALF = 128, HTB = HALF * BK * 2  , STAGE_BYTES = 8 * HTB, NXCD = 8, WGM = 8;

__host__ __device__ __forceinline__ int lds_byte(int r, int c) { const int st = (r >> 4) * 2 + (c >> 5), rr = r & 15, cc = c & 31, ob = rr * 64 + cc * 2; return st * 1024 + (ob ^ (((ob >> 9) & 1) << 5)); }
__host__ __device__ __forceinline__ void stage_rc(int b, int& R, int& C) { const int st = b / 1024, sb = b % 1024, swz = sb ^ (((sb >> 9) & 1) << 5); R = (st >> 1) * 16 + swz / 64; C = (st & 1) * 32 + (swz % 64) / 2; }
__host__ __device__ __forceinline__ int perm32(int rho) { const int n = rho >> 4, i = rho & 15; return 8 * (i >> 2) + 4 * n + (i & 3); }

struct Unit { int pm, pn, kb; };
struct Gemm { const bf16_t* A; const bf16_t* Bt; int M, N, K, ld; };

struct StaticOrder {
    int nM, nN, nwg, G, c;
    __host__ __device__ void init(int M, int N, int G_, int c_) { nM = M / BM; nN = N / BM; nwg = nM * nN; G = G_; c = c_; }
    __host__ __device__ bool next(int i, Unit& u) const {
        const long L = (long)i * G + c; if (L >= nwg) return false;
        int wgid = (int)L; { const int q = nwg / NXCD, r = nwg % NXCD, xcd = wgid % NXCD, off = wgid / NXCD; wgid = (xcd < r ? xcd * (q + 1) : r * (q + 1) + (xcd - r) * q) + off; }
        const int nig = WGM * nN, gid = wgid / nig, fm = gid * WGM, gsz = (nM - fm) < WGM ? (nM - fm) : WGM;
        u.pm = fm + ((wgid % nig) % gsz); u.pn = (wgid % nig) / gsz; u.kb = 0; return true;
    }
    __device__ __forceinline__ void a_ready(const Unit&) const {}
    __device__ __forceinline__ void done(const Unit&) const {}
};

__device__ __forceinline__ unsigned cvt_pk_bf16(float lo, float hi) { unsigned r; asm volatile("v_cvt_pk_bf16_f32 %0, %1, %2" : "=v"(r) : "v"(lo), "v"(hi)); return r; }
typedef float f32x2 __attribute__((ext_vector_type(2)));
template <class Epi, class Sched, bool ALIGN_EPI = false, bool SP2 = false>
__device__ __forceinline__ void gemm_phase(PG8_LAS unsigned char* lds, const Gemm g, const Sched& S, const Epi& E, const int wid) {
    int lane_; asm volatile("v_mbcnt_lo_u32_b32 %0, -1, 0\n\tv_mbcnt_hi_u32_b32 %0, -1, %0" : "=v"(lane_));
    const int lane = lane_, tid = wid * 64 + lane, wr = wid >> 2, wc = wid & 3, fr = lane & 15, fq = lane >> 4;
    const int K = g.ld, nt = g.K / BK;
    unsigned voffA[2], voffB[2];
#pragma unroll
    for (int i = 0; i < 2; ++i) { int R, C; stage_rc(tid * 16 + i * 8192, R, C); const int Rb = Epi::PERM ? ((R & ~31) + perm32(R & 31)) : R;
        voffA[i] = (unsigned)(R * K + C) * 2u; voffB[i] = (unsigned)(Rb * K + C) * 2u; }
    const size_t kstep = (size_t)(BK * 2);
    const size_t hstep = (size_t)HALF * K * 2;
    const size_t tstep = 2 * hstep;
    const unsigned ldsw = (unsigned)wid * 1024u;
    const int aoff = lds_byte(wr * 64 + fr, fq * 8), boff = lds_byte(wc * 32 + fr, fq * 8);
#define PG8_SA(b, h) (((b) * 2 + (h)) * HTB)
#define PG8_SB(b, h) ((4 + (b) * 2 + (h)) * HTB)
#define PG8_STAGE(bufoff, gbase, voff) do { _Pragma("unroll") for (int _i = 0; _i < 2; ++_i) \
        __builtin_amdgcn_global_load_lds((const unsigned*)((const char*)(gbase) + (voff)[_i]), (PG8_LAS unsigned*)(lds + (bufoff) + ldsw + _i * 8192), 16, 0, 0); } while (0)
#define PG8_LDA(dst, b, h) do { _Pragma("unroll") for (int m = 0; m < 4; ++m) _Pragma("unroll") for (int k = 0; k < 2; ++k) dst[m][k] = *(const PG8_LAS bf16x8*)(lds + PG8_SA(b, h) + aoff + m * 2048 + k * 1024); } while (0)
#define PG8_LDB(dst, b, h) do { _Pragma("unroll") for (int n = 0; n < 2; ++n) _Pragma("unroll") for (int k = 0; k < 2; ++k) dst[n][k] = *(const PG8_LAS bf16x8*)(lds + PG8_SB(b, h) + boff + n * 2048 + k * 1024); } while (0)
#define PG8_MMA(ai, bj, At, Bt) do { __builtin_amdgcn_s_setprio(1); _Pragma("unroll") for (int m = 0; m < 4; ++m) _Pragma("unroll") for (int n = 0; n < 2; ++n) _Pragma("unroll") for (int k = 0; k < 2; ++k) \
        acc[ai][bj][m][n] = __builtin_amdgcn_mfma_f32_16x16x32_bf16(Bt[n][k], At[m][k], acc[ai][bj][m][n], 0, 0, 0); __builtin_amdgcn_s_setprio(0); } while (0)
#define PG8_WAIT_V(n) asm volatile("s_waitcnt vmcnt(" #n ")" ::: "memory")
#define PG8_WAIT_L(n) asm volatile("s_waitcnt lgkmcnt(" #n ")" ::: "memory")
#define PG8_BAR __builtin_amdgcn_s_barrier()
#define PG8_SCHED __builtin_amdgcn_sched_barrier(0)
    Unit cur, nxt; int ui = 0;
    if (!S.next(0, cur)) return;
    f32x4 acc[2][2][4][2];
#pragma unroll
    for (int a = 0; a < 2; ++a)
#pragma unroll
        for (int b = 0; b < 2; ++b)
#pragma unroll
            for (int m = 0; m < 4; ++m)
#pragma unroll
                for (int n = 0; n < 2; ++n) acc[a][b][m][n] = (f32x4){0.f, 0.f, 0.f, 0.f};
    bf16x8 At[4][2], B0[2][2], B1[2][2];
    const char* cA = (const char*)g.A + (size_t)cur.pm * tstep + cur.kb; const char* cB = (const char*)g.Bt + (size_t)cur.pn * tstep + cur.kb;
    S.a_ready(cur);
    if constexpr (SP2) {
        PG8_STAGE(PG8_SB(0, 0), cB, voffB); PG8_STAGE(PG8_SB(0, 1), cB + hstep, voffB); PG8_STAGE(PG8_SA(0, 0), cA, voffA); PG8_STAGE(PG8_SA(0, 1), cA + hstep, voffA);
        if (wr == 1) PG8_BAR;
        PG8_WAIT_V(2); PG8_BAR;
        PG8_STAGE(PG8_SB(1, 0), cB + kstep, voffB); PG8_STAGE(PG8_SA(1, 0), cA + kstep, voffA); PG8_STAGE(PG8_SB(1, 1), cB + hstep + kstep, voffB);
        PG8_WAIT_V(6); PG8_BAR;
    } else {
        PG8_STAGE(PG8_SB(0, 0), cB, voffB); PG8_STAGE(PG8_SA(0, 0), cA, voffA); PG8_STAGE(PG8_SB(0, 1), cB + hstep, voffB); PG8_STAGE(PG8_SA(0, 1), cA + hstep, voffA);
        if (wr == 1) PG8_BAR;
        PG8_WAIT_V(4); PG8_BAR;
        PG8_STAGE(PG8_SB(1, 0), cB + kstep, voffB); PG8_STAGE(PG8_SA(1, 0), cA + kstep, voffA); PG8_STAGE(PG8_SB(1, 1), cB + hstep + kstep, voffB);
        PG8_WAIT_V(6); PG8_BAR;
    }
    for (;;) {
        const bool has_next = S.next(ui + 1, nxt);
        const char* nA = has_next ? (const char*)g.A + (size_t)nxt.pm * tstep + nxt.kb : cA; const char* nB = has_next ? (const char*)g.Bt + (size_t)nxt.pn * tstep + nxt.kb : cB;
        for (int t = 0; t < nt; t += 2) {
            const bool last = (t == nt - 2);
            const char* a1 = cA + (size_t)(t + 1) * kstep;
            const char* a2 = last ? nA : cA + (size_t)(t + 2) * kstep; const char* b2 = last ? nB : cB + (size_t)(t + 2) * kstep;
            const char* a3 = a2 + kstep; const char* b3 = b2 + kstep;
            if (last && has_next) S.a_ready(nxt);
            if constexpr (SP2) {
            PG8_LDB(B0, 0, 0); PG8_LDB(B1, 0, 1); PG8_SCHED; PG8_LDA(At, 0, 0); PG8_STAGE(PG8_SA(1, 1), a1 + hstep, voffA);
            PG8_WAIT_V(8); PG8_WAIT_L(0); PG8_BAR; PG8_MMA(0, 0, At, B0); PG8_MMA(0, 1, At, B1); PG8_BAR; PG8_SCHED;
            PG8_LDA(At, 0, 1); PG8_STAGE(PG8_SB(0, 0), b2, voffB); PG8_STAGE(PG8_SB(0, 1), b2 + hstep, voffB); PG8_STAGE(PG8_SA(0, 0), a2, voffA);
            PG8_WAIT_V(8); PG8_WAIT_L(0); PG8_BAR; PG8_MMA(1, 0, At, B0); PG8_MMA(1, 1, At, B1); PG8_BAR; PG8_SCHED;
            PG8_LDB(B0, 1, 0); PG8_LDB(B1, 1, 1); PG8_SCHED; PG8_LDA(At, 1, 0); PG8_STAGE(PG8_SA(0, 1), a2 + hstep, voffA);
            PG8_WAIT_V(8); PG8_WAIT_L(0); PG8_BAR; PG8_MMA(0, 0, At, B0); PG8_MMA(0, 1, At, B1); PG8_BAR; PG8_SCHED;
            PG8_LDA(At, 1, 1); PG8_STAGE(PG8_SB(1, 0), b3, voffB); PG8_STAGE(PG8_SB(1, 1), b3 + hstep, voffB); PG8_STAGE(PG8_SA(1, 0), a3, voffA);
            PG8_WAIT_V(8); PG8_WAIT_L(0); PG8_BAR; PG8_MMA(1, 0, At, B0); PG8_MMA(1, 1, At, B1); PG8_BAR; PG8_SCHED;
            } else {
            PG8_LDB(B0, 0, 0); PG8_SCHED; PG8_LDA(At, 0, 0); PG8_STAGE(PG8_SA(1, 1), a1 + hstep, voffA);
            PG8_WAIT_L(8); PG8_BAR; PG8_WAIT_L(0); PG8_MMA(0, 0, At, B0); PG8_BAR; PG8_SCHED;
            PG8_LDB(B1, 0, 1); PG8_STAGE(PG8_SB(0, 0), b2, voffB);
            PG8_BAR; PG8_WAIT_L(0); PG8_MMA(0, 1, At, B1); PG8_BAR;
            PG8_LDA(At, 0, 1); PG8_STAGE(PG8_SA(0, 0), a2, voffA);
            PG8_BAR; PG8_WAIT_L(0); PG8_MMA(1, 0, At, B0); PG8_BAR; PG8_SCHED;
            PG8_STAGE(PG8_SB(0, 1), b2 + hstep, voffB);
            PG8_WAIT_V(6); PG8_BAR; PG8_MMA(1, 1, At, B1); PG8_BAR;
            PG8_LDB(B0, 1, 0); PG8_SCHED; PG8_LDA(At, 1, 0); PG8_STAGE(PG8_SA(0, 1), a2 + hstep, voffA);
            PG8_WAIT_L(8); PG8_BAR; PG8_WAIT_L(0); PG8_MMA(0, 0, At, B0); PG8_BAR; PG8_SCHED;
            PG8_LDB(B1, 1, 1); PG8_STAGE(PG8_SB(1, 0), b3, voffB);
            PG8_BAR; PG8_WAIT_L(0); PG8_MMA(0, 1, At, B1); PG8_BAR;
            PG8_LDA(At, 1, 1); PG8_STAGE(PG8_SA(1, 0), a3, voffA);
            PG8_BAR; PG8_WAIT_L(0); PG8_MMA(1, 0, At, B0); PG8_BAR; PG8_SCHED;
            PG8_STAGE(PG8_SB(1, 1), b3 + hstep, voffB);
            PG8_WAIT_V(6); PG8_BAR; PG8_MMA(1, 1, At, B1); PG8_BAR;
            }
        }
        if constexpr (ALIGN_EPI) { if (wr == 0) PG8_BAR; }
        if constexpr (!Epi::AFTER_DRAIN) { E(acc, cur, wr, wc, fr, fq); S.done(cur); }
        if (!has_next) break;
#pragma unroll
        for (int a = 0; a < 2; ++a)
#pragma unroll
            for (int b = 0; b < 2; ++b)
#pragma unroll
                for (int m = 0; m < 4; ++m)
#pragma unroll
                    for (int n = 0; n < 2; ++n) acc[a][b][m][n] = (f32x4){0.f, 0.f, 0.f, 0.f};
        cur = nxt; cA = nA; cB = nB; ++ui;
        if constexpr (ALIGN_EPI) { if (wr == 1) PG8_BAR; }
    }
    PG8_WAIT_V(0);
    if constexpr (!ALIGN_EPI) { if (wr == 0) PG8_BAR; }
    PG8_BAR;
    if constexpr (Epi::AFTER_DRAIN) { E.fused(acc, cur, wr, wc, fr, fq, lds, wid, lane); S.done(cur); }
#undef PG8_SA
#undef PG8_SB
#undef PG8_STAGE
#undef PG8_LDA
#undef PG8_LDB
#undef PG8_MMA
#undef PG8_WAIT_V
#undef PG8_WAIT_L
#undef PG8_BAR
#undef PG8_SCHED
}
}

constexpr int DM = 1024, NB = 2, SEQ = 8192, CTXL = 256;
constexpr int MLAT = NB * SEQ, MCTX = NB * CTXL, MTOT = MLAT + MCTX;
constexpr int NIN_E = 1792, NIN_O = 2560, DRNN = 1280, DFF = 2816, NEXP = 8, NFF2 = 2 * DFF;
constexpr int COL_V = 512, COL_Q = 1024, COL_K = 1536, COL_VAL = 1664;
constexpr float EPS = 1e-6f, LOG2E = 1.4426950408889634f, QSCALE = 0.125f * LOG2E;
constexpr int MOE_MAXT = 136;
constexpr int MOE_ROWS = MOE_MAXT * 256;

typedef unsigned short bf16;
typedef unsigned v4u __attribute__((ext_vector_type(4)));
typedef unsigned v2u __attribute__((ext_vector_type(2)));
typedef float f32x4 __attribute__((ext_vector_type(4)));
typedef float f32x2 __attribute__((ext_vector_type(2)));
#define GAS __attribute__((address_space(1)))
#define LAS __attribute__((address_space(3)))
typedef GAS unsigned gu32;
#define RLX_AGENT __ATOMIC_RELAXED, __HIP_MEMORY_SCOPE_AGENT
#define LDS_WAIT() asm volatile("s_waitcnt lgkmcnt(0)" ::: "memory")
#define VM_WAIT() asm volatile("s_waitcnt vmcnt(0)" ::: "memory")

__device__ __forceinline__ float bf2f(unsigned short u) { return __builtin_bit_cast(float, (unsigned)u << 16); }
__device__ __forceinline__ float bflo(unsigned u) { return __builtin_bit_cast(float, u << 16); }
__device__ __forceinline__ float bfhi(unsigned u) { return __builtin_bit_cast(float, u & 0xffff0000u); }
__device__ __forceinline__ unsigned pk2(float lo, float hi) { return pg8::cvt_pk_bf16(lo, hi); }
__device__ __forceinline__ unsigned short f2bf1(float x) { return (unsigned short)(pg8::cvt_pk_bf16(x, 0.f) & 0xffffu); }
__device__ __forceinline__ float fexp2(float x) { return __builtin_amdgcn_exp2f(x); }
__device__ __forceinline__ float frcp(float x) { return __builtin_amdgcn_rcpf(x); }
__device__ __forceinline__ float sigmoid_f(float x) { return frcp(1.f + fexp2(-LOG2E * x)); }
__device__ __forceinline__ float silu_f(float x) { return x * sigmoid_f(x); }
__device__ __forceinline__ float gelu_f(float x) { const float u = x * (1.f + 0.044715f * x * x); return x * frcp(1.f + fexp2((-2.f * 0.7978845608028654f * LOG2E) * u)); }
__device__ __forceinline__ f32x4 gelu4(f32x4 v) { return (f32x4){gelu_f(v[0]), gelu_f(v[1]), gelu_f(v[2]), gelu_f(v[3])}; }
__device__ __forceinline__ int ld_i32_agent(const int* p) { return __hip_atomic_load(p, RLX_AGENT); }
__device__ __forceinline__ float wave_sum(float v) {
#pragma unroll
    for (int o = 1; o < 64; o <<= 1) v += __shfl_xor(v, o);
    return v;
}
__device__ __forceinline__ float wave_max(float v) {
#pragma unroll
    for (int o = 1; o < 64; o <<= 1) v = fmaxf(v, __shfl_xor(v, o));
    return v;
}
__device__ __forceinline__ int lane_id_asm() { int l; asm volatile("v_mbcnt_lo_u32_b32 %0, -1, 0\n\tv_mbcnt_hi_u32_b32 %0, -1, %0" : "=v"(l)); return l; }
#define FRESH_TID() (F.wave * 64 + lane_id_asm())
__device__ __forceinline__ int mod_of_tile(int pm) { return pm < 32 ? 0 : (pm < 64 ? 1 : 2); }
__device__ __forceinline__ int mod_of_row(int r) { return r < SEQ ? 0 : (r < MLAT ? 1 : 2); }

struct EpiInEven {
    static constexpr bool PERM = true, AFTER_DRAIN = false;
    bf16* G1; const float* rope;
    __device__ __forceinline__ void operator()(const pg8::f32x4 (&acc)[2][2][4][2], const pg8::Unit& u, int wr, int wc, int fr, int fq) const {
        const int pn = u.pn; const bool lat = u.pm < 64;
#pragma unroll
        for (int ai = 0; ai < 2; ++ai)
#pragma unroll
            for (int m = 0; m < 4; ++m) {
                const int row = u.pm * 256 + ai * 128 + wr * 64 + m * 16 + fr;
                bf16* rowp = G1 + (size_t)row * NIN_E + pn * 256 + wc * 32 + 8 * fq;
                const int t = row & (SEQ - 1);
#pragma unroll
                for (int bj = 0; bj < 2; ++bj) {
                    f32x4 v0 = acc[ai][bj][m][0], v1 = acc[ai][bj][m][1];
                    if (pn < 4) { v0 = gelu4(v0); v1 = gelu4(v1); }
                    else if (pn < 6 || bj == 0) {
                        if (lat) {
                            const int pos = (wc & 1) ? (t & 63) : (t >> 6);
                            const f32x4* tp = (const f32x4*)(rope + (pos * 16 + 4 * fq) * 2);
                            const f32x4 c0 = tp[0], c1 = tp[1];
                            f32x4 w0, w1;
                            w0[0] = v0[0] * c0[0] - v0[1] * c0[1]; w0[1] = v0[1] * c0[0] + v0[0] * c0[1];
                            w0[2] = v0[2] * c0[2] - v0[3] * c0[3]; w0[3] = v0[3] * c0[2] + v0[2] * c0[3];
                            w1[0] = v1[0] * c1[0] - v1[1] * c1[1]; w1[1] = v1[1] * c1[0] + v1[0] * c1[1];
                            w1[2] = v1[2] * c1[2] - v1[3] * c1[3]; w1[3] = v1[3] * c1[2] + v1[2] * c1[3];
                            v0 = w0; v1 = w1;
                        }
                        if (pn < 6) { v0 = v0 * QSCALE; v1 = v1 * QSCALE; }
                    }
                    v4u w; w.x = pk2(v0[0], v0[1]); w.y = pk2(v0[2], v0[3]); w.z = pk2(v1[0], v1[1]); w.w = pk2(v1[2], v1[3]);
                    *(v4u*)(rowp + bj * 128) = w;
                }
            }
    }
};
struct EpiResid {
    static constexpr bool PERM = true, AFTER_DRAIN = false;
    const float* rin_lat; const float* rin_ctx; float* out_lat; float* out_ctx; const float* gate;
    __device__ __forceinline__ void operator()(const pg8::f32x4 (&acc)[2][2][4][2], const pg8::Unit& u, int wr, int wc, int fr, int fq) const {
        const bool lat = u.pm < 64; const float* g = gate + mod_of_tile(u.pm) * 6144;
        const float* rb = lat ? rin_lat : rin_ctx - (size_t)MLAT * DM; float* ob = lat ? out_lat : out_ctx - (size_t)MLAT * DM;
        const int col0 = u.pn * 256 + wc * 32 + 8 * fq;
        f32x4 gv[2][2];
#pragma unroll
        for (int bj = 0; bj < 2; ++bj)
#pragma unroll
            for (int n = 0; n < 2; ++n) gv[bj][n] = *(const f32x4*)(g + col0 + bj * 128 + 4 * n);
#pragma unroll
        for (int ai = 0; ai < 2; ++ai)
#pragma unroll
            for (int m = 0; m < 4; ++m) {
                const size_t p = (size_t)(u.pm * 256 + ai * 128 + wr * 64 + m * 16 + fr) * DM + col0;
#pragma unroll
                for (int bj = 0; bj < 2; ++bj) {
                    const f32x4 r0 = *(const f32x4*)(rb + p + bj * 128), r1 = *(const f32x4*)(rb + p + bj * 128 + 4);
                    *(f32x4*)(ob + p + bj * 128) = r0 + gv[bj][0] * acc[ai][bj][m][0];
                    *(f32x4*)(ob + p + bj * 128 + 4) = r1 + gv[bj][1] * acc[ai][bj][m][1];
                }
            }
    }
};
struct EpiSwiGLU {
    static constexpr bool PERM = true, AFTER_DRAIN = false;
    bf16* H; int nN;
    __device__ __forceinline__ void operator()(const pg8::f32x4 (&acc)[2][2][4][2], const pg8::Unit& u, int wr, int wc, int fr, int fq) const {
        const int pnl = u.pn % nN, col0 = pnl * 128 + wc * 32 + 8 * fq;
#pragma unroll
        for (int ai = 0; ai < 2; ++ai)
#pragma unroll
            for (int m = 0; m < 4; ++m) {
                const size_t row = (size_t)(u.pm * 256 + ai * 128 + wr * 64 + m * 16 + fr);
                const f32x4 a0 = acc[ai][0][m][0], a1 = acc[ai][0][m][1], b0 = acc[ai][1][m][0], b1 = acc[ai][1][m][1];
                v4u w;
                w.x = pk2(silu_f(a0[0]) * b0[0], silu_f(a0[1]) * b0[1]); w.y = pk2(silu_f(a0[2]) * b0[2], silu_f(a0[3]) * b0[3]);
                w.z = pk2(silu_f(a1[0]) * b1[0], silu_f(a1[1]) * b1[1]); w.w = pk2(silu_f(a1[2]) * b1[2], silu_f(a1[3]) * b1[3]);
                *(v4u*)(H + row * DFF + col0) = w;
            }
    }
};
struct EpiStore {
    static constexpr bool PERM = true, AFTER_DRAIN = false;
    bf16* O; int ldc; int nN; int ngelu;
    __device__ __forceinline__ void operator()(const pg8::f32x4 (&acc)[2][2][4][2], const pg8::Unit& u, int wr, int wc, int fr, int fq) const {
        const int pnl = u.pn % nN, col0 = pnl * 256 + wc * 32 + 8 * fq; const bool g = pnl < ngelu;
#pragma unroll
        for (int ai = 0; ai < 2; ++ai)
#pragma unroll
            for (int m = 0; m < 4; ++m) {
                bf16* rowp = O + (size_t)(u.pm * 256 + ai * 128 + wr * 64 + m * 16 + fr) * ldc + col0;
#pragma unroll
                for (int bj = 0; bj < 2; ++bj) {
                    f32x4 v0 = acc[ai][bj][m][0], v1 = acc[ai][bj][m][1];
                    if (g) { v0 = gelu4(v0); v1 = gelu4(v1); }
                    v4u w; w.x = pk2(v0[0], v0[1]); w.y = pk2(v0[2], v0[3]); w.z = pk2(v1[0], v1[1]); w.w = pk2(v1[2], v1[3]);
                    *(v4u*)(rowp + bj * 128) = w;
                }
            }
    }
};
struct MoeOrder {
    const int* tile_e; int ntiles, nN, G, c;
    __device__ __forceinline__ bool next(int i, pg8::Unit& u) const {
        const long L = (long)i * G + c; if (L >= (long)ntiles * nN) return false;
        const int pm = (int)(L / nN), pn = (int)(L % nN);
        u.pm = pm; u.pn = __builtin_amdgcn_readfirstlane(ld_i32_agent(tile_e + pm)) * nN + pn; u.kb = 0; return true;
    }
    __device__ __forceinline__ void a_ready(const pg8::Unit&) const {}
    __device__ __forceinline__ void done(const pg8::Unit&) const {}
};

struct CtxSplitOrder {
    int nsplit, klen_bytes, G, c;
    __device__ __forceinline__ bool next(int i, pg8::Unit& u) const {
        const int L = i * G + c; if (L >= 8 * nsplit) return false;
        const int tile = L / nsplit, kp = L % nsplit; u.pm = 64 + (tile >> 2); u.pn = tile & 3; u.kb = kp * klen_bytes; return true;
    }
    __device__ __forceinline__ void a_ready(const pg8::Unit&) const {}
    __device__ __forceinline__ void done(const pg8::Unit&) const {}
};
struct EpiPartial {
    static constexpr bool PERM = true, AFTER_DRAIN = false;
    float* part; int klen_bytes;
    __device__ __forceinline__ void operator()(const pg8::f32x4 (&acc)[2][2][4][2], const pg8::Unit& u, int wr, int wc, int fr, int fq) const {
        float* pb = part + (size_t)(u.kb / klen_bytes) * MCTX * DM; const int col0 = u.pn * 256 + wc * 32 + 8 * fq;
#pragma unroll
        for (int ai = 0; ai < 2; ++ai)
#pragma unroll
            for (int m = 0; m < 4; ++m) {
                const size_t p = (size_t)((u.pm - 64) * 256 + ai * 128 + wr * 64 + m * 16 + fr) * DM + col0;
#pragma unroll
                for (int bj = 0; bj < 2; ++bj) { *(f32x4*)(pb + p + bj * 128) = acc[ai][bj][m][0]; *(f32x4*)(pb + p + bj * 128 + 4) = acc[ai][bj][m][1]; }
            }
    }
};
#define XB_TMO      128
#define XB_XCNT(j)  (256  + 64 * (j))
#define XB_XSUB(j)  (1280 + 64 * (j))
#define XB_XGEN(j)  (2304 + 64 * (j))
#define XB_TOP      3328
#define XB_TOPGEN   3392
#define XCD_BAR_WORDS 3456
#define XB_SPIN_CAP (1u << 18)

__device__ __forceinline__ unsigned xb_ld(unsigned* p)              { return __hip_atomic_load(p, __ATOMIC_RELAXED, __HIP_MEMORY_SCOPE_AGENT); }
__device__ __forceinline__ unsigned xb_add(unsigned* p, unsigned v) { return __hip_atomic_fetch_add(p, v, __ATOMIC_RELAXED, __HIP_MEMORY_SCOPE_AGENT); }
__device__ __forceinline__ unsigned xb_xcc_id() { return (unsigned)__builtin_amdgcn_s_getreg((3 << 11) | 20) & 0xFu; }
#define XB_SPIN(cond, bar) do { unsigned _sp = 0; while (cond) { __builtin_amdgcn_s_sleep(1); \
    if ((++_sp & 255u) == 0u) { if (xb_ld(&(bar)[XB_TMO])) break; if (_sp > XB_SPIN_CAP) { atomicAdd(&(bar)[XB_TMO], 1u); break; } } } } while (0)

struct XcdBarrier {
    unsigned* bar; unsigned x;
    volatile LAS unsigned* st;
};

__device__ __forceinline__ XcdBarrier xcd_barrier_post(unsigned* bar, volatile LAS unsigned* st, const bool t0) {
    XcdBarrier b; b.bar = bar; b.x = xb_xcc_id(); b.st = st;
    if (t0) (void)xb_add(&bar[XB_XCNT(b.x)], 1u);
    return b;
}
__device__ __forceinline__ void xcd_barrier_complete(unsigned* bar, unsigned x, unsigned& nloc, unsigned& nx) {
    const unsigned G = gridDim.x * gridDim.y * gridDim.z;
    unsigned sum, cnt, mine, sp = 0u;
    for (;;) {
        sum = 0u; cnt = 0u; mine = 0u;
#pragma unroll
        for (unsigned j = 0; j < 16; ++j) { const unsigned c = xb_ld(&bar[XB_XCNT(j)]); sum += c; cnt += (c > 0u) ? 1u : 0u; mine = (j == x) ? c : mine; }
        if (sum == G) break;
        __builtin_amdgcn_s_sleep(1);
        if ((++sp & 255u) == 0u) { if (xb_ld(&bar[XB_TMO])) break; if (sp > XB_SPIN_CAP) { atomicAdd(&bar[XB_TMO], 1u); break; } }
    }
    nloc = mine > 0u ? mine : 1u; nx = cnt > 0u ? cnt : 1u;
}

__device__ __forceinline__ void xcd_barrier(const XcdBarrier& b, const bool t0) {
    asm volatile("s_waitcnt vmcnt(0)" ::: "memory");
    __syncthreads();
    if (t0) {
        unsigned* bar = b.bar;
        __builtin_amdgcn_s_waitcnt(0);
        unsigned nloc = b.st[0], nx = b.st[1];
        if (nloc == 0u) { xcd_barrier_complete(bar, b.x, nloc, nx); b.st[0] = nloc; b.st[1] = nx; }
        const unsigned old = xb_add(&bar[XB_XSUB(b.x)], 1u);
        const unsigned gen = old / nloc;
        if (old + 1u == (gen + 1u) * nloc) {
            __builtin_amdgcn_fence(__ATOMIC_RELEASE, "agent");
            asm volatile("s_waitcnt vmcnt(0)" ::: "memory");
            const unsigned og = xb_add(&bar[XB_TOP], 1u);
            const unsigned tg = og / nx;
            if (og + 1u == (tg + 1u) * nx) xb_add(&bar[XB_TOPGEN], 1u);
            else XB_SPIN(xb_ld(&bar[XB_TOPGEN]) == tg, bar);
            __builtin_amdgcn_fence(__ATOMIC_ACQUIRE, "agent");
            xb_add(&bar[XB_XGEN(b.x)], 1u);
            asm volatile("s_waitcnt vmcnt(0)" ::: "memory");
        } else {
            XB_SPIN(xb_ld(&bar[XB_XGEN(b.x)]) == gen, bar);
            __builtin_amdgcn_fence(__ATOMIC_ACQUIRE, "agent");
            asm volatile("s_waitcnt vmcnt(0)" ::: "memory");
        }
    }
    __syncthreads();
}

constexpr size_t MiB = 1u << 20;
constexpr size_t WS_CTL = 0, CTL_ZERO_BYTES = 1 * MiB;
constexpr size_t WS_MOD = 1 * MiB;
constexpr size_t WS_ROPE = 1 * MiB + 256 * 1024;
constexpr size_t WS_TOKE = 1 * MiB + 512 * 1024;
constexpr size_t WS_TOKG = WS_TOKE + 128 * 1024;
constexpr size_t WS_TOKR = WS_TOKG + 128 * 1024;
constexpr size_t WS_TOKS = WS_TOKR + 128 * 1024;
constexpr size_t WS_META = 2 * MiB;
constexpr size_t WS_SA = 2 * MiB + 256 * 1024, WS_SH = 3 * MiB;
constexpr size_t WS_SGW = 35 * MiB + 768 * 1024;
constexpr size_t WS_LW = 34 * MiB + 512 * 1024;
constexpr size_t WS_WINE = 4 * MiB, WS_WOUTE = 8 * MiB, WS_FFN13 = 10 * MiB, WS_FFN2 = 21 * MiB, WS_WINO = 27 * MiB, WS_WOUTO = 32 * MiB;
constexpr size_t WS_MOE13 = 36 * MiB, WS_MOE2 = 124 * MiB;
constexpr size_t WS_H = 168 * MiB;
constexpr size_t WS_G1 = 201 * MiB;
constexpr size_t WS_PART = 201 * MiB;
constexpr size_t WS_MIX = 259 * MiB;
constexpr size_t WS_XC = 292 * MiB;
constexpr size_t WS_FH = 294 * MiB;
constexpr size_t WS_G2 = 201 * MiB;
constexpr size_t WS_Y1 = 284 * MiB;
constexpr size_t WS_LAF = 36 * MiB, WS_BBF = 78 * MiB, WS_LAB = 120 * MiB, WS_BBB = 324 * MiB, WS_HF = 366 * MiB;
constexpr size_t WS_HP = 168 * MiB;
constexpr size_t WS_MH = 236 * MiB;
constexpr size_t WS_YD = 36 * MiB;
constexpr size_t WS_NEED = 424 * MiB;
constexpr int CW_CNT = 64;
constexpr int CW_BAR = 4096;

constexpr int RING_BYTES = 143360, LDSCTL_OFF = RING_BYTES, MISC_OFF = LDSCTL_OFF + 320, LDS_BYTES = 147456;
constexpr int NWAVES = 8, NTHR = 512;

enum Phase { PH_PRO = 0, PH_NORM1E, PH_GIN_E, PH_MIX_E, PH_GOUT_E, PH_NORM2E, PH_FFN_UP, PH_FFN_DN, PH_NORM1O, PH_GIN_O, PH_LRU_G, PH_LRU_S, PH_GOUT_O, PH_ROUTE, PH_PERM,
             PH_MOE_UP, PH_MOE_DN, PH_COMB, NPH };
#ifndef MK_ONE_LAUNCH
#define MK_ONE_LAUNCH 1
#endif

struct Args { const float* in[34]; float* out; unsigned char* ws; int ph_lo, ph_hi; };
struct Frame {
    LAS unsigned char* lds; volatile LAS unsigned* MISC; gu32* ctl;
    int wave, vcu, G;
};

struct MapId { __device__ __forceinline__ int operator()(int n) const { return n; } };
struct MapRope {
    __device__ __forceinline__ int operator()(int n) const {
        if (n < COL_Q || n >= COL_VAL) return n;
        const int base = n < COL_K ? COL_Q : COL_K, r = n - base, h = r >> 6, d = r & 63;
        return base + h * 64 + (d & 32) + 2 * (d & 15) + ((d >> 4) & 1);
    }
};
struct MapGLU { int off; __device__ __forceinline__ int operator()(int n) const { return (n >> 7) * 256 + off + (n & 127); } };

template <class RowMap>
__device__ __forceinline__ void tr_item(const float* W, int K, int N, bf16* WT, LAS float* scr, int item, int lane, RowMap rm) {
    const int nblk = N / 32, kb = item / nblk, nb = item % nblk, k0 = 64 * kb, n0 = 32 * nb;
    float ld[32];
#pragma unroll
    for (int i = 0; i < 32; ++i) ld[i] = W[(size_t)(k0 + 2 * i + (lane >> 5)) * N + n0 + (lane & 31)];
#pragma unroll
    for (int i = 0; i < 32; ++i) scr[(2 * i + (lane >> 5)) * 33 + (lane & 31)] = ld[i];
    LDS_WAIT(); asm volatile("" ::: "memory");
    const int c = lane & 7;
#pragma unroll
    for (int j = 0; j < 4; ++j) { const int n = (lane >> 3) + 8 * j; const LAS float* s = scr + (8 * c) * 33 + n;
        v4u o; o.x = pk2(s[0 * 33], s[1 * 33]); o.y = pk2(s[2 * 33], s[3 * 33]); o.z = pk2(s[4 * 33], s[5 * 33]); o.w = pk2(s[6 * 33], s[7 * 33]);
        *(GAS v4u*)(WT + (size_t)rm(n0 + n) * K + k0 + 8 * c) = o; }
    LDS_WAIT(); asm volatile("" ::: "memory");
}

__device__ __forceinline__ void ph_prologue(const Args& A, Frame& F) {
    const int lane = lane_id_asm(), tid = F.wave * 64 + lane; (void)tid;
    unsigned char* ws = A.ws;
    LAS float* sact = (LAS float*)F.lds;
    LAS float* red = sact + 3 * 1024;
    for (int t = tid; t < 3 * 1024; t += NTHR) { const int v = t >> 10, k = t & 1023; const float x = v < 2 ? A.in[1][v * 1024 + k] : A.in[3][k]; sact[t] = silu_f(x); }
    __syncthreads();
    float* mod = (float*)(ws + WS_MOD);
    for (int item = blockIdx.x; item < 256; item += F.G) {
        const int L = item >> 7, ch = item & 127; const float* W = (L ? A.in[16] : A.in[4]) + ch * 48; const float* bias = (L ? A.in[17] : A.in[5]);
        if (tid < 504) {
            const int c4 = tid % 12, ks = tid / 12; f32x4 a0 = {0.f, 0.f, 0.f, 0.f}, a1 = a0, a2 = a0;
#pragma unroll 8
            for (int k = ks; k < 1024; k += 42) { const f32x4 w = *(const f32x4*)(W + (size_t)k * 6144 + c4 * 4); a0 += sact[k] * w; a1 += sact[1024 + k] * w; a2 += sact[2048 + k] * w; }
            LAS float* r = red + ks * 144 + c4 * 4;
#pragma unroll
            for (int j = 0; j < 4; ++j) { r[j] = a0[j]; r[48 + j] = a1[j]; r[96 + j] = a2[j]; }
        }
        __syncthreads();
        if (tid < 144) { const int v = tid / 48, cc = tid % 48, n = ch * 48 + cc; float s = 0.f; for (int ks = 0; ks < 42; ++ks) s += red[ks * 144 + tid]; mod[(L * 3 + v) * 6144 + n] = s + bias[n]; }
        __syncthreads();
    }
    { const int idx = blockIdx.x * NTHR + tid; if (idx < 128 * 16) { const int pos = idx >> 4, f = idx & 15; const float freq = fexp2(-(float)f * (13.287712379549449f / 16.f)); const float rev = (float)pos * freq * 0.15915494309189535f;
        float* rp = (float*)(ws + WS_ROPE) + idx * 2; rp[0] = __builtin_amdgcn_cosf(rev); rp[1] = __builtin_amdgcn_sinf(rev); } }
    { const int idx = blockIdx.x * NTHR + tid; if (idx < 4 * 128 * 128 / 4) { const f32x4 v = ((const f32x4*)A.in[9])[idx]; v2u o; o.x = pk2(v[0], v[1]); o.y = pk2(v[2], v[3]); ((v2u*)(ws + WS_SGW))[idx] = o; } }
    LAS float* scr = (LAS float*)(F.lds + F.wave * 16384);
    const int gw = F.vcu * NWAVES + F.wave, NGW = F.G * NWAVES;
    constexpr int I_WINE = 16 * 56, I_WOUTE = 16 * 32, I_F1 = 16 * 88, I_F2 = 44 * 32, I_WINO = 16 * 80, I_WOUTO = 20 * 32;
    constexpr int I_LW = 2 * 20 * 8;
    constexpr int NITEMS = I_WINE + I_WOUTE + 2 * I_F1 + I_F2 + I_WINO + I_WOUTO + I_LW;
    for (int it = gw; it < NITEMS; it += NGW) {
        int r = it;
        if (r < I_WINE) { tr_item(A.in[8], DM, NIN_E, (bf16*)(ws + WS_WINE), scr, r, lane, MapRope{}); continue; } r -= I_WINE;
        if (r < I_WOUTE) { tr_item(A.in[12], DM, DM, (bf16*)(ws + WS_WOUTE), scr, r, lane, MapId{}); continue; } r -= I_WOUTE;
        if (r < I_F1) { tr_item(A.in[13], DM, DFF, (bf16*)(ws + WS_FFN13), scr, r, lane, MapGLU{0}); continue; } r -= I_F1;
        if (r < I_F1) { tr_item(A.in[14], DM, DFF, (bf16*)(ws + WS_FFN13), scr, r, lane, MapGLU{128}); continue; } r -= I_F1;
        if (r < I_F2) { tr_item(A.in[15], DFF, DM, (bf16*)(ws + WS_FFN2), scr, r, lane, MapId{}); continue; } r -= I_F2;
        if (r < I_WINO) { tr_item(A.in[20], DM, NIN_O, (bf16*)(ws + WS_WINO), scr, r, lane, MapId{}); continue; } r -= I_WINO;
        if (r < I_WOUTO) { tr_item(A.in[28], DRNN, DM, (bf16*)(ws + WS_WOUTO), scr, r, lane, MapId{}); continue; } r -= I_WOUTO;
        { const int g = r / 160, mi = (r % 160) / 8, item = r % 8, dd = mi / 10, blk = mi % 10;
          tr_item(A.in[g ? 25 : 23] + (size_t)mi * 16384, 128, 128, (bf16*)(ws + WS_LW) + (size_t)((dd * 2 + g) * 10 + blk) * 16384, scr, item, lane, MapId{}); }
    }
}
__device__ __forceinline__ void ph_convert_moe(const Args& A, Frame& F) {
    const int lane = lane_id_asm(), tid = F.wave * 64 + lane; (void)tid;
    unsigned char* ws = A.ws;
    LAS float* scr = (LAS float*)(F.lds + F.wave * 16384);
    const int gw = F.vcu * NWAVES + F.wave, NGW = F.G * NWAVES;
    constexpr int I_F1 = 16 * 88, I_F2 = 44 * 32, PER_E = 2 * I_F1 + I_F2;
    for (int it = gw; it < NEXP * PER_E; it += NGW) {
        const int e = it / PER_E; int r = it % PER_E;
        bf16* w13 = (bf16*)(ws + WS_MOE13) + (size_t)e * NFF2 * DM; bf16* w2 = (bf16*)(ws + WS_MOE2) + (size_t)e * DM * DFF;
        if (r < I_F1) { tr_item(A.in[30] + (size_t)e * DM * DFF, DM, DFF, w13, scr, r, lane, MapGLU{0}); continue; } r -= I_F1;
        if (r < I_F1) { tr_item(A.in[31] + (size_t)e * DM * DFF, DM, DFF, w13, scr, r, lane, MapGLU{128}); continue; } r -= I_F1;
        tr_item(A.in[32] + (size_t)e * DFF * DM, DFF, DM, w2, scr, r, lane, MapId{});
    }
}

__device__ __forceinline__ void norm_mod_v(const float* gain, const float* scale, const float* shift, int lane, f32x4 (&v)[4]) {
    float ss = 0.f;
#pragma unroll
    for (int j = 0; j < 4; ++j) ss += (v[j][0] * v[j][0] + v[j][1] * v[j][1]) + (v[j][2] * v[j][2] + v[j][3] * v[j][3]);
    const float rstd = 1.f / sqrtf(wave_sum(ss) * (1.f / DM) + EPS);
#pragma unroll
    for (int j = 0; j < 4; ++j) { const f32x4 g = ((const f32x4*)gain)[lane + 64 * j], sc = ((const f32x4*)scale)[lane + 64 * j], sh = ((const f32x4*)shift)[lane + 64 * j];
        v[j] = v[j] * rstd * g * (1.f + sc) + sh; }
}
__device__ __forceinline__ void norm_mod_regs(const float* xrow, const float* gain, const float* scale, const float* shift, int lane, f32x4 (&v)[4]) {
    const f32x4* xr = (const f32x4*)xrow + lane;
#pragma unroll
    for (int j = 0; j < 4; ++j) v[j] = xr[64 * j];
    norm_mod_v(gain, scale, shift, lane, v);
}
struct CtxFix { const float* part; int nsplit; const float* gate; const float* base; float* xout; };
__device__ __forceinline__ void ph_norm(Frame& F, const float* xl, const float* xc, const float* gain, const float* modL, int p_shift, int p_scale, bf16* H, int nrows, const CtxFix cf) {
    const int lane = lane_id_asm();
    const int gw = F.vcu * NWAVES + F.wave, NGW = F.G * NWAVES;
    for (int r = gw; r < nrows; r += NGW) {
        const float* md = modL + mod_of_row(r) * 6144;
        f32x4 v[4];
        if (r >= MLAT && cf.nsplit > 0) {
            const size_t ro = (size_t)(r - MLAT) * DM;
#pragma unroll
            for (int j = 0; j < 4; ++j) { f32x4 s = ((const f32x4*)(cf.part + ro))[lane + 64 * j];
                for (int kp = 1; kp < cf.nsplit; ++kp) s += ((const f32x4*)(cf.part + (size_t)kp * MCTX * DM + ro))[lane + 64 * j];
                v[j] = ((const f32x4*)(cf.base + ro))[lane + 64 * j] + ((const f32x4*)cf.gate)[lane + 64 * j] * s;
                ((f32x4*)(cf.xout + ro))[lane + 64 * j] = v[j]; }
        } else {
            const f32x4* xr = (const f32x4*)(r < MLAT ? xl + (size_t)r * DM : xc + (size_t)(r - MLAT) * DM) + lane;
#pragma unroll
            for (int j = 0; j < 4; ++j) v[j] = xr[64 * j];
        }
        norm_mod_v(gain, md + p_scale * 1024, md + p_shift * 1024, lane, v);
        GAS v2u* o = (GAS v2u*)(H + (size_t)r * DM) + lane;
#pragma unroll
        for (int j = 0; j < 4; ++j) { v2u w; w.x = pk2(v[j][0], v[j][1]); w.y = pk2(v[j][2], v[j][3]); o[64 * j] = w; }
    }
}

__device__ __forceinline__ void route_row(const Args& A, const LAS float* rw, int t, int lane, f32x4 (&v)[4], float (&lg)[8]) {
    const float* md = (const float*)(A.ws + WS_MOD) + (3 + (t >> 13)) * 6144;
    norm_mod_regs(A.out + (size_t)t * DM, A.in[19], md + 4 * 1024, md + 3 * 1024, lane, v);
#pragma unroll
    for (int e = 0; e < 8; ++e) { float s = 0.f;
#pragma unroll
        for (int j = 0; j < 4; ++j) { const f32x4 w = *(const LAS f32x4*)(rw + e * 1024 + 4 * (lane + 64 * j)); s += (v[j][0] * w[0] + v[j][1] * w[1]) + (v[j][2] * w[2] + v[j][3] * w[3]); }
        lg[e] = wave_sum(s); }
}
__device__ __forceinline__ void ph_route(const Args& A, Frame& F) {
    const int lane = lane_id_asm(), tid = F.wave * 64 + lane;
    LAS float* rw = (LAS float*)F.lds; LAS unsigned* lcnt = (LAS unsigned*)(F.lds + 32768);
    for (int i = tid; i < DM * 8; i += NTHR) rw[(i & 7) * 1024 + (i >> 3)] = A.in[29][i];
    if (tid < 16) lcnt[tid] = 0u;
    __syncthreads();
    int* toke = (int*)(A.ws + WS_TOKE); float* tokg = (float*)(A.ws + WS_TOKG); int* tokr = (int*)(A.ws + WS_TOKR);
    for (int t0 = blockIdx.x * 64; t0 < MLAT; t0 += F.G * 64) {
        for (int i = 0; i < 8; ++i) {
            const int t = t0 + F.wave * 8 + i;
            f32x4 v[4]; float lg[8]; route_row(A, rw, t, lane, v, lg);
            int i0 = 0; float l0 = lg[0];
#pragma unroll
            for (int e = 1; e < 8; ++e) if (lg[e] > l0) { l0 = lg[e]; i0 = e; }
            int i1 = -1; float l1 = -INFINITY;
#pragma unroll
            for (int e = 0; e < 8; ++e) if (e != i0 && lg[e] > l1) { l1 = lg[e]; i1 = e; }
            const float g0 = 1.f / (1.f + expf(l1 - l0)), g1 = 1.f - g0;
            if (lane == 0) {
                const int r0 = (int)__hip_atomic_fetch_add(lcnt + i0, 1u, __ATOMIC_RELAXED, __HIP_MEMORY_SCOPE_WORKGROUP), r1 = (int)__hip_atomic_fetch_add(lcnt + i1, 1u, __ATOMIC_RELAXED, __HIP_MEMORY_SCOPE_WORKGROUP);
                toke[t] = i0; toke[MLAT + t] = i1; tokg[t] = g0; tokg[MLAT + t] = g1; tokr[t] = r0; tokr[MLAT + t] = r1;
            }
        }
        __syncthreads();
        if (tid < 8) { const unsigned c = lcnt[tid]; lcnt[8 + tid] = c ? __hip_atomic_fetch_add((unsigned*)(F.ctl + CW_CNT + 16 * tid), c, RLX_AGENT) : 0u; }
        __syncthreads();
        if (tid < 128) { const int idx = (tid & 1) * MLAT + t0 + (tid >> 1); tokr[idx] += (int)lcnt[8 + toke[idx]]; }
        __syncthreads();
        if (tid < 8) lcnt[tid] = 0u;
        __syncthreads();
    }
}
__device__ __forceinline__ void ph_permute(const Args& A, Frame& F) {
    const int lane = lane_id_asm(), tid = F.wave * 64 + lane; (void)tid;
    const int* toke = (const int*)(A.ws + WS_TOKE); const int* tokr = (const int*)(A.ws + WS_TOKR); int* toks = (int*)(A.ws + WS_TOKS); int* meta = (int*)(A.ws + WS_META); bf16* HP = (bf16*)(A.ws + WS_HP);
    int off[8]; int tot = 0;
#pragma unroll
    for (int e = 0; e < 8; ++e) { const int c = (int)__hip_atomic_load((unsigned*)(F.ctl + CW_CNT + 16 * e), RLX_AGENT); off[e] = tot; tot += ((c + 255) >> 8) << 8; }
    if (blockIdx.x == 0 && tid < MOE_MAXT + 8) { int e = 0;
#pragma unroll
        for (int k = 1; k < 8; ++k) if (tid * 256 >= off[k]) e = k;
        meta[tid] = e; if (tid == 0) meta[256] = tot >> 8; }
    const int gw = F.vcu * NWAVES + F.wave, NGW = F.G * NWAVES;
    for (int t = gw; t < MLAT; t += NGW) {
        const float* md = (const float*)(A.ws + WS_MOD) + (3 + (t >> 13)) * 6144;
        f32x4 v[4]; norm_mod_regs(A.out + (size_t)t * DM, A.in[19], md + 4 * 1024, md + 3 * 1024, lane, v);
        const int e0 = toke[t], e1 = toke[MLAT + t]; int s0 = tokr[t], s1 = tokr[MLAT + t];
        int o0 = 0, o1 = 0;
#pragma unroll
        for (int k = 0; k < 8; ++k) { if (k == e0) o0 = off[k]; if (k == e1) o1 = off[k]; }
        s0 += o0; s1 += o1;
        GAS v2u* p0 = (GAS v2u*)(HP + (size_t)s0 * DM) + lane; GAS v2u* p1 = (GAS v2u*)(HP + (size_t)s1 * DM) + lane;
#pragma unroll
        for (int j = 0; j < 4; ++j) { v2u w; w.x = pk2(v[j][0], v[j][1]); w.y = pk2(v[j][2], v[j][3]); p0[64 * j] = w; p1[64 * j] = w; }
        if (lane == 0) { toks[t] = s0; toks[MLAT + t] = s1; }
    }
}
__device__ __forceinline__ void ph_combine(const Args& A, Frame& F, float* outp) {
    const int lane = lane_id_asm(), tid = F.wave * 64 + lane; (void)tid;
    const float* tokg = (const float*)(A.ws + WS_TOKG); const int* tokr = (const int*)(A.ws + WS_TOKS); const bf16* YD = (const bf16*)(A.ws + WS_YD); const float* fn = A.in[33];
    const int gw = F.vcu * NWAVES + F.wave, NGW = F.G * NWAVES;
    for (int t = gw; t < MLAT; t += NGW) {
        const float* g2 = (const float*)(A.ws + WS_MOD) + (3 + (t >> 13)) * 6144 + 5 * 1024;
        const int s0 = tokr[t], s1 = tokr[MLAT + t]; const float g0 = tokg[t], g1 = tokg[MLAT + t];
        const f32x4* xr = (const f32x4*)(A.out + (size_t)t * DM) + lane; f32x4* orow = (f32x4*)(outp + (size_t)t * DM) + lane; const v2u* y0 = (const v2u*)(YD + (size_t)s0 * DM) + lane; const v2u* y1 = (const v2u*)(YD + (size_t)s1 * DM) + lane;
        f32x4 z[4]; float ss = 0.f;
#pragma unroll
        for (int j = 0; j < 4; ++j) { const f32x4 x = xr[64 * j], g = ((const f32x4*)g2)[lane + 64 * j]; const v2u a = y0[64 * j], b = y1[64 * j];
            f32x4 m; m[0] = g0 * bflo(a.x) + g1 * bflo(b.x); m[1] = g0 * bfhi(a.x) + g1 * bfhi(b.x); m[2] = g0 * bflo(a.y) + g1 * bflo(b.y); m[3] = g0 * bfhi(a.y) + g1 * bfhi(b.y);
            z[j] = x + g * m; ss += (z[j][0] * z[j][0] + z[j][1] * z[j][1]) + (z[j][2] * z[j][2] + z[j][3] * z[j][3]); }
        const float rstd = 1.f / sqrtf(wave_sum(ss) * (1.f / DM) + EPS);
#pragma unroll
        for (int j = 0; j < 4; ++j) orow[64 * j] = z[j] * rstd * ((const f32x4*)fn)[lane + 64 * j];
    }
}

constexpr int RCP = 272, HFL_OFF = 256 * RCP;
__device__ __forceinline__ void lru_ab(float rp, float ip, float rcv, float nba, float nbx, float kc, float& a, float& b) {
    const float rg = frcp(1.f + fexp2(fmaf(rp, -LOG2E, nba)));
    const float ig = frcp(1.f + fexp2(fmaf(ip, -LOG2E, nbx)));
    const float la = kc * rg;
    a = fexp2(la * LOG2E);
    const float x = 2.f * la;
    const float om = -x * (1.f + x * (0.5f + x * (0.16666667f + x * (0.041666668f + x * (0.008333334f + x * 0.0013888889f)))));
    b = __builtin_amdgcn_sqrtf(om) * (ig * rcv);
}
template <bool PASS3>
__device__ __forceinline__ void lru_unit(const Args& A, Frame& F, int pm, int blk) {
    const bf16* G2 = (const bf16*)(A.ws + WS_G2);
    LAS unsigned char* rcT = F.lds;
    const int lane = lane_id_asm(), tid = F.wave * 64 + lane, r0 = pm * 256, w = F.wave, c = lane & 15, q = lane >> 4;
    int seg_lo, seg_hi; if (pm < 64) { seg_lo = (pm >> 5) * SEQ; seg_hi = seg_lo + SEQ; } else { seg_lo = r0; seg_hi = r0 + 256; }
    {
        const int c8 = tid & 15, rgp = tid >> 4, ch0 = blk * 128 + c8 * 8;
        const float* cw = A.in[21]; const float* cb = A.in[22];
        f32x4 wj[4][2], cbv[2];
#pragma unroll
        for (int j = 0; j < 4; ++j) { wj[j][0] = *(const f32x4*)(cw + j * DRNN + ch0); wj[j][1] = *(const f32x4*)(cw + j * DRNN + ch0 + 4); }
        cbv[0] = *(const f32x4*)(cb + ch0); cbv[1] = *(const f32x4*)(cb + ch0 + 4);
        v4u x[11];
#pragma unroll
        for (int i = 0; i < 11; ++i) { const int grow = r0 + rgp * 8 + i - 2; const bool ok = (grow >= seg_lo) && (grow < seg_hi); const int gc = grow < seg_lo ? seg_lo : (grow >= seg_hi ? seg_hi - 1 : grow);
            const v4u t = *(const v4u*)(G2 + (size_t)gc * NIN_O + DRNN + ch0); x[i].x = ok ? t.x : 0u; x[i].y = ok ? t.y : 0u; x[i].z = ok ? t.z : 0u; x[i].w = ok ? t.w : 0u; }
#pragma unroll
        for (int r = 0; r < 8; ++r) { f32x4 o0 = cbv[0], o1 = cbv[1];
#pragma unroll
            for (int j = 0; j < 4; ++j) { const v4u t = x[r + j]; o0 += wj[j][0] * (f32x4){bflo(t.x), bfhi(t.x), bflo(t.y), bfhi(t.y)}; o1 += wj[j][1] * (f32x4){bflo(t.z), bfhi(t.z), bflo(t.w), bfhi(t.w)}; }
            v4u pk; pk.x = pk2(o0[0], o0[1]); pk.y = pk2(o0[2], o0[3]); pk.z = pk2(o1[0], o1[1]); pk.w = pk2(o1[2], o1[3]);
            *(LAS v4u*)(rcT + (rgp * 8 + r) * RCP + c8 * 16) = pk; }
    }
    __syncthreads();
    const int ch = blk * 128 + 16 * w + c;
    float* SA = (float*)(A.ws + WS_SA); float* SH = (float*)(A.ws + WS_SH);
    pg8::bf16x8 Bid;
#pragma unroll
    for (int e = 0; e < 8; ++e) Bid[e] = (8 * q + e == (w & 1) * 16 + c) ? (short)0x3F80 : (short)0;
    float cin = 0.f;
    if (PASS3) {
        const int d = (lane >> 4) & 1, b = pm >> 5; const int chc = blk * 128 + 16 * w + (lane & 15);
#pragma unroll 11
        for (int s = 0; s < 33; ++s) {
            int T; bool ok;
            if (s == 0) { T = 64 + b; ok = true; } else if (d == 0) { T = 32 * b + s - 1; ok = T < pm; } else { T = 32 * b + 32 - s; ok = T > pm; }
            const int Tc = ok ? T : pm;
            const float av = SA[(size_t)(Tc * 2 + d) * DRNN + chc], hv = SH[(size_t)(Tc * 2 + d) * DRNN + chc];
            if (ok) cin = av * cin + hv;
        }
    }
    LAS unsigned* hfl = (LAS unsigned*)(F.lds + HFL_OFF + w * 8192) + lane;
    bf16* Y1 = (bf16*)(A.ws + WS_Y1);
#pragma unroll
    for (int d = 0; d < 2; ++d) {
        const float nba = -LOG2E * A.in[24][d * DRNN + ch], nbx = -LOG2E * A.in[26][d * DRNN + ch], kc = -8.f * log1pf(expf(-A.in[27][d * DRNN + ch]));
        pg8::bf16x8 Bw[2][4];
        { const bf16* LW = (const bf16*)(A.ws + WS_LW);
#pragma unroll
          for (int g = 0; g < 2; ++g)
#pragma unroll
            for (int ks = 0; ks < 4; ++ks) Bw[g][ks] = *(const pg8::bf16x8*)(LW + (size_t)((d * 2 + g) * 10 + blk) * 16384 + (16 * w + c) * 128 + ks * 32 + 8 * q); }
        float a_run = 1.f, h_run = PASS3 ? __shfl(cin, d * 16 + c) : 0.f;
#pragma unroll 1
        for (int gi = 0; gi < 4; ++gi) {
            const int g4 = d == 0 ? gi : 3 - gi;
            float gt[4][4];
            if (PASS3 && d == 1) {
#pragma unroll
                for (int mm = 0; mm < 4; ++mm)
#pragma unroll
                    for (int r = 0; r < 4; ++r) gt[mm][r] = bf2f(G2[(size_t)(r0 + (g4 * 4 + mm) * 16 + 4 * q + r) * NIN_O + ch]);
            }
            pg8::f32x4 acc[2][4], rcv[4];
#pragma unroll
            for (int mm = 0; mm < 4; ++mm) { acc[0][mm] = (pg8::f32x4){0.f, 0.f, 0.f, 0.f}; acc[1][mm] = acc[0][mm]; rcv[mm] = acc[0][mm]; }
#pragma unroll
            for (int mm = 0; mm < 4; ++mm) {
                const LAS unsigned char* ap = rcT + ((g4 * 4 + mm) * 16 + c) * RCP + q * 16;
                pg8::bf16x8 af[4];
#pragma unroll
                for (int ks = 0; ks < 4; ++ks) af[ks] = *(const LAS pg8::bf16x8*)(ap + ks * 64);
                const pg8::bf16x8 afi = *(const LAS pg8::bf16x8*)(ap + (w >> 1) * 64);
#pragma unroll
                for (int ks = 0; ks < 4; ++ks) {
                    acc[0][mm] = __builtin_amdgcn_mfma_f32_16x16x32_bf16(af[ks], Bw[0][ks], acc[0][mm], 0, 0, 0);
                    acc[1][mm] = __builtin_amdgcn_mfma_f32_16x16x32_bf16(af[ks], Bw[1][ks], acc[1][mm], 0, 0, 0);
                }
                rcv[mm] = __builtin_amdgcn_mfma_f32_16x16x32_bf16(afi, Bid, rcv[mm], 0, 0, 0);
            }
#pragma unroll
            for (int mmi = 0; mmi < 4; ++mmi) {
                const int mm = d == 0 ? mmi : 3 - mmi, m = g4 * 4 + mm;
                float av[4], bv[4];
#pragma unroll
                for (int r = 0; r < 4; ++r) lru_ab(acc[0][mm][r], acc[1][mm][r], rcv[mm][r], nba, nbx, kc, av[r], bv[r]);
                float A4, B4;
                if (d == 0) { A4 = av[0] * av[1] * av[2] * av[3]; B4 = ((bv[0] * av[1] + bv[1]) * av[2] + bv[2]) * av[3] + bv[3]; }
                else        { A4 = av[0] * av[1] * av[2] * av[3]; B4 = ((bv[3] * av[2] + bv[2]) * av[1] + bv[1]) * av[0] + bv[0]; }
                float TA[4], TB[4];
#pragma unroll
                for (int k = 0; k < 4; ++k) { TA[k] = __shfl(A4, c + 16 * k); TB[k] = __shfl(B4, c + 16 * k); }
                float EA = 1.f, EB = 0.f, PA = 1.f, PB = 0.f;
#pragma unroll
                for (int k = 0; k < 4; ++k) { const int kk = d == 0 ? k : 3 - k; if (kk == q) { EA = PA; EB = PB; } PB = TA[kk] * PB + TB[kk]; PA = PA * TA[kk]; }
                if (PASS3) {
                    float h = EA * h_run + EB; float hv[4];
#pragma unroll
                    for (int ri = 0; ri < 4; ++ri) { const int r = d == 0 ? ri : 3 - ri; h = av[r] * h + bv[r]; hv[r] = h; }
                    if (d == 0) { hfl[(m * 2 + 0) * 64] = pk2(hv[0], hv[1]); hfl[(m * 2 + 1) * 64] = pk2(hv[2], hv[3]); }
                    else { const unsigned f0 = hfl[(m * 2 + 0) * 64], f1 = hfl[(m * 2 + 1) * 64];
                        const size_t row = (size_t)(r0 + m * 16 + 4 * q);
                        Y1[(row + 0) * DRNN + ch] = f2bf1(gt[mm][0] * (bflo(f0) + hv[0])); Y1[(row + 1) * DRNN + ch] = f2bf1(gt[mm][1] * (bfhi(f0) + hv[1]));
                        Y1[(row + 2) * DRNN + ch] = f2bf1(gt[mm][2] * (bflo(f1) + hv[2])); Y1[(row + 3) * DRNN + ch] = f2bf1(gt[mm][3] * (bfhi(f1) + hv[3])); }
                }
                h_run = PA * h_run + PB; a_run *= PA;
            }
        }
        if (!PASS3) { if (q == 0) { SA[(size_t)(pm * 2 + d) * DRNN + ch] = a_run; SH[(size_t)(pm * 2 + d) * DRNN + ch] = h_run; } }
    }
    __syncthreads();
}
template <bool PASS3>
__device__ __forceinline__ void ph_lru(const Args& A, Frame& F) {
    const int ntile = PASS3 ? 64 : 66;
    for (int u = blockIdx.x; u < ntile * 10; u += F.G) lru_unit<PASS3>(A, F, u / 10, u % 10);
}

typedef short s16x4 __attribute__((ext_vector_type(4)));
__device__ __forceinline__ s16x4 lds_tr16(const LAS unsigned char* p) { return __builtin_bit_cast(s16x4, __builtin_amdgcn_ds_read_tr16_b64_v4i16((LAS s16x4*)p)); }
constexpr int KP = 144, VP = 160;
constexpr int ATT_KOFF = 0, ATT_VOFF = 2 * 64 * KP, ATT_QOFF = ATT_VOFF + 2 * 64 * VP;
__device__ __forceinline__ void attn_unit(const Args& A, Frame& F, int b, int kvh, int qb, bool ctxq) {
    const bf16* G1 = (const bf16*)(A.ws + WS_G1); bf16* MIX = (bf16*)(A.ws + WS_MIX);
    const int lane = lane_id_asm(), tid = F.wave * 64 + lane, w = F.wave, li = lane & 15, g = lane >> 4, hw = w & 1, h = kvh * 4 + (w >> 1);
    const int qrow0 = (ctxq ? MLAT + b * CTXL : b * SEQ) + qb * 128 + 64 * hw;
    LAS unsigned char* lQ = F.lds + ATT_QOFF + w * (64 * KP);
#pragma unroll
    for (int i = 0; i < 8; ++i) { const int ck = lane + 64 * i, row = ck >> 3, dc = ck & 7;
        *(LAS v4u*)(lQ + row * KP + dc * 16) = *(const v4u*)(G1 + (size_t)(qrow0 + row) * NIN_E + COL_Q + h * 64 + 8 * dc); }
    const float sk = A.in[11][h] * LOG2E;
    float mrun[4], lrun[4]; pg8::f32x4 O[4][4];
#pragma unroll
    for (int mt = 0; mt < 4; ++mt) { mrun[mt] = sk; lrun[mt] = (g == 0) ? 1.f : 0.f;
#pragma unroll
        for (int dt = 0; dt < 4; ++dt) O[dt][mt] = (pg8::f32x4){0.f, 0.f, 0.f, 0.f}; }
    const int t_first = ctxq ? 6 : (qb == 0 ? 2 : 0), t_hi = ctxq ? 6 : (qb == SEQ / 128 - 1 ? 4 : 6);
    const int skey = tid >> 3, sdc = tid & 7;
    LAS unsigned char* lK = F.lds + ATT_KOFF; LAS unsigned char* lV = F.lds + ATT_VOFF;
    int cur = t_first, buf = 0;
    { const size_t rowb = cur < 6 ? (size_t)b * SEQ + (qb - 1) * 128 + 64 * cur : (size_t)MLAT + b * CTXL + 64 * (cur - 6);
      const bf16* src = G1 + (rowb + skey) * NIN_E + kvh * 64 + 8 * sdc;
      const v4u kr = *(const v4u*)(src + COL_K), vr = *(const v4u*)(src + COL_VAL);
      *(LAS v4u*)(lK + skey * KP + sdc * 16) = kr; *(LAS v4u*)(lV + skey * VP + sdc * 16) = vr; }
    __syncthreads();
    for (;;) {
        const int nxt = (cur < 6 && cur + 1 == t_hi) ? 6 : cur + 1; const bool has = nxt < 10;
        v4u kr = {0u, 0u, 0u, 0u}, vr = {0u, 0u, 0u, 0u};
        if (has) { const size_t rowb = nxt < 6 ? (size_t)b * SEQ + (qb - 1) * 128 + 64 * nxt : (size_t)MLAT + b * CTXL + 64 * (nxt - 6);
            const bf16* src = G1 + (rowb + skey) * NIN_E + kvh * 64 + 8 * sdc; kr = *(const v4u*)(src + COL_K); vr = *(const v4u*)(src + COL_VAL); }
        const bool skip = (cur == 0 && hw == 1) || (cur == 5 && hw == 0);
        if (!skip) {
            const LAS unsigned char* kb = lK + buf * (64 * KP); const LAS unsigned char* vb = lV + buf * (64 * VP);
            pg8::bf16x8 Kf[4][2];
#pragma unroll
            for (int nt = 0; nt < 4; ++nt)
#pragma unroll
                for (int ks = 0; ks < 2; ++ks) Kf[nt][ks] = *(const LAS pg8::bf16x8*)(kb + (16 * nt + li) * KP + (32 * ks + 8 * g) * 2);
            const int kpos0 = (qb - 1) * 128 + 64 * cur;
            float alpha[4]; pg8::bf16x8 Pf[4][2];
#pragma unroll
            for (int mt = 0; mt < 4; ++mt) {
                pg8::f32x4 S[4];
#pragma unroll
                for (int nt = 0; nt < 4; ++nt) S[nt] = (pg8::f32x4){0.f, 0.f, 0.f, 0.f};
#pragma unroll
                for (int ks = 0; ks < 2; ++ks)
                    { const pg8::bf16x8 qf = *(const LAS pg8::bf16x8*)(lQ + (16 * mt + li) * KP + (32 * ks + 8 * g) * 2);
#pragma unroll
                    for (int nt = 0; nt < 4; ++nt) S[nt] = __builtin_amdgcn_mfma_f32_16x16x32_bf16(Kf[nt][ks], qf, S[nt], 0, 0, 0); }
                if (cur < 2 || cur == 4 || cur == 5) {
                    const int tq = qb * 128 + 64 * hw + 16 * mt + li;
#pragma unroll
                    for (int nt = 0; nt < 4; ++nt)
#pragma unroll
                        for (int r = 0; r < 4; ++r) { const int tk = kpos0 + 16 * nt + 4 * g + r; const int df = cur < 2 ? tq - tk : tk - tq; if (df > 128) S[nt][r] = -INFINITY; }
                }
                float mx = fmaxf(fmaxf(fmaxf(S[0][0], S[0][1]), fmaxf(S[0][2], S[0][3])), fmaxf(fmaxf(S[1][0], S[1][1]), fmaxf(S[1][2], S[1][3])));
                mx = fmaxf(mx, fmaxf(fmaxf(fmaxf(S[2][0], S[2][1]), fmaxf(S[2][2], S[2][3])), fmaxf(fmaxf(S[3][0], S[3][1]), fmaxf(S[3][2], S[3][3]))));
                mx = fmaxf(mx, __shfl_xor(mx, 16)); mx = fmaxf(mx, __shfl_xor(mx, 32));
                const float mnew = fmaxf(mrun[mt], mx); alpha[mt] = fexp2(mrun[mt] - mnew); mrun[mt] = mnew;
                float ls = 0.f;
#pragma unroll
                for (int nt = 0; nt < 4; ++nt)
#pragma unroll
                    for (int r = 0; r < 4; ++r) { const float p = fexp2(S[nt][r] - mnew); S[nt][r] = p; ls += p; }
                lrun[mt] = lrun[mt] * alpha[mt] + ls;
#pragma unroll
                for (int ks = 0; ks < 2; ++ks) { v4u pw; pw.x = pk2(S[2 * ks][0], S[2 * ks][1]); pw.y = pk2(S[2 * ks][2], S[2 * ks][3]); pw.z = pk2(S[2 * ks + 1][0], S[2 * ks + 1][1]); pw.w = pk2(S[2 * ks + 1][2], S[2 * ks + 1][3]);
                    Pf[mt][ks] = __builtin_bit_cast(pg8::bf16x8, pw); }
                if (mt == 1 && has) { LAS unsigned char* kd = lK + (buf ^ 1) * (64 * KP); LAS unsigned char* vd = lV + (buf ^ 1) * (64 * VP);
                    *(LAS v4u*)(kd + skey * KP + sdc * 16) = kr; *(LAS v4u*)(vd + skey * VP + sdc * 16) = vr; }
            }
#pragma unroll
            for (int dt = 0; dt < 4; ++dt) {
                pg8::bf16x8 Vf[2];
#pragma unroll
                for (int ks = 0; ks < 2; ++ks) {
                    const LAS unsigned char* p0 = vb + (32 * ks + 4 * g + (li >> 2)) * VP + (16 * dt + 4 * (li & 3)) * 2;
                    const s16x4 lo = lds_tr16(p0), hi = lds_tr16(p0 + 16 * VP);
                    Vf[ks] = (pg8::bf16x8){lo[0], lo[1], lo[2], lo[3], hi[0], hi[1], hi[2], hi[3]};
                }
#pragma unroll
                for (int mt = 0; mt < 4; ++mt) { O[dt][mt] = O[dt][mt] * alpha[mt];
#pragma unroll
                    for (int ks = 0; ks < 2; ++ks) O[dt][mt] = __builtin_amdgcn_mfma_f32_16x16x32_bf16(Vf[ks], Pf[mt][ks], O[dt][mt], 0, 0, 0); }
            }
        }
        if (skip && has) { LAS unsigned char* kd = lK + (buf ^ 1) * (64 * KP); LAS unsigned char* vd = lV + (buf ^ 1) * (64 * VP);
            *(LAS v4u*)(kd + skey * KP + sdc * 16) = kr; *(LAS v4u*)(vd + skey * VP + sdc * 16) = vr; }
        __syncthreads();
        if (!has) break;
        cur = nxt; buf ^= 1;
    }
#pragma unroll
    for (int mt = 0; mt < 4; ++mt) {
        float l = lrun[mt]; l += __shfl_xor(l, 16); l += __shfl_xor(l, 32); const float inv = 1.f / l;
        bf16* orow = MIX + (size_t)(qrow0 + 16 * mt + li) * DM + 512 + h * 64 + 4 * g;
#pragma unroll
        for (int dt = 0; dt < 4; ++dt) { v2u o; o.x = pk2(O[dt][mt][0] * inv, O[dt][mt][1] * inv); o.y = pk2(O[dt][mt][2] * inv, O[dt][mt][3] * inv); *(v2u*)(orow + 16 * dt) = o; }
    }
}
constexpr int SGP = 272;
__device__ __forceinline__ float red16(float v) { v += __shfl_xor(v, 1); v += __shfl_xor(v, 2); v += __shfl_xor(v, 4); v += __shfl_xor(v, 8); return v; }
__device__ __forceinline__ void sgu_unit(const Args& A, Frame& F, int chunk, int grp) {
    const bf16* G1 = (const bf16*)(A.ws + WS_G1); bf16* MIX = (bf16*)(A.ws + WS_MIX);
    const int lane = lane_id_asm(), tid = F.wave * 64 + lane, row0 = chunk * 128, w = F.wave, li = lane & 15, gq = lane >> 4;
    LAS unsigned char* vn = F.lds;
    { const int ck = tid & 15;
#pragma unroll
      for (int i = 0; i < 4; ++i) { const int row = (tid >> 4) + 32 * i;
        const v4u x = *(const v4u*)(G1 + (size_t)(row0 + row) * NIN_E + COL_V + grp * 128 + ck * 8);
        float f[8] = {bflo(x.x), bfhi(x.x), bflo(x.y), bfhi(x.y), bflo(x.z), bfhi(x.z), bflo(x.w), bfhi(x.w)};
        float s = ((f[0] + f[1]) + (f[2] + f[3])) + ((f[4] + f[5]) + (f[6] + f[7])); s = red16(s); const float mean = s * (1.f / 128.f);
        float ss = 0.f;
#pragma unroll
        for (int e = 0; e < 8; ++e) { f[e] -= mean; ss += f[e] * f[e]; }
        ss = red16(ss); const float rs = 1.f / sqrtf(ss * (1.f / 128.f) + EPS);
        v4u o; o.x = pk2(f[0] * rs, f[1] * rs); o.y = pk2(f[2] * rs, f[3] * rs); o.z = pk2(f[4] * rs, f[5] * rs); o.w = pk2(f[6] * rs, f[7] * rs);
        *(LAS v4u*)(vn + row * SGP + ck * 16) = o; } }
    __syncthreads();
    const bf16* Wb = (const bf16*)(A.ws + WS_SGW) + (size_t)(grp * 128 + 16 * w + li) * 128 + 8 * gq;
    pg8::bf16x8 Wf[4];
#pragma unroll
    for (int ks = 0; ks < 4; ++ks) Wf[ks] = *(const pg8::bf16x8*)(Wb + 32 * ks);
    pg8::f32x4 acc[8];
#pragma unroll
    for (int nt = 0; nt < 8; ++nt) acc[nt] = (pg8::f32x4){0.f, 0.f, 0.f, 0.f};
#pragma unroll
    for (int ks = 0; ks < 4; ++ks)
#pragma unroll
        for (int nt = 0; nt < 8; ++nt) {
            const LAS unsigned char* p0 = vn + (32 * ks + 8 * gq + (li >> 2)) * SGP + (16 * nt + 4 * (li & 3)) * 2;
            const s16x4 lo = lds_tr16(p0), hi = lds_tr16(p0 + 4 * SGP);
            const pg8::bf16x8 vf = (pg8::bf16x8){lo[0], lo[1], lo[2], lo[3], hi[0], hi[1], hi[2], hi[3]};
            acc[nt] = __builtin_amdgcn_mfma_f32_16x16x32_bf16(vf, Wf[ks], acc[nt], 0, 0, 0);
        }
    const float bias = A.in[10][grp * 128 + 16 * w + li];
    const size_t prow = (size_t)(row0 + 16 * w + li);
#pragma unroll
    for (int nt = 0; nt < 8; ++nt) {
        const v2u u = *(const v2u*)(G1 + prow * NIN_E + grp * 128 + 16 * nt + 4 * gq);
        v2u o; o.x = pk2(bflo(u.x) * (acc[nt][0] + bias), bfhi(u.x) * (acc[nt][1] + bias)); o.y = pk2(bflo(u.y) * (acc[nt][2] + bias), bfhi(u.y) * (acc[nt][3] + bias));
        *(v2u*)(MIX + prow * DM + grp * 128 + 16 * nt + 4 * gq) = o;
    }
    __syncthreads();
}
__device__ __forceinline__ void ph_mix(const Args& A, Frame& F) {
    constexpr int N_ATT = NB * (SEQ / 128) * 2, N_CATT = NB * (CTXL / 128) * 2, N_SGU = (MTOT / 128) * 4;
    for (int it = F.vcu; it < N_ATT + N_CATT + N_SGU; it += F.G) {
        if (it < N_ATT + N_CATT) {
            const bool cq = it >= N_ATT; const int j = cq ? it - N_ATT : it;
            const int b = cq ? (j >> 2) : (j >> 7), qb = cq ? ((j >> 1) & 1) : ((j >> 1) & 63), kvh = j & 1;
            attn_unit(A, F, b, kvh, qb, cq);
        } else { const int s = it - (N_ATT + N_CATT); sgu_unit(A, F, s >> 2, s & 3); }
    }
}

__global__ void __launch_bounds__(NTHR, 2) fwd_kernel(Args A) {
    extern __shared__ __attribute__((aligned(16))) unsigned char lds[];
    Frame F;
    F.lds = (LAS unsigned char*)lds; F.MISC = (volatile LAS unsigned*)(F.lds + MISC_OFF);
    F.wave = __builtin_amdgcn_readfirstlane((int)threadIdx.x >> 6);
    F.G = gridDim.x; { const int bx = blockIdx.x; F.vcu = (F.G % 8 == 0) ? (bx % 8) * (F.G / 8) + bx / 8 : bx; }
    unsigned char* ws = A.ws;
    F.ctl = (gu32*)(ws + WS_CTL);
    for (int u = threadIdx.x; u < (LDS_BYTES - LDSCTL_OFF) / 4; u += NTHR) ((LAS unsigned*)(F.lds + LDSCTL_OFF))[u] = 0u;
    __syncthreads();
    XcdBarrier bar; bar.bar = (unsigned*)(F.ctl + CW_BAR); bar.x = 0; bar.st = nullptr;
    if (MK_ONE_LAUNCH) bar = xcd_barrier_post((unsigned*)(F.ctl + CW_BAR), F.MISC + 8, threadIdx.x == 0);
    const int lo = A.ph_lo, hi = A.ph_hi;
#define IN(k) (lo <= (k) && (k) < hi)
#define SEAM(k) do { if (IN(k) && IN((k) + 1)) xcd_barrier(bar, F.wave == 0 && lane_id_asm() == 0); } while (0)
    const float* mod = (const float*)(ws + WS_MOD);
    bf16* Hb = (bf16*)(ws + WS_H); float* XC = (float*)(ws + WS_XC);

    if (IN(PH_PRO)) { ph_prologue(A, F); __syncthreads(); } SEAM(PH_PRO);
    if (IN(PH_NORM1E)) ph_norm(F, A.in[0], A.in[2], A.in[6], mod, 0, 1, Hb, MTOT, CtxFix{nullptr, 0, nullptr, nullptr, nullptr}); SEAM(PH_NORM1E);
    if (IN(PH_GIN_E)) {
        pg8::Gemm g{Hb, (const bf16*)(ws + WS_WINE), MTOT, NIN_E, DM, DM}; pg8::StaticOrder S; S.init(MTOT, NIN_E, F.G, (int)blockIdx.x);
        EpiInEven E{(bf16*)(ws + WS_G1), (const float*)(ws + WS_ROPE)};
        pg8::gemm_phase<EpiInEven, pg8::StaticOrder, true, true>(F.lds, g, S, E, F.wave);
    } SEAM(PH_GIN_E);
    if (IN(PH_MIX_E)) ph_mix(A, F); SEAM(PH_MIX_E);
    if (IN(PH_GOUT_E)) {
        { pg8::Gemm g{(const bf16*)(ws + WS_MIX), (const bf16*)(ws + WS_WOUTE), MLAT, DM, DM, DM}; pg8::StaticOrder S; S.init(MLAT, DM, F.G, (int)blockIdx.x);
          EpiResid E{A.in[0], A.in[2], A.out, XC, mod + 2 * 1024};
          pg8::gemm_phase<EpiResid, pg8::StaticOrder, true, true>(F.lds, g, S, E, F.wave); }
        { pg8::Gemm g{(const bf16*)(ws + WS_MIX), (const bf16*)(ws + WS_WOUTE), MTOT, DM, 256, DM}; CtxSplitOrder S{4, 512, F.G, (int)blockIdx.x};
          EpiPartial E{(float*)(ws + WS_PART), 512};
          pg8::gemm_phase<EpiPartial, CtxSplitOrder, true, true>(F.lds, g, S, E, F.wave); }
    } SEAM(PH_GOUT_E);
    if (IN(PH_NORM2E)) ph_norm(F, A.out, XC, A.in[7], mod, 3, 4, Hb, MTOT, CtxFix{(const float*)(ws + WS_PART), 4, mod + 2 * 6144 + 2 * 1024, A.in[2], XC}); SEAM(PH_NORM2E);
    if (IN(PH_FFN_UP)) {
        pg8::Gemm g{Hb, (const bf16*)(ws + WS_FFN13), MTOT, NFF2, DM, DM}; pg8::StaticOrder S; S.init(MTOT, NFF2, F.G, (int)blockIdx.x);
        EpiSwiGLU E{(bf16*)(ws + WS_FH), NFF2 / 256};
        pg8::gemm_phase<EpiSwiGLU, pg8::StaticOrder, true, true>(F.lds, g, S, E, F.wave);
    } SEAM(PH_FFN_UP);
    if (IN(PH_FFN_DN)) {
        { pg8::Gemm g{(const bf16*)(ws + WS_FH), (const bf16*)(ws + WS_FFN2), MLAT, DM, DFF, DFF}; pg8::StaticOrder S; S.init(MLAT, DM, F.G, (int)blockIdx.x);
          EpiResid E{A.out, XC, A.out, XC, mod + 5 * 1024};
          pg8::gemm_phase<EpiResid, pg8::StaticOrder, true, true>(F.lds, g, S, E, F.wave); }
        { pg8::Gemm g{(const bf16*)(ws + WS_FH), (const bf16*)(ws + WS_FFN2), MTOT, DM, 256, DFF}; CtxSplitOrder S{11, 512, F.G, (int)blockIdx.x};
          EpiPartial E{(float*)(ws + WS_PART), 512};
          pg8::gemm_phase<EpiPartial, CtxSplitOrder, true, true>(F.lds, g, S, E, F.wave); }
    } SEAM(PH_FFN_DN);
    if (IN(PH_NORM1O)) ph_norm(F, A.out, XC, A.in[18], mod + 3 * 6144, 0, 1, Hb, MTOT, CtxFix{(const float*)(ws + WS_PART), 11, mod + 2 * 6144 + 5 * 1024, XC, XC}); SEAM(PH_NORM1O);
    if (IN(PH_GIN_O)) {
        pg8::Gemm g{Hb, (const bf16*)(ws + WS_WINO), MTOT, NIN_O, DM, DM}; pg8::StaticOrder S; S.init(MTOT, NIN_O, F.G, (int)blockIdx.x);
        EpiStore E{(bf16*)(ws + WS_G2), NIN_O, NIN_O / 256, 5};
        pg8::gemm_phase<EpiStore, pg8::StaticOrder, true, true>(F.lds, g, S, E, F.wave);
    } SEAM(PH_GIN_O);
    if (IN(PH_LRU_G)) ph_lru<false>(A, F); SEAM(PH_LRU_G);
    if (IN(PH_LRU_S)) ph_lru<true>(A, F); SEAM(PH_LRU_S);
    if (IN(PH_GOUT_O)) {
        pg8::Gemm g{(const bf16*)(ws + WS_Y1), (const bf16*)(ws + WS_WOUTO), MLAT, DM, DRNN, DRNN}; pg8::StaticOrder S; S.init(MLAT, DM, F.G, (int)blockIdx.x);
        EpiResid E{A.out, XC, A.out, XC, mod + 3 * 6144 + 2 * 1024};
        pg8::gemm_phase<EpiResid, pg8::StaticOrder, true, true>(F.lds, g, S, E, F.wave);
    } SEAM(PH_GOUT_O);
    if (IN(PH_ROUTE)) { ph_route(A, F); ph_convert_moe(A, F); } SEAM(PH_ROUTE);
    if (IN(PH_PERM)) ph_permute(A, F); SEAM(PH_PERM);
    if (IN(PH_MOE_UP)) {
        const int* meta = (const int*)(ws + WS_META); const int nt = __builtin_amdgcn_readfirstlane(ld_i32_agent(meta + 256));
        pg8::Gemm g{(const bf16*)(ws + WS_HP), (const bf16*)(ws + WS_MOE13), MOE_ROWS, NFF2, DM, DM}; MoeOrder S{meta, nt, NFF2 / 256, F.G, (int)blockIdx.x};
        EpiSwiGLU E{(bf16*)(ws + WS_MH), NFF2 / 256};
        pg8::gemm_phase<EpiSwiGLU, MoeOrder, true, true>(F.lds, g, S, E, F.wave);
    } SEAM(PH_MOE_UP);
    if (IN(PH_MOE_DN)) {
        const int* meta = (const int*)(ws + WS_META); const int nt = __builtin_amdgcn_readfirstlane(ld_i32_agent(meta + 256));
        pg8::Gemm g{(const bf16*)(ws + WS_MH), (const bf16*)(ws + WS_MOE2), MOE_ROWS, DM, DFF, DFF}; MoeOrder S{meta, nt, DM / 256, F.G, (int)blockIdx.x};
        EpiStore E{(bf16*)(ws + WS_YD), DM, DM / 256, 0};
        pg8::gemm_phase<EpiStore, MoeOrder, true, true>(F.lds, g, S, E, F.wave);
    } SEAM(PH_MOE_DN);
    if (IN(PH_COMB)) ph_combine(A, F, A.out);
#undef IN
#undef SEAM
}

extern "C" void kernel_launch(void* const* d_in, const int* in_sizes, int n_in, void* d_out, int out_size, void* d_ws, size_t ws_size, hipStream_t stream) {
    static int grid = 0;
    if (grid == 0) {
        if (n_in != 34 || in_sizes[0] != MLAT * DM || out_size != MLAT * DM || ws_size < WS_NEED) { fprintf(stderr, "kernel_launch: unexpected shapes (n_in %d, out %d, ws %zu)\n", n_in, out_size, ws_size); grid = -1; return; }
        int dev = 0, cus = 0, per_cu = 0;
        if (hipGetDevice(&dev) != hipSuccess || hipDeviceGetAttribute(&cus, hipDeviceAttributeMultiprocessorCount, dev) != hipSuccess) { grid = -1; return; }
        if (hipFuncSetAttribute((const void*)fwd_kernel, hipFuncAttributeMaxDynamicSharedMemorySize, LDS_BYTES) != hipSuccess) { grid = -1; return; }
        if (hipOccupancyMaxActiveBlocksPerMultiprocessor(&per_cu, (const void*)fwd_kernel, NTHR, LDS_BYTES) != hipSuccess || per_cu < 1) { fprintf(stderr, "kernel_launch: occupancy query says %d\n", per_cu); }
        (void)hipGetLastError();
        grid = cus;
    }
    if (grid < 0) return;
    (void)hipMemsetAsync((char*)d_ws + WS_CTL, 0, CTL_ZERO_BYTES, stream);
    Args a{};
    for (int i = 0; i < 34; ++i) a.in[i] = (const float*)d_in[i];
    a.out = (float*)d_out; a.ws = (unsigned char*)d_ws;
#if MK_ONE_LAUNCH
    a.ph_lo = 0; a.ph_hi = NPH;
    hipLaunchKernelGGL(fwd_kernel, dim3(grid), dim3(NTHR), LDS_BYTES, stream, a);
#else
    for (int p = 0; p < NPH; ++p) { a.ph_lo = p; a.ph_hi = p + 1; hipLaunchKernelGGL(fwd_kernel, dim3(grid), dim3(NTHR), LDS_BYTES, stream, a); }
#endif
}
```

```cpp
#include <hip/hip_runtime.h>
#include <cstdio>
#include <cstdint>
namespace pg8 {
#define PG8_LAS __attribute__((address_space(3)))
typedef unsigned short bf16_t;
typedef short bf16x8 __attribute__((ext_vector_type(8)));
typedef float f32x4 __attribute__((ext_vector_type(4)));
typedef unsigned u32x4 __attribute__((ext_vector_type(4)));
constexpr int BM = 256, BK = 64, HALF = 128, HTB = HALF * BK * 2  , STAGE_BYTES = 8 * HTB, NXCD = 8, WGM = 8;

__host__ __device__ __forceinline__ int lds_byte(int r, int c) { const int st = (r >> 4) * 2 + (c >> 5), rr = r & 15, cc = c & 31, ob = rr * 64 + cc * 2; return st * 1024 + (ob ^ (((ob >> 9) & 1) << 5)); }
__host__ __device__ __forceinline__ void stage_rc(int b, int& R, int& C) { const int st = b / 1024, sb = b % 1024, swz = sb ^ (((sb >> 9) & 1) << 5); R = (st >> 1) * 16 + swz / 64; C = (st & 1) * 32 + (swz % 64) / 2; }
__host__ __device__ __forceinline__ int perm32(int rho) { const int n = rho >> 4, i = rho & 15; return 8 * (i >> 2) + 4 * n + (i & 3); }

struct Unit { int pm, pn, kb; };
struct Gemm { const bf16_t* A; const bf16_t* Bt; int M, N, K, ld; };

struct StaticOrder {
    int nM, nN, nwg, G, c;
    __host__ __device__ void init(int M, int N, int G_, int c_) { nM = M / BM; nN = N / BM; nwg = nM * nN; G = G_; c = c_; }
    __host__ __device__ bool next(int i, Unit& u) const {
        const long L = (long)i * G + c; if (L >= nwg) return false;
        int wgid = (int)L; { const int q = nwg / NXCD, r = nwg % NXCD, xcd = wgid % NXCD, off = wgid / NXCD; wgid = (xcd < r ? xcd * (q + 1) : r * (q + 1) + (xcd - r) * q) + off; }
        const int nig = WGM * nN, gid = wgid / nig, fm = gid * WGM, gsz = (nM - fm) < WGM ? (nM - fm) : WGM;
        u.pm = fm + ((wgid % nig) % gsz); u.pn = (wgid % nig) / gsz; u.kb = 0; return true;
    }
    __device__ __forceinline__ void a_ready(const Unit&) const {}
    __device__ __forceinline__ void done(const Unit&) const {}
};

__device__ __forceinline__ unsigned cvt_pk_bf16(float lo, float hi) { unsigned r; asm volatile("v_cvt_pk_bf16_f32 %0, %1, %2" : "=v"(r) : "v"(lo), "v"(hi)); return r; }
typedef float f32x2 __attribute__((ext_vector_type(2)));
template <class Epi, class Sched, bool ALIGN_EPI = false, bool SP2 = false>
__device__ __forceinline__ void gemm_phase(PG8_LAS unsigned char* lds, const Gemm g, const Sched& S, const Epi& E, const int wid) {
    int lane_; asm volatile("v_mbcnt_lo_u32_b32 %0, -1, 0\n\tv_mbcnt_hi_u32_b32 %0, -1, %0" : "=v"(lane_));
    const int lane = lane_, tid = wid * 64 + lane, wr = wid >> 2, wc = wid & 3, fr = lane & 15, fq = lane >> 4;
    const int K = g.ld, nt = g.K / BK;
    unsigned voffA[2], voffB[2];
#pragma unroll
    for (int i = 0; i < 2; ++i) { int R, C; stage_rc(tid * 16 + i * 8192, R, C); const int Rb = Epi::PERM ? ((R & ~31) + perm32(R & 31)) : R;
        voffA[i] = (unsigned)(R * K + C) * 2u; voffB[i] = (unsigned)(Rb * K + C) * 2u; }
    const size_t kstep = (size_t)(BK * 2);
    const size_t hstep = (size_t)HALF * K * 2;
    const size_t tstep = 2 * hstep;
    const unsigned ldsw = (unsigned)wid * 1024u;
    const int aoff = lds_byte(wr * 64 + fr, fq * 8), boff = lds_byte(wc * 32 + fr, fq * 8);
#define PG8_SA(b, h) (((b) * 2 + (h)) * HTB)
#define PG8_SB(b, h) ((4 + (b) * 2 + (h)) * HTB)
#define PG8_STAGE(bufoff, gbase, voff) do { _Pragma("unroll") for (int _i = 0; _i < 2; ++_i) \
        __builtin_amdgcn_global_load_lds((const unsigned*)((const char*)(gbase) + (voff)[_i]), (PG8_LAS unsigned*)(lds + (bufoff) + ldsw + _i * 8192), 16, 0, 0); } while (0)
#define PG8_LDA(dst, b, h) do { _Pragma("unroll") for (int m = 0; m < 4; ++m) _Pragma("unroll") for (int k = 0; k < 2; ++k) dst[m][k] = *(const PG8_LAS bf16x8*)(lds + PG8_SA(b, h) + aoff + m * 2048 + k * 1024); } while (0)
#define PG8_LDB(dst, b, h) do { _Pragma("unroll") for (int n = 0; n < 2; ++n) _Pragma("unroll") for (int k = 0; k < 2; ++k) dst[n][k] = *(const PG8_LAS bf16x8*)(lds + PG8_SB(b, h) + boff + n * 2048 + k * 1024); } while (0)
#define PG8_MMA(ai, bj, At, Bt) do { __builtin_amdgcn_s_setprio(1); _Pragma("unroll") for (int m = 0; m < 4; ++m) _Pragma("unroll") for (int n = 0; n < 2; ++n) _Pragma("unroll") for (int k = 0; k < 2; ++k) \
        acc[ai][bj][m][n] = __builtin_amdgcn_mfma_f32_16x16x32_bf16(Bt[n][k], At[m][k], acc[ai][bj][m][n], 0, 0, 0); __builtin_amdgcn_s_setprio(0); } while (0)
#define PG8_WAIT_V(n) asm volatile("s_waitcnt vmcnt(" #n ")" ::: "memory")
#define PG8_WAIT_L(n) asm volatile("s_waitcnt lgkmcnt(" #n ")" ::: "memory")
#define PG8_BAR __builtin_amdgcn_s_barrier()
#define PG8_SCHED __builtin_amdgcn_sched_barrier(0)
    Unit cur, nxt; int ui = 0;
    if (!S.next(0, cur)) return;
    f32x4 acc[2][2][4][2];
#pragma unroll
    for (int a = 0; a < 2; ++a)
#pragma unroll
        for (int b = 0; b < 2; ++b)
#pragma unroll
            for (int m = 0; m < 4; ++m)
#pragma unroll
                for (int n = 0; n < 2; ++n) acc[a][b][m][n] = (f32x4){0.f, 0.f, 0.f, 0.f};
    bf16x8 At[4][2], B0[2][2], B1[2][2];
    const char* cA = (const char*)g.A + (size_t)cur.pm * tstep + cur.kb; const char* cB = (const char*)g.Bt + (size_t)cur.pn * tstep + cur.kb;
    S.a_ready(cur);
    if constexpr (SP2) {
        PG8_STAGE(PG8_SB(0, 0), cB, voffB); PG8_STAGE(PG8_SB(0, 1), cB + hstep, voffB); PG8_STAGE(PG8_SA(0, 0), cA, voffA); PG8_STAGE(PG8_SA(0, 1), cA + hstep, voffA);
        if (wr == 1) PG8_BAR;
        PG8_WAIT_V(2); PG8_BAR;
        PG8_STAGE(PG8_SB(1, 0), cB + kstep, voffB); PG8_STAGE(PG8_SA(1, 0), cA + kstep, voffA); PG8_STAGE(PG8_SB(1, 1), cB + hstep + kstep, voffB);
        PG8_WAIT_V(6); PG8_BAR;
    } else {
        PG8_STAGE(PG8_SB(0, 0), cB, voffB); PG8_STAGE(PG8_SA(0, 0), cA, voffA); PG8_STAGE(PG8_SB(0, 1), cB + hstep, voffB); PG8_STAGE(PG8_SA(0, 1), cA + hstep, voffA);
        if (wr == 1) PG8_BAR;
        PG8_WAIT_V(4); PG8_BAR;
        PG8_STAGE(PG8_SB(1, 0), cB + kstep, voffB); PG8_STAGE(PG8_SA(1, 0), cA + kstep, voffA); PG8_STAGE(PG8_SB(1, 1), cB + hstep + kstep, voffB);
        PG8_WAIT_V(6); PG8_BAR;
    }
    for (;;) {
        const bool has_next = S.next(ui + 1, nxt);
        const char* nA = has_next ? (const char*)g.A + (size_t)nxt.pm * tstep + nxt.kb : cA; const char* nB = has_next ? (const char*)g.Bt + (size_t)nxt.pn * tstep + nxt.kb : cB;
        for (int t = 0; t < nt; t += 2) {
            const bool last = (t == nt - 2);
            const char* a1 = cA + (size_t)(t + 1) * kstep;
            const char* a2 = last ? nA : cA + (size_t)(t + 2) * kstep; const char* b2 = last ? nB : cB + (size_t)(t + 2) * kstep;
            const char* a3 = a2 + kstep; const char* b3 = b2 + kstep;
            if (last && has_next) S.a_ready(nxt);
            if constexpr (SP2) {
            PG8_LDB(B0, 0, 0); PG8_LDB(B1, 0, 1); PG8_SCHED; PG8_LDA(At, 0, 0); PG8_STAGE(PG8_SA(1, 1), a1 + hstep, voffA);
            PG8_WAIT_V(8); PG8_WAIT_L(0); PG8_BAR; PG8_MMA(0, 0, At, B0); PG8_MMA(0, 1, At, B1); PG8_BAR; PG8_SCHED;
            PG8_LDA(At, 0, 1); PG8_STAGE(PG8_SB(0, 0), b2, voffB); PG8_STAGE(PG8_SB(0, 1), b2 + hstep, voffB); PG8_STAGE(PG8_SA(0, 0), a2, voffA);
            PG8_WAIT_V(8); PG8_WAIT_L(0); PG8_BAR; PG8_MMA(1, 0, At, B0); PG8_MMA(1, 1, At, B1); PG8_BAR; PG8_SCHED;
            PG8_LDB(B0, 1, 0); PG8_LDB(B1, 1, 1); PG8_SCHED; PG8_LDA(At, 1, 0); PG8_STAGE(PG8_SA(0, 1), a2 + hstep, voffA);
            PG8_WAIT_V(8); PG8_WAIT_L(0); PG8_BAR; PG8_MMA(0, 0, At, B0); PG8_MMA(0, 1, At, B1); PG8_BAR; PG8_SCHED;
            PG8_LDA(At, 1, 1); PG8_STAGE(PG8_SB(1, 0), b3, voffB); PG8_STAGE(PG8_SB(1, 1), b3 + hstep, voffB); PG8_STAGE(PG8_SA(1, 0), a3, voffA);
            PG8_WAIT_V(8); PG8_WAIT_L(0); PG8_BAR; PG8_MMA(1, 0, At, B0); PG8_MMA(1, 1, At, B1); PG8_BAR; PG8_SCHED;
            } else {
            PG8_LDB(B0, 0, 0); PG8_SCHED; PG8_LDA(At, 0, 0); PG8_STAGE(PG8_SA(1, 1), a1 + hstep, voffA);
            PG8_WAIT_L(8); PG8_BAR; PG8_WAIT_L(0); PG8_MMA(0, 0, At, B0); PG8_BAR; PG8_SCHED;
            PG8_LDB(B1, 0, 1); PG8_STAGE(PG8_SB(0, 0), b2, voffB);
            PG8_BAR; PG8_WAIT_L(0); PG8_MMA(0, 1, At, B1); PG8_BAR;
            PG8_LDA(At, 0, 1); PG8_STAGE(PG8_SA(0, 0), a2, voffA);
            PG8_BAR; PG8_WAIT_L(0); PG8_MMA(1, 0, At, B0); PG8_BAR; PG8_SCHED;
            PG8_STAGE(PG8_SB(0, 1), b2 + hstep, voffB);
            PG8_WAIT_V(6); PG8_BAR; PG8_MMA(1, 1, At, B1); PG8_BAR;
            PG8_LDB(B0, 1, 0); PG8_SCHED; PG8_LDA(At, 1, 0); PG8_STAGE(PG8_SA(0, 1), a2 + hstep, voffA);
            PG8_WAIT_L(8); PG8_BAR; PG8_WAIT_L(0); PG8_MMA(0, 0, At, B0); PG8_BAR; PG8_SCHED;
            PG8_LDB(B1, 1, 1); PG8_STAGE(PG8_SB(1, 0), b3, voffB);
            PG8_BAR; PG8_WAIT_L(0); PG8_MMA(0, 1, At, B1); PG8_BAR;
            PG8_LDA(At, 1, 1); PG8_STAGE(PG8_SA(1, 0), a3, voffA);
            PG8_BAR; PG8_WAIT_L(0); PG8_MMA(1, 0, At, B0); PG8_BAR; PG8_SCHED;
            PG8_STAGE(PG8_SB(1, 1), b3 + hstep, voffB);
            PG8_WAIT_V(6); PG8_BAR; PG8_MMA(1, 1, At, B1); PG8_BAR;
            }
        }
        if constexpr (ALIGN_EPI) { if (wr == 0) PG8_BAR; }
        if constexpr (!Epi::AFTER_DRAIN) { E(acc, cur, wr, wc, fr, fq); S.done(cur); }
        if (!has_next) break;
#pragma unroll
        for (int a = 0; a < 2; ++a)
#pragma unroll
            for (int b = 0; b < 2; ++b)
#pragma unroll
                for (int m = 0; m < 4; ++m)
#pragma unroll
                    for (int n = 0; n < 2; ++n) acc[a][b][m][n] = (f32x4){0.f, 0.f, 0.f, 0.f};
        cur = nxt; cA = nA; cB = nB; ++ui;
        if constexpr (ALIGN_EPI) { if (wr == 1) PG8_BAR; }
    }
    PG8_WAIT_V(0);
    if constexpr (!ALIGN_EPI) { if (wr == 0) PG8_BAR; }
    PG8_BAR;
    if constexpr (Epi::AFTER_DRAIN) { E.fused(acc, cur, wr, wc, fr, fq, lds, wid, lane); S.done(cur); }
#undef PG8_SA
#undef PG8_SB
#undef PG8_STAGE
#undef PG8_LDA
#undef PG8_LDB
#undef PG8_MMA
#undef PG8_WAIT_V
#undef PG8_WAIT_L
#undef PG8_BAR
#undef PG8_SCHED
}
}

constexpr int DM = 1024, NB = 2, SEQ = 8192, CTXL = 256;
constexpr int MLAT = NB * SEQ, MCTX = NB * CTXL, MTOT = MLAT + MCTX;
constexpr int NIN_E = 1792, NIN_O = 2560, DRNN = 1280, DFF = 2816, NEXP = 8, NFF2 = 2 * DFF;
constexpr int COL_V = 512, COL_Q = 1024, COL_K = 1536, COL_VAL = 1664;
constexpr float EPS = 1e-6f, LOG2E = 1.4426950408889634f, QSCALE = 0.125f * LOG2E;
constexpr int MOE_MAXT = 136;
constexpr int MOE_ROWS = MOE_MAXT * 256;

typedef unsigned short bf16;
typedef unsigned v4u __attribute__((ext_vector_type(4)));
typedef unsigned v2u __attribute__((ext_vector_type(2)));
typedef float f32x4 __attribute__((ext_vector_type(4)));
typedef float f32x2 __attribute__((ext_vector_type(2)));
#define GAS __attribute__((address_space(1)))
#define LAS __attribute__((address_space(3)))
typedef GAS unsigned gu32;
#define RLX_AGENT __ATOMIC_RELAXED, __HIP_MEMORY_SCOPE_AGENT
#define LDS_WAIT() asm volatile("s_waitcnt lgkmcnt(0)" ::: "memory")
#define VM_WAIT() asm volatile("s_waitcnt vmcnt(0)" ::: "memory")

__device__ __forceinline__ float bf2f(unsigned short u) { return __builtin_bit_cast(float, (unsigned)u << 16); }
__device__ __forceinline__ float bflo(unsigned u) { return __builtin_bit_cast(float, u << 16); }
__device__ __forceinline__ float bfhi(unsigned u) { return __builtin_bit_cast(float, u & 0xffff0000u); }
__device__ __forceinline__ unsigned pk2(float lo, float hi) { return pg8::cvt_pk_bf16(lo, hi); }
__device__ __forceinline__ unsigned short f2bf1(float x) { return (unsigned short)(pg8::cvt_pk_bf16(x, 0.f) & 0xffffu); }
__device__ __forceinline__ float fexp2(float x) { return __builtin_amdgcn_exp2f(x); }
__device__ __forceinline__ float frcp(float x) { return __builtin_amdgcn_rcpf(x); }
__device__ __forceinline__ float sigmoid_f(float x) { return frcp(1.f + fexp2(-LOG2E * x)); }
__device__ __forceinline__ float silu_f(float x) { return x * sigmoid_f(x); }
__device__ __forceinline__ float gelu_f(float x) { const float u = x * (1.f + 0.044715f * x * x); return x * frcp(1.f + fexp2((-2.f * 0.7978845608028654f * LOG2E) * u)); }
__device__ __forceinline__ f32x4 gelu4(f32x4 v) { return (f32x4){gelu_f(v[0]), gelu_f(v[1]), gelu_f(v[2]), gelu_f(v[3])}; }
__device__ __forceinline__ int ld_i32_agent(const int* p) { return __hip_atomic_load(p, RLX_AGENT); }
__device__ __forceinline__ float wave_sum(float v) {
#pragma unroll
    for (int o = 1; o < 64; o <<= 1) v += __shfl_xor(v, o);
    return v;
}
__device__ __forceinline__ float wave_max(float v) {
#pragma unroll
    for (int o = 1; o < 64; o <<= 1) v = fmaxf(v, __shfl_xor(v, o));
    return v;
}
__device__ __forceinline__ int lane_id_asm() { int l; asm volatile("v_mbcnt_lo_u32_b32 %0, -1, 0\n\tv_mbcnt_hi_u32_b32 %0, -1, %0" : "=v"(l)); return l; }
#define FRESH_TID() (F.wave * 64 + lane_id_asm())
__device__ __forceinline__ void st16_wt(void* p, v4u w) { asm volatile("global_store_dwordx4 %0, %1, off sc1\n\ts_nop 1" :: "v"(p), "v"(w) : "memory"); }
__device__ __forceinline__ int mod_of_tile(int pm) { return pm < 32 ? 0 : (pm < 64 ? 1 : 2); }
__device__ __forceinline__ int mod_of_row(int r) { return r < SEQ ? 0 : (r < MLAT ? 1 : 2); }

struct EpiInEven {
    static constexpr bool PERM = true, AFTER_DRAIN = false;
    bf16* G1; const float* rope;
    __device__ __forceinline__ void operator()(const pg8::f32x4 (&acc)[2][2][4][2], const pg8::Unit& u, int wr, int wc, int fr_, int fq_) const {
        (void)fr_; (void)fq_; const int lane_e = lane_id_asm(), fr = lane_e & 15, fq = lane_e >> 4;
        const int pn = u.pn; const bool lat = u.pm < 64;
#pragma unroll
        for (int ai = 0; ai < 2; ++ai)
#pragma unroll
            for (int m = 0; m < 4; ++m) {
                const int row = u.pm * 256 + ai * 128 + wr * 64 + m * 16 + fr;
                bf16* rowp = G1 + (size_t)row * NIN_E + pn * 256 + wc * 32 + 8 * fq;
                const int t = row & (SEQ - 1);
#pragma unroll
                for (int bj = 0; bj < 2; ++bj) {
                    f32x4 v0 = acc[ai][bj][m][0], v1 = acc[ai][bj][m][1];
                    if (pn < 4) { v0 = gelu4(v0); v1 = gelu4(v1); }
                    else if (pn < 6 || bj == 0) {
                        if (lat) {
                            const int pos = (wc & 1) ? (t & 63) : (t >> 6);
                            const f32x4* tp = (const f32x4*)(rope + (pos * 16 + 4 * fq) * 2);
                            const f32x4 c0 = tp[0], c1 = tp[1];
                            f32x4 w0, w1;
                            w0[0] = v0[0] * c0[0] - v0[1] * c0[1]; w0[1] = v0[1] * c0[0] + v0[0] * c0[1];
                            w0[2] = v0[2] * c0[2] - v0[3] * c0[3]; w0[3] = v0[3] * c0[2] + v0[2] * c0[3];
                            w1[0] = v1[0] * c1[0] - v1[1] * c1[1]; w1[1] = v1[1] * c1[0] + v1[0] * c1[1];
                            w1[2] = v1[2] * c1[2] - v1[3] * c1[3]; w1[3] = v1[3] * c1[2] + v1[2] * c1[3];
                            v0 = w0; v1 = w1;
                        }
                        if (pn < 6) { v0 = v0 * QSCALE; v1 = v1 * QSCALE; }
                    }
                    v4u w; w.x = pk2(v0[0], v0[1]); w.y = pk2(v0[2], v0[3]); w.z = pk2(v1[0], v1[1]); w.w = pk2(v1[2], v1[3]);
                    *(v4u*)(rowp + bj * 128) = w;
                }
            }
    }
};
struct EpiResid {
    static constexpr bool PERM = true, AFTER_DRAIN = false;
    const float* rin_lat; const float* rin_ctx; float* out_lat; float* out_ctx; const float* gate;
    __device__ __forceinline__ void operator()(const pg8::f32x4 (&acc)[2][2][4][2], const pg8::Unit& u, int wr, int wc, int fr_, int fq_) const {
        (void)fr_; (void)fq_; const int lane_e = lane_id_asm(), fr = lane_e & 15, fq = lane_e >> 4;
        const bool lat = u.pm < 64; const float* g = gate + mod_of_tile(u.pm) * 6144;
        const float* rb = lat ? rin_lat : rin_ctx - (size_t)MLAT * DM; float* ob = lat ? out_lat : out_ctx - (size_t)MLAT * DM;
        const int col0 = u.pn * 256 + wc * 32 + 8 * fq;
        f32x4 gv[2][2];
#pragma unroll
        for (int bj = 0; bj < 2; ++bj)
#pragma unroll
            for (int n = 0; n < 2; ++n) gv[bj][n] = *(const f32x4*)(g + col0 + bj * 128 + 4 * n);
#pragma unroll
        for (int ai = 0; ai < 2; ++ai)
#pragma unroll
            for (int m = 0; m < 4; ++m) {
                const size_t p = (size_t)(u.pm * 256 + ai * 128 + wr * 64 + m * 16 + fr) * DM + col0;
#pragma unroll
                for (int bj = 0; bj < 2; ++bj) {
                    const f32x4 r0 = *(const f32x4*)(rb + p + bj * 128), r1 = *(const f32x4*)(rb + p + bj * 128 + 4);
                    *(f32x4*)(ob + p + bj * 128) = r0 + gv[bj][0] * acc[ai][bj][m][0];
                    *(f32x4*)(ob + p + bj * 128 + 4) = r1 + gv[bj][1] * acc[ai][bj][m][1];
                }
            }
    }
};
struct EpiSwiGLU {
    static constexpr bool PERM = true, AFTER_DRAIN = false;
    bf16* H; int nN;
    __device__ __forceinline__ void operator()(const pg8::f32x4 (&acc)[2][2][4][2], const pg8::Unit& u, int wr, int wc, int fr_, int fq_) const {
        (void)fr_; (void)fq_; const int lane_e = lane_id_asm(), fr = lane_e & 15, fq = lane_e >> 4;
        const int pnl = u.pn % nN, col0 = pnl * 128 + wc * 32 + 8 * fq;
#pragma unroll
        for (int ai = 0; ai < 2; ++ai)
#pragma unroll
            for (int m = 0; m < 4; ++m) {
                const size_t row = (size_t)(u.pm * 256 + ai * 128 + wr * 64 + m * 16 + fr);
                const f32x4 a0 = acc[ai][0][m][0], a1 = acc[ai][0][m][1], b0 = acc[ai][1][m][0], b1 = acc[ai][1][m][1];
                v4u w;
                w.x = pk2(silu_f(a0[0]) * b0[0], silu_f(a0[1]) * b0[1]); w.y = pk2(silu_f(a0[2]) * b0[2], silu_f(a0[3]) * b0[3]);
                w.z = pk2(silu_f(a1[0]) * b1[0], silu_f(a1[1]) * b1[1]); w.w = pk2(silu_f(a1[2]) * b1[2], silu_f(a1[3]) * b1[3]);
                *(v4u*)(H + row * DFF + col0) = w;
            }
    }
};
struct EpiStore {
    static constexpr bool PERM = true, AFTER_DRAIN = false;
    bf16* O; int ldc; int nN; int ngelu;
    __device__ __forceinline__ void operator()(const pg8::f32x4 (&acc)[2][2][4][2], const pg8::Unit& u, int wr, int wc, int fr_, int fq_) const {
        (void)fr_; (void)fq_; const int lane_e = lane_id_asm(), fr = lane_e & 15, fq = lane_e >> 4;
        const int pnl = u.pn % nN, col0 = pnl * 256 + wc * 32 + 8 * fq; const bool g = pnl < ngelu;
#pragma unroll
        for (int ai = 0; ai < 2; ++ai)
#pragma unroll
            for (int m = 0; m < 4; ++m) {
                bf16* rowp = O + (size_t)(u.pm * 256 + ai * 128 + wr * 64 + m * 16 + fr) * ldc + col0;
#pragma unroll
                for (int bj = 0; bj < 2; ++bj) {
                    f32x4 v0 = acc[ai][bj][m][0], v1 = acc[ai][bj][m][1];
                    if (g) { v0 = gelu4(v0); v1 = gelu4(v1); }
                    v4u w; w.x = pk2(v0[0], v0[1]); w.y = pk2(v0[2], v0[3]); w.z = pk2(v1[0], v1[1]); w.w = pk2(v1[2], v1[3]);
                    *(v4u*)(rowp + bj * 128) = w;
                }
            }
    }
};
struct MoeOrder {
    const int* tile_e; int ntiles, nN, G, c;
    __device__ __forceinline__ bool next(int i, pg8::Unit& u) const {
        pg8::StaticOrder S; S.init(ntiles * 256, nN * 256, G, c);
        if (!S.next(i, u)) return false;
        u.pn += __builtin_amdgcn_readfirstlane(ld_i32_agent(tile_e + u.pm)) * nN; return true;
    }
    __device__ __forceinline__ void a_ready(const pg8::Unit&) const {}
    __device__ __forceinline__ void done(const pg8::Unit&) const {}
};

struct CtxSplitOrder {
    int nsplit, klen_bytes, G, c;
    __device__ __forceinline__ bool next(int i, pg8::Unit& u) const {
        const int L = i * G + c; if (L >= 8 * nsplit) return false;
        const int tile = L / nsplit, kp = L % nsplit; u.pm = 64 + (tile >> 2); u.pn = tile & 3; u.kb = kp * klen_bytes; return true;
    }
    __device__ __forceinline__ void a_ready(const pg8::Unit&) const {}
    __device__ __forceinline__ void done(const pg8::Unit&) const {}
};
struct EpiPartial {
    static constexpr bool PERM = true, AFTER_DRAIN = false;
    float* part; int klen_bytes;
    __device__ __forceinline__ void operator()(const pg8::f32x4 (&acc)[2][2][4][2], const pg8::Unit& u, int wr, int wc, int fr_, int fq_) const {
        (void)fr_; (void)fq_; const int lane_e = lane_id_asm(), fr = lane_e & 15, fq = lane_e >> 4;
        float* pb = part + (size_t)(u.kb / klen_bytes) * MCTX * DM; const int col0 = u.pn * 256 + wc * 32 + 8 * fq;
#pragma unroll
        for (int ai = 0; ai < 2; ++ai)
#pragma unroll
            for (int m = 0; m < 4; ++m) {
                const size_t p = (size_t)((u.pm - 64) * 256 + ai * 128 + wr * 64 + m * 16 + fr) * DM + col0;
#pragma unroll
                for (int bj = 0; bj < 2; ++bj) { *(f32x4*)(pb + p + bj * 128) = acc[ai][bj][m][0]; *(f32x4*)(pb + p + bj * 128 + 4) = acc[ai][bj][m][1]; }
            }
    }
};

struct MoeTailOrder {
    const int* tile_e; int ntail, G, c;
    __device__ __forceinline__ bool next(int i, pg8::Unit& u) const {
        const int L = i * G + c; if (L >= ntail * 44) return false;
        const int tile = 128 + L / 44, r = L % 44, pn = r / 11, kp = r % 11;
        u.pm = tile; u.pn = __builtin_amdgcn_readfirstlane(ld_i32_agent(tile_e + tile)) * 4 + pn; u.kb = kp * 512; return true;
    }
    __device__ __forceinline__ void a_ready(const pg8::Unit&) const {}
    __device__ __forceinline__ void done(const pg8::Unit&) const {}
};
struct EpiPartialBf16 {
    static constexpr bool PERM = true, AFTER_DRAIN = false;
    bf16* part;
    __device__ __forceinline__ void operator()(const pg8::f32x4 (&acc)[2][2][4][2], const pg8::Unit& u, int wr, int wc, int fr_, int fq_) const {
        (void)fr_; (void)fq_; const int lane_e = lane_id_asm(), fr = lane_e & 15, fq = lane_e >> 4;
        bf16* pb = part + (size_t)(u.kb / 512) * (8 * 256) * DM; const int col0 = (u.pn & 3) * 256 + wc * 32 + 8 * fq;
#pragma unroll
        for (int ai = 0; ai < 2; ++ai)
#pragma unroll
            for (int m = 0; m < 4; ++m) {
                bf16* rowp = pb + (size_t)((u.pm - 128) * 256 + ai * 128 + wr * 64 + m * 16 + fr) * DM + col0;
#pragma unroll
                for (int bj = 0; bj < 2; ++bj) { const pg8::f32x4 v0 = acc[ai][bj][m][0], v1 = acc[ai][bj][m][1];
                    v4u w; w.x = pk2(v0[0], v0[1]); w.y = pk2(v0[2], v0[3]); w.z = pk2(v1[0], v1[1]); w.w = pk2(v1[2], v1[3]);
                    *(v4u*)(rowp + bj * 128) = w; }
            }
    }
};
#define XB_TMO      128
#define XB_XCNT(j)  (256  + 64 * (j))
#define XB_XSUB(j)  (1280 + 64 * (j))
#define XB_XGEN(j)  (2304 + 64 * (j))
#define XB_TOP      3328
#define XB_TOPGEN   3392
#define XCD_BAR_WORDS 3456
#define XB_SPIN_CAP (1u << 18)

__device__ __forceinline__ unsigned xb_ld(unsigned* p)              { return __hip_atomic_load(p, __ATOMIC_RELAXED, __HIP_MEMORY_SCOPE_AGENT); }
__device__ __forceinline__ unsigned xb_add(unsigned* p, unsigned v) { return __hip_atomic_fetch_add(p, v, __ATOMIC_RELAXED, __HIP_MEMORY_SCOPE_AGENT); }
__device__ __forceinline__ unsigned xb_xcc_id() { return (unsigned)__builtin_amdgcn_s_getreg((3 << 11) | 20) & 0xFu; }
#define XB_SPIN(cond, bar) do { unsigned _sp = 0; while (cond) { __builtin_amdgcn_s_sleep(1); \
    if ((++_sp & 255u) == 0u) { if (xb_ld(&(bar)[XB_TMO])) break; if (_sp > XB_SPIN_CAP) { atomicAdd(&(bar)[XB_TMO], 1u); break; } } } } while (0)

struct XcdBarrier {
    unsigned* bar; unsigned x;
    volatile LAS unsigned* st;
};

__device__ __forceinline__ XcdBarrier xcd_barrier_post(unsigned* bar, volatile LAS unsigned* st, const bool t0) {
    XcdBarrier b; b.bar = bar; b.x = xb_xcc_id(); b.st = st;
    if (t0) (void)xb_add(&bar[XB_XCNT(b.x)], 1u);
    return b;
}
__device__ __forceinline__ void xcd_barrier_complete(unsigned* bar, unsigned x, unsigned& nloc, unsigned& nx) {
    const unsigned G = gridDim.x * gridDim.y * gridDim.z;
    unsigned sum, cnt, mine, sp = 0u;
    for (;;) {
        sum = 0u; cnt = 0u; mine = 0u;
#pragma unroll
        for (unsigned j = 0; j < 16; ++j) { const unsigned c = xb_ld(&bar[XB_XCNT(j)]); sum += c; cnt += (c > 0u) ? 1u : 0u; mine = (j == x) ? c : mine; }
        if (sum == G) break;
        __builtin_amdgcn_s_sleep(1);
        if ((++sp & 255u) == 0u) { if (xb_ld(&bar[XB_TMO])) break; if (sp > XB_SPIN_CAP) { atomicAdd(&bar[XB_TMO], 1u); break; } }
    }
    nloc = mine > 0u ? mine : 1u; nx = cnt > 0u ? cnt : 1u;
}

__device__ __forceinline__ void xcd_barrier(const XcdBarrier& b, const bool t0) {
    asm volatile("s_waitcnt vmcnt(0)" ::: "memory");
    __syncthreads();
    if (t0) {
        unsigned* bar = b.bar;
        __builtin_amdgcn_s_waitcnt(0);
        unsigned nloc = b.st[0], nx = b.st[1];
        if (nloc == 0u) { xcd_barrier_complete(bar, b.x, nloc, nx); b.st[0] = nloc; b.st[1] = nx; }
        const unsigned old = xb_add(&bar[XB_XSUB(b.x)], 1u);
        const unsigned gen = old / nloc;
        if (old + 1u == (gen + 1u) * nloc) {
            __builtin_amdgcn_fence(__ATOMIC_RELEASE, "agent");
            asm volatile("s_waitcnt vmcnt(0)" ::: "memory");
            const unsigned og = xb_add(&bar[XB_TOP], 1u);
            const unsigned tg = og / nx;
            if (og + 1u == (tg + 1u) * nx) xb_add(&bar[XB_TOPGEN], 1u);
            else XB_SPIN(xb_ld(&bar[XB_TOPGEN]) == tg, bar);
            __builtin_amdgcn_fence(__ATOMIC_ACQUIRE, "agent");
            xb_add(&bar[XB_XGEN(b.x)], 1u);
            asm volatile("s_waitcnt vmcnt(0)" ::: "memory");
        } else {
            XB_SPIN(xb_ld(&bar[XB_XGEN(b.x)]) == gen, bar);
            __builtin_amdgcn_fence(__ATOMIC_ACQUIRE, "agent");
            asm volatile("s_waitcnt vmcnt(0)" ::: "memory");
        }
    }
    __syncthreads();
}

constexpr size_t MiB = 1u << 20;
constexpr size_t WS_CTL = 0, CTL_ZERO_BYTES = 1 * MiB;
constexpr size_t WS_MOD = 1 * MiB;
constexpr size_t WS_ROPE = 1 * MiB + 256 * 1024;
constexpr size_t WS_TOKE = 1 * MiB + 512 * 1024;
constexpr size_t WS_TOKG = WS_TOKE + 128 * 1024;
constexpr size_t WS_TOKR = WS_TOKG + 128 * 1024;
constexpr size_t WS_TOKS = WS_TOKR + 128 * 1024;
constexpr size_t WS_META = 2 * MiB;
constexpr size_t WS_SA = 2 * MiB + 256 * 1024, WS_SH = 3 * MiB;
constexpr size_t WS_SGW = 35 * MiB + 768 * 1024;
constexpr size_t WS_LW = 34 * MiB + 512 * 1024;
constexpr size_t WS_WINE = 4 * MiB, WS_WOUTE = 8 * MiB, WS_FFN13 = 10 * MiB, WS_FFN2 = 21 * MiB, WS_WINO = 27 * MiB, WS_WOUTO = 32 * MiB;
constexpr size_t WS_MOE13 = 36 * MiB, WS_MOE2 = 124 * MiB;
constexpr size_t WS_H = 168 * MiB;
constexpr size_t WS_G1 = 201 * MiB;
constexpr size_t WS_PART = 201 * MiB;
constexpr size_t WS_MIX = 259 * MiB;
constexpr size_t WS_XC = 292 * MiB;
constexpr size_t WS_FH = 294 * MiB;
constexpr size_t WS_G2 = 201 * MiB;
constexpr size_t WS_Y1 = 284 * MiB;
constexpr size_t WS_LAF = 36 * MiB, WS_BBF = 78 * MiB, WS_LAB = 120 * MiB, WS_BBB = 324 * MiB, WS_HF = 366 * MiB;
constexpr size_t WS_HP = 168 * MiB;
constexpr size_t WS_MH = 236 * MiB;
constexpr size_t WS_YD = 36 * MiB;
constexpr size_t WS_PARTM = 168 * MiB;
constexpr size_t WS_NEED = 424 * MiB;
constexpr int CW_CNT = 64;
constexpr int CW_BAR = 4096;

constexpr int RING_BYTES = 143360, LDSCTL_OFF = RING_BYTES, MISC_OFF = LDSCTL_OFF + 320, LDS_BYTES = 147456;
constexpr int NWAVES = 8, NTHR = 512;

enum Phase { PH_PRO = 0, PH_NORM1E, PH_GIN_E, PH_MIX_E, PH_GOUT_E, PH_NORM2E, PH_FFN_UP, PH_FFN_DN, PH_NORM1O, PH_GIN_O, PH_LRU_G, PH_LRU_S, PH_GOUT_O, PH_ROUTE, PH_PERM,
             PH_MOE_UP, PH_MOE_DN, PH_COMB, NPH };
#ifndef MK_ONE_LAUNCH
#define MK_ONE_LAUNCH 1
#endif

struct Args { const float* in[34]; float* out; unsigned char* ws; int ph_lo, ph_hi; };
struct Frame {
    LAS unsigned char* lds; volatile LAS unsigned* MISC; gu32* ctl;
    int wave, vcu, G;
};

struct MapId { __device__ __forceinline__ int operator()(int n) const { return n; } };
struct MapRope {
    __device__ __forceinline__ int operator()(int n) const {
        if (n < COL_Q || n >= COL_VAL) return n;
        const int base = n < COL_K ? COL_Q : COL_K, r = n - base, h = r >> 6, d = r & 63;
        return base + h * 64 + (d & 32) + 2 * (d & 15) + ((d >> 4) & 1);
    }
};
struct MapGLU { int off; __device__ __forceinline__ int operator()(int n) const { return (n >> 7) * 256 + off + (n & 127); } };

struct TrDesc { const float* W; bf16* WT; int K, N, item, mk, off; };
__device__ __forceinline__ int tr_rowmap(int mk, int off, int n) { return mk == 0 ? n : (mk == 1 ? MapRope{}(n) : ((n >> 7) * 256 + off + (n & 127))); }
__device__ __forceinline__ void tr_load(const TrDesc& t, int lane, float (&ld)[32]) {
    const int nblk = t.N / 32, kb = t.item / nblk, nb = t.item % nblk; const float* p = t.W + (size_t)(64 * kb + (lane >> 5)) * t.N + 32 * nb + (lane & 31);
#pragma unroll
    for (int i = 0; i < 32; ++i) ld[i] = p[(size_t)(2 * i) * t.N];
}
__device__ __forceinline__ void tr_store(const TrDesc& t, int lane, LAS float* scr, const float (&ld)[32]) {
    const int nblk = t.N / 32, kb = t.item / nblk, nb = t.item % nblk, k0 = 64 * kb, n0 = 32 * nb;
#pragma unroll
    for (int i = 0; i < 32; ++i) scr[(2 * i + (lane >> 5)) * 33 + (lane & 31)] = ld[i];
    LDS_WAIT(); asm volatile("" ::: "memory");
    const int c = lane & 7;
#pragma unroll
    for (int j = 0; j < 4; ++j) { const int n = (lane >> 3) + 8 * j; const LAS float* s = scr + (8 * c) * 33 + n;
        v4u o; o.x = pk2(s[0 * 33], s[1 * 33]); o.y = pk2(s[2 * 33], s[3 * 33]); o.z = pk2(s[4 * 33], s[5 * 33]); o.w = pk2(s[6 * 33], s[7 * 33]);
        *(GAS v4u*)(t.WT + (size_t)tr_rowmap(t.mk, t.off, n0 + n) * t.K + k0 + 8 * c) = o; }
    LDS_WAIT(); asm volatile("" ::: "memory");
}
template <class D>
__device__ __forceinline__ void tr_run(const D& desc, LAS float* scr, int lane, int first, int stride, int hi) {
    int it = first; if (it >= hi) return;
    float la[32], lb[32];
    TrDesc ta = desc(it), tb = ta; tr_load(ta, lane, la);
    for (;;) {
        int nx = it + stride; bool has = nx < hi;
        if (has) { tb = desc(nx); tr_load(tb, lane, lb); }
        tr_store(ta, lane, scr, la);
        if (!has) break;
        it = nx; nx = it + stride; has = nx < hi;
        if (has) { ta = desc(nx); tr_load(ta, lane, la); }
        tr_store(tb, lane, scr, lb);
        if (!has) break;
        it = nx;
    }
}
struct ProDesc {
    const Args* A;
    __device__ __forceinline__ TrDesc operator()(int it) const {
        constexpr int I_WINE = 16 * 56, I_WOUTE = 16 * 32, I_F1 = 16 * 88, I_F2 = 44 * 32, I_WINO = 16 * 80, I_WOUTO = 20 * 32;
        unsigned char* ws = A->ws; int r = it;
        if (r < I_WINE) return TrDesc{A->in[8], (bf16*)(ws + WS_WINE), DM, NIN_E, r, 1, 0}; r -= I_WINE;
        if (r < I_WOUTE) return TrDesc{A->in[12], (bf16*)(ws + WS_WOUTE), DM, DM, r, 0, 0}; r -= I_WOUTE;
        if (r < I_F1) return TrDesc{A->in[13], (bf16*)(ws + WS_FFN13), DM, DFF, r, 2, 0}; r -= I_F1;
        if (r < I_F1) return TrDesc{A->in[14], (bf16*)(ws + WS_FFN13), DM, DFF, r, 2, 128}; r -= I_F1;
        if (r < I_F2) return TrDesc{A->in[15], (bf16*)(ws + WS_FFN2), DFF, DM, r, 0, 0}; r -= I_F2;
        if (r < I_WINO) return TrDesc{A->in[20], (bf16*)(ws + WS_WINO), DM, NIN_O, r, 0, 0}; r -= I_WINO;
        if (r < I_WOUTO) return TrDesc{A->in[28], (bf16*)(ws + WS_WOUTO), DRNN, DM, r, 0, 0}; r -= I_WOUTO;
        const int g = r / 160, mi = (r % 160) / 8, item = r % 8, dd = mi / 10, blk = mi % 10;
        return TrDesc{A->in[g ? 25 : 23] + (size_t)mi * 16384, (bf16*)(ws + WS_LW) + (size_t)((dd * 2 + g) * 10 + blk) * 16384, 128, 128, item, 0, 0};
    }
};
constexpr int PRO_NITEMS = 16 * 56 + 16 * 32 + 2 * 16 * 88 + 44 * 32 + 16 * 80 + 20 * 32 + 2 * 20 * 8;
constexpr int CVT_I_F1 = 16 * 88, CVT_I_F2 = 44 * 32, CVT_PER_E = 2 * CVT_I_F1 + CVT_I_F2, CVT_TOTAL = NEXP * CVT_PER_E;
struct MoeDesc {
    const Args* A;
    __device__ __forceinline__ TrDesc operator()(int it) const {
        unsigned char* ws = A->ws; const int e = it / CVT_PER_E; int r = it % CVT_PER_E;
        bf16* w13 = (bf16*)(ws + WS_MOE13) + (size_t)e * NFF2 * DM; bf16* w2 = (bf16*)(ws + WS_MOE2) + (size_t)e * DM * DFF;
        if (r < CVT_I_F1) return TrDesc{A->in[30] + (size_t)e * DM * DFF, w13, DM, DFF, r, 2, 0}; r -= CVT_I_F1;
        if (r < CVT_I_F1) return TrDesc{A->in[31] + (size_t)e * DM * DFF, w13, DM, DFF, r, 2, 128}; r -= CVT_I_F1;
        return TrDesc{A->in[32] + (size_t)e * DFF * DM, w2, DFF, DM, r, 0, 0};
    }
};

__device__ __forceinline__ void ph_prologue(const Args& A, Frame& F) {
    const int lane = lane_id_asm(), tid = F.wave * 64 + lane; (void)tid;
    unsigned char* ws = A.ws;
    LAS float* sact = (LAS float*)F.lds;
    LAS float* red = sact + 3 * 1024;
    for (int t = tid; t < 3 * 1024; t += NTHR) { const int v = t >> 10, k = t & 1023; const float x = v < 2 ? A.in[1][v * 1024 + k] : A.in[3][k]; sact[t] = silu_f(x); }
    __syncthreads();
    float* mod = (float*)(ws + WS_MOD);
    for (int item = blockIdx.x; item < 256; item += F.G) {
        const int L = item >> 7, ch = item & 127; const float* W = (L ? A.in[16] : A.in[4]) + ch * 48; const float* bias = (L ? A.in[17] : A.in[5]);
        if (tid < 504) {
            const int c4 = tid % 12, ks = tid / 12; f32x4 a0 = {0.f, 0.f, 0.f, 0.f}, a1 = a0, a2 = a0;
#pragma unroll 8
            for (int k = ks; k < 1024; k += 42) { const f32x4 w = *(const f32x4*)(W + (size_t)k * 6144 + c4 * 4); a0 += sact[k] * w; a1 += sact[1024 + k] * w; a2 += sact[2048 + k] * w; }
            LAS float* r = red + ks * 144 + c4 * 4;
#pragma unroll
            for (int j = 0; j < 4; ++j) { r[j] = a0[j]; r[48 + j] = a1[j]; r[96 + j] = a2[j]; }
        }
        __syncthreads();
        if (tid < 144) { const int v = tid / 48, cc = tid % 48, n = ch * 48 + cc; float s = 0.f; for (int ks = 0; ks < 42; ++ks) s += red[ks * 144 + tid]; mod[(L * 3 + v) * 6144 + n] = s + bias[n]; }
        __syncthreads();
    }
    { const int idx = blockIdx.x * NTHR + tid; if (idx < 128 * 16) { const int pos = idx >> 4, f = idx & 15; const float freq = fexp2(-(float)f * (13.287712379549449f / 16.f)); const float rev = (float)pos * freq * 0.15915494309189535f;
        float* rp = (float*)(ws + WS_ROPE) + idx * 2; rp[0] = __builtin_amdgcn_cosf(rev); rp[1] = __builtin_amdgcn_sinf(rev); } }
    { const int idx = blockIdx.x * NTHR + tid; if (idx < 4 * 128 * 128 / 4) { const f32x4 v = ((const f32x4*)A.in[9])[idx]; v2u o; o.x = pk2(v[0], v[1]); o.y = pk2(v[2], v[3]); ((v2u*)(ws + WS_SGW))[idx] = o; } }
    LAS float* scr = (LAS float*)(F.lds + F.wave * 16384);
    tr_run(ProDesc{&A}, scr, lane, F.vcu * NWAVES + F.wave, F.G * NWAVES, PRO_NITEMS);
}
__device__ __forceinline__ void convert_moe_range(const Args& A, Frame& F, int lo, int hi, int nblk, int brank) {
    const int lane = lane_id_asm();
    tr_run(MoeDesc{&A}, (LAS float*)(F.lds + F.wave * 16384), lane, lo + brank * NWAVES + F.wave, nblk * NWAVES, hi);
}
constexpr int CVT_S1 = 2000, CVT_S2 = 5360, CVT_S3 = 10080, CVT_S4 = 14400, CVT_S5 = 20544, CVT_S6 = CVT_S5 + 1792, CVT_S7 = CVT_S6 + 1344;
constexpr int CVT_NFILL = 6, CVT_FILL_END = (CVT_S7 + CVT_NFILL * 256 * 7 < CVT_TOTAL) ? CVT_S7 + CVT_NFILL * 256 * 7 : CVT_TOTAL;

__device__ __forceinline__ void norm_mod_v(const float* gain, const float* scale, const float* shift, int lane, f32x4 (&v)[4]) {
    float ss = 0.f;
#pragma unroll
    for (int j = 0; j < 4; ++j) ss += (v[j][0] * v[j][0] + v[j][1] * v[j][1]) + (v[j][2] * v[j][2] + v[j][3] * v[j][3]);
    const float rstd = 1.f / sqrtf(wave_sum(ss) * (1.f / DM) + EPS);
#pragma unroll
    for (int j = 0; j < 4; ++j) { const f32x4 g = ((const f32x4*)gain)[lane + 64 * j], sc = ((const f32x4*)scale)[lane + 64 * j], sh = ((const f32x4*)shift)[lane + 64 * j];
        v[j] = v[j] * rstd * g * (1.f + sc) + sh; }
}
__device__ __forceinline__ void norm_mod_regs(const float* xrow, const float* gain, const float* scale, const float* shift, int lane, f32x4 (&v)[4]) {
    const f32x4* xr = (const f32x4*)xrow + lane;
#pragma unroll
    for (int j = 0; j < 4; ++j) v[j] = xr[64 * j];
    norm_mod_v(gain, scale, shift, lane, v);
}
struct RowMod { f32x4 gs[4], sh[4]; };
__device__ __forceinline__ RowMod load_rowmod(const float* gain, const float* scale, const float* shift, int lane) {
    RowMod m;
#pragma unroll
    for (int j = 0; j < 4; ++j) { m.gs[j] = ((const f32x4*)gain)[lane + 64 * j] * (1.f + ((const f32x4*)scale)[lane + 64 * j]); m.sh[j] = ((const f32x4*)shift)[lane + 64 * j]; }
    return m;
}
__device__ __forceinline__ void load_row(const float* xrow, int lane, f32x4 (&v)[4]) {
    const f32x4* xr = (const f32x4*)xrow + lane;
#pragma unroll
    for (int j = 0; j < 4; ++j) v[j] = xr[64 * j];
}
__device__ __forceinline__ void norm_apply(const RowMod& m, f32x4 (&v)[4]) {
    float ss = 0.f;
#pragma unroll
    for (int j = 0; j < 4; ++j) ss += (v[j][0] * v[j][0] + v[j][1] * v[j][1]) + (v[j][2] * v[j][2] + v[j][3] * v[j][3]);
    const float rstd = 1.f / sqrtf(wave_sum(ss) * (1.f / DM) + EPS);
#pragma unroll
    for (int j = 0; j < 4; ++j) v[j] = v[j] * rstd * m.gs[j] + m.sh[j];
}
__device__ __forceinline__ void store_row_bf16(bf16* orow, int lane, const f32x4 (&v)[4]) {
    GAS v2u* o = (GAS v2u*)orow + lane;
#pragma unroll
    for (int j = 0; j < 4; ++j) { v2u w; w.x = pk2(v[j][0], v[j][1]); w.y = pk2(v[j][2], v[j][3]); o[64 * j] = w; }
}
struct CtxFix { const float* part; int nsplit; const float* gate; const float* base; float* xout; };
__device__ __forceinline__ void ph_norm(Frame& F, const float* xl, const float* xc, const float* gain, const float* modL, int p_shift, int p_scale, bf16* H, int nrows, const CtxFix cf) {
    const int lane = lane_id_asm();
    const int gw = F.vcu * NWAVES + F.wave, NGW = F.G * NWAVES, per = MLAT / NGW;
    for (int r0 = gw * per; r0 < MLAT; r0 += NGW * per) {
        const float* md = modL + mod_of_row(r0) * 6144; const RowMod m = load_rowmod(gain, md + p_scale * 1024, md + p_shift * 1024, lane);
        f32x4 cur[4], nxt[4]; load_row(xl + (size_t)r0 * DM, lane, cur);
        for (int i = 0; i < per; ++i) {
            if (i + 1 < per) load_row(xl + (size_t)(r0 + i + 1) * DM, lane, nxt);
            norm_apply(m, cur); store_row_bf16(H + (size_t)(r0 + i) * DM, lane, cur);
#pragma unroll
            for (int j = 0; j < 4; ++j) cur[j] = nxt[j];
        }
    }
    for (int r = MLAT + gw; r < nrows; r += NGW) {
        const float* md = modL + 2 * 6144; const RowMod m = load_rowmod(gain, md + p_scale * 1024, md + p_shift * 1024, lane);
        f32x4 v[4]; const size_t ro = (size_t)(r - MLAT) * DM;
        if (cf.nsplit > 0) {
#pragma unroll
            for (int j = 0; j < 4; ++j) { f32x4 s = ((const f32x4*)(cf.part + ro))[lane + 64 * j];
                for (int kp = 1; kp < cf.nsplit; ++kp) s += ((const f32x4*)(cf.part + (size_t)kp * MCTX * DM + ro))[lane + 64 * j];
                v[j] = ((const f32x4*)(cf.base + ro))[lane + 64 * j] + ((const f32x4*)cf.gate)[lane + 64 * j] * s;
                ((f32x4*)(cf.xout + ro))[lane + 64 * j] = v[j]; }
        } else load_row(xc + ro, lane, v);
        norm_apply(m, v); store_row_bf16(H + (size_t)r * DM, lane, v);
    }
}

__device__ __forceinline__ void route_logits(const LAS float* rw, int lane, const f32x4 (&v)[4], float (&lg)[8]) {
#pragma unroll
    for (int e = 0; e < 8; ++e) { float s = 0.f;
#pragma unroll
        for (int j = 0; j < 4; ++j) { const f32x4 w = *(const LAS f32x4*)(rw + e * 1024 + 4 * (lane + 64 * j)); s += (v[j][0] * w[0] + v[j][1] * w[1]) + (v[j][2] * w[2] + v[j][3] * w[3]); }
        lg[e] = wave_sum(s); }
}
__device__ __forceinline__ void ph_route(const Args& A, Frame& F) {
    const int lane = lane_id_asm(), tid = F.wave * 64 + lane;
    LAS float* rw = (LAS float*)F.lds; LAS unsigned* lcnt = (LAS unsigned*)(F.lds + 32768);
    for (int i = tid; i < DM * 8; i += NTHR) rw[(i & 7) * 1024 + (i >> 3)] = A.in[29][i];
    if (tid < 16) lcnt[tid] = 0u;
    __syncthreads();
    int* toke = (int*)(A.ws + WS_TOKE); float* tokg = (float*)(A.ws + WS_TOKG); int* tokr = (int*)(A.ws + WS_TOKR);
    for (int t0 = blockIdx.x * 64; t0 < MLAT; t0 += F.G * 64) {
        const float* md = (const float*)(A.ws + WS_MOD) + (3 + (t0 >> 13)) * 6144; const RowMod m = load_rowmod(A.in[19], md + 4 * 1024, md + 3 * 1024, lane);
        const int tb = t0 + F.wave * 8;
        f32x4 cur[4], nxt[4]; load_row(A.out + (size_t)tb * DM, lane, cur);
        for (int i = 0; i < 8; ++i) {
            const int t = tb + i;
            if (i + 1 < 8) load_row(A.out + (size_t)(t + 1) * DM, lane, nxt);
            norm_apply(m, cur);
            float lg[8]; route_logits(rw, lane, cur, lg);
            int i0 = 0; float l0 = lg[0];
#pragma unroll
            for (int e = 1; e < 8; ++e) if (lg[e] > l0) { l0 = lg[e]; i0 = e; }
            int i1 = -1; float l1 = -INFINITY;
#pragma unroll
            for (int e = 0; e < 8; ++e) if (e != i0 && lg[e] > l1) { l1 = lg[e]; i1 = e; }
            const float g0 = 1.f / (1.f + expf(l1 - l0)), g1 = 1.f - g0;
            if (lane == 0) {
                const int r0 = (int)__hip_atomic_fetch_add(lcnt + i0, 1u, __ATOMIC_RELAXED, __HIP_MEMORY_SCOPE_WORKGROUP), r1 = (int)__hip_atomic_fetch_add(lcnt + i1, 1u, __ATOMIC_RELAXED, __HIP_MEMORY_SCOPE_WORKGROUP);
                toke[t] = i0; toke[MLAT + t] = i1; tokg[t] = g0; tokg[MLAT + t] = g1; tokr[t] = r0; tokr[MLAT + t] = r1;
            }
#pragma unroll
            for (int j = 0; j < 4; ++j) cur[j] = nxt[j];
        }
        __syncthreads();
        if (tid < 8) { const unsigned c = lcnt[tid]; lcnt[8 + tid] = c ? __hip_atomic_fetch_add((unsigned*)(F.ctl + CW_CNT + 16 * tid), c, RLX_AGENT) : 0u; }
        __syncthreads();
        if (tid < 128) { const int idx = (tid & 1) * MLAT + t0 + (tid >> 1); tokr[idx] += (int)lcnt[8 + toke[idx]]; }
        __syncthreads();
        if (tid < 8) lcnt[tid] = 0u;
        __syncthreads();
    }
}
__device__ __forceinline__ void ph_permute(const Args& A, Frame& F) {
    const int lane = lane_id_asm(), tid = F.wave * 64 + lane; (void)tid;
    const int* toke = (const int*)(A.ws + WS_TOKE); const int* tokr = (const int*)(A.ws + WS_TOKR); int* toks = (int*)(A.ws + WS_TOKS); int* meta = (int*)(A.ws + WS_META); bf16* HP = (bf16*)(A.ws + WS_HP);
    int off[8]; int tot = 0;
#pragma unroll
    for (int e = 0; e < 8; ++e) { const int c = (int)__hip_atomic_load((unsigned*)(F.ctl + CW_CNT + 16 * e), RLX_AGENT); off[e] = tot; tot += ((c + 255) >> 8) << 8; }
    if (blockIdx.x == 0 && tid < MOE_MAXT + 8) { int e = 0;
#pragma unroll
        for (int k = 1; k < 8; ++k) if (tid * 256 >= off[k]) e = k;
        meta[tid] = e; if (tid == 0) meta[256] = tot >> 8; }
    const int gw = F.vcu * NWAVES + F.wave, NGW = F.G * NWAVES, per = MLAT / NGW;
    for (int r0 = gw * per; r0 < MLAT; r0 += NGW * per) {
        const float* md = (const float*)(A.ws + WS_MOD) + (3 + (r0 >> 13)) * 6144; const RowMod m = load_rowmod(A.in[19], md + 4 * 1024, md + 3 * 1024, lane);
        f32x4 cur[4], nxt[4]; load_row(A.out + (size_t)r0 * DM, lane, cur);
        for (int i = 0; i < per; ++i) {
            const int t = r0 + i;
            if (i + 1 < per) load_row(A.out + (size_t)(t + 1) * DM, lane, nxt);
            const int e0 = toke[t], e1 = toke[MLAT + t]; int s0 = tokr[t], s1 = tokr[MLAT + t];
            norm_apply(m, cur);
            int o0 = 0, o1 = 0;
#pragma unroll
            for (int k = 0; k < 8; ++k) { if (k == e0) o0 = off[k]; if (k == e1) o1 = off[k]; }
            s0 += o0; s1 += o1;
            store_row_bf16(HP + (size_t)s0 * DM, lane, cur); store_row_bf16(HP + (size_t)s1 * DM, lane, cur);
            if (lane == 0) { toks[t] = s0; toks[MLAT + t] = s1; }
#pragma unroll
            for (int j = 0; j < 4; ++j) cur[j] = nxt[j];
        }
    }
}
struct CombRow { f32x4 x[4]; v2u a[4], b[4]; };
__device__ __forceinline__ void comb_load(const Args& A, int t, int s0, int s1, int lane, CombRow& r) {
    const bf16* YD = (const bf16*)(A.ws + WS_YD);
    const f32x4* xr = (const f32x4*)(A.out + (size_t)t * DM) + lane; const v2u* y0 = (const v2u*)(YD + (size_t)(s0 < 32768 ? s0 : 0) * DM) + lane; const v2u* y1 = (const v2u*)(YD + (size_t)(s1 < 32768 ? s1 : 0) * DM) + lane;
#pragma unroll
    for (int j = 0; j < 4; ++j) { r.x[j] = xr[64 * j]; r.a[j] = y0[64 * j]; r.b[j] = y1[64 * j]; }
}
__device__ __forceinline__ f32x4 bf4(v2u a) { return (f32x4){bflo(a.x), bfhi(a.x), bflo(a.y), bfhi(a.y)}; }
__device__ __forceinline__ void ph_combine(const Args& A, Frame& F, float* outp) {
    const int lane = lane_id_asm();
    const float* tokg = (const float*)(A.ws + WS_TOKG); const int* toks = (const int*)(A.ws + WS_TOKS); const float* fn = A.in[33];
    const bf16* PM = (const bf16*)(A.ws + WS_PARTM);
    const int gw = F.vcu * NWAVES + F.wave, NGW = F.G * NWAVES, per = MLAT / NGW;
    for (int r0 = gw * per; r0 < MLAT; r0 += NGW * per) {
        const float* g2p = (const float*)(A.ws + WS_MOD) + (3 + (r0 >> 13)) * 6144 + 5 * 1024;
        f32x4 g2[4], fnv[4];
#pragma unroll
        for (int j = 0; j < 4; ++j) { g2[j] = ((const f32x4*)g2p)[lane + 64 * j]; fnv[j] = ((const f32x4*)fn)[lane + 64 * j]; }
        const int li = lane < per ? lane : per - 1;
        const int ms0 = toks[r0 + li], ms1 = toks[MLAT + r0 + li]; const float mg0 = tokg[r0 + li], mg1 = tokg[MLAT + r0 + li];
        CombRow cur, nxt; comb_load(A, r0, __shfl(ms0, 0), __shfl(ms1, 0), lane, cur);
        for (int i = 0; i < per; ++i) {
            const int t = r0 + i; const int s0 = __shfl(ms0, i), s1 = __shfl(ms1, i); const float g0 = __shfl(mg0, i), g1 = __shfl(mg1, i);
            if (i + 1 < per) comb_load(A, t + 1, __shfl(ms0, i + 1), __shfl(ms1, i + 1), lane, nxt);
            f32x4 z[4]; float ss = 0.f;
#pragma unroll
            for (int j = 0; j < 4; ++j) {
                f32x4 ya = bf4(cur.a[j]), yb = bf4(cur.b[j]);
                if (s0 >= 32768) { ya = (f32x4){0.f, 0.f, 0.f, 0.f}; for (int kp = 0; kp < 11; ++kp) ya += bf4(((const v2u*)(PM + ((size_t)kp * 2048 + (s0 - 32768)) * DM))[lane + 64 * j]); }
                if (s1 >= 32768) { yb = (f32x4){0.f, 0.f, 0.f, 0.f}; for (int kp = 0; kp < 11; ++kp) yb += bf4(((const v2u*)(PM + ((size_t)kp * 2048 + (s1 - 32768)) * DM))[lane + 64 * j]); }
                z[j] = cur.x[j] + g2[j] * (g0 * ya + g1 * yb); ss += (z[j][0] * z[j][0] + z[j][1] * z[j][1]) + (z[j][2] * z[j][2] + z[j][3] * z[j][3]); }
            const float rstd = 1.f / sqrtf(wave_sum(ss) * (1.f / DM) + EPS);
            f32x4* orow = (f32x4*)(outp + (size_t)t * DM) + lane;
#pragma unroll
            for (int j = 0; j < 4; ++j) orow[64 * j] = z[j] * rstd * fnv[j];
            cur = nxt;
        }
    }
}
template <class Fill>
__device__ __forceinline__ void xcd_barrier_fill(const XcdBarrier& b, const bool t0, const Fill& fill) {
    asm volatile("s_waitcnt vmcnt(0)" ::: "memory");
    __syncthreads();
    if (t0) {
        unsigned* bar = b.bar;
        __builtin_amdgcn_s_waitcnt(0);
        unsigned nloc = b.st[0], nx = b.st[1];
        if (nloc == 0u) { xcd_barrier_complete(bar, b.x, nloc, nx); b.st[0] = nloc; b.st[1] = nx; }
        const unsigned old = xb_add(&bar[XB_XSUB(b.x)], 1u);
        const unsigned gen = old / nloc;
        if (old + 1u == (gen + 1u) * nloc) {
            __builtin_amdgcn_fence(__ATOMIC_RELEASE, "agent");
            asm volatile("s_waitcnt vmcnt(0)" ::: "memory");
            const unsigned og = xb_add(&bar[XB_TOP], 1u);
            const unsigned tg = og / nx;
            if (og + 1u == (tg + 1u) * nx) xb_add(&bar[XB_TOPGEN], 1u);
            else XB_SPIN(xb_ld(&bar[XB_TOPGEN]) == tg, bar);
            __builtin_amdgcn_fence(__ATOMIC_ACQUIRE, "agent");
            xb_add(&bar[XB_XGEN(b.x)], 1u);
            asm volatile("s_waitcnt vmcnt(0)" ::: "memory");
        } else {
            XB_SPIN(xb_ld(&bar[XB_XGEN(b.x)]) == gen, bar);
            __builtin_amdgcn_fence(__ATOMIC_ACQUIRE, "agent");
            asm volatile("s_waitcnt vmcnt(0)" ::: "memory");
        }
    }
    fill();
    __syncthreads();
}

constexpr int RCP = 272, HFL_OFF = 256 * RCP;
__device__ __forceinline__ void lru_ab(float rp, float ip, float rcv, float nba, float nbx, float kc, float& a, float& b) {
    const float rg = frcp(1.f + fexp2(fmaf(rp, -LOG2E, nba)));
    const float ig = frcp(1.f + fexp2(fmaf(ip, -LOG2E, nbx)));
    const float la = kc * rg;
    a = fexp2(la * LOG2E);
    const float om = fmaf(-a, a, 1.f);
    b = __builtin_amdgcn_sqrtf(om) * (ig * rcv);
}
template <bool PASS3>
__device__ __forceinline__ void lru_unit(const Args& A, Frame& F, int pm, int blk) {
    const bf16* G2 = (const bf16*)(A.ws + WS_G2);
    LAS unsigned char* rcT = F.lds;
    const int lane = lane_id_asm(), tid = F.wave * 64 + lane, r0 = pm * 256, w = F.wave, c = lane & 15, q = lane >> 4;
    int seg_lo, seg_hi; if (pm < 64) { seg_lo = (pm >> 5) * SEQ; seg_hi = seg_lo + SEQ; } else { seg_lo = r0; seg_hi = r0 + 256; }
    {
        const int c8 = tid & 15, rgp = tid >> 4, ch0 = blk * 128 + c8 * 8;
        const float* cw = A.in[21]; const float* cb = A.in[22];
        f32x4 wj[4][2], cbv[2];
#pragma unroll
        for (int j = 0; j < 4; ++j) { wj[j][0] = *(const f32x4*)(cw + j * DRNN + ch0); wj[j][1] = *(const f32x4*)(cw + j * DRNN + ch0 + 4); }
        cbv[0] = *(const f32x4*)(cb + ch0); cbv[1] = *(const f32x4*)(cb + ch0 + 4);
        v4u x[11];
#pragma unroll
        for (int i = 0; i < 11; ++i) { const int grow = r0 + rgp * 8 + i - 2; const bool ok = (grow >= seg_lo) && (grow < seg_hi); const int gc = grow < seg_lo ? seg_lo : (grow >= seg_hi ? seg_hi - 1 : grow);
            const v4u t = *(const v4u*)(G2 + (size_t)gc * NIN_O + DRNN + ch0); x[i].x = ok ? t.x : 0u; x[i].y = ok ? t.y : 0u; x[i].z = ok ? t.z : 0u; x[i].w = ok ? t.w : 0u; }
#pragma unroll
        for (int r = 0; r < 8; ++r) { f32x4 o0 = cbv[0], o1 = cbv[1];
#pragma unroll
            for (int j = 0; j < 4; ++j) { const v4u t = x[r + j]; o0 += wj[j][0] * (f32x4){bflo(t.x), bfhi(t.x), bflo(t.y), bfhi(t.y)}; o1 += wj[j][1] * (f32x4){bflo(t.z), bfhi(t.z), bflo(t.w), bfhi(t.w)}; }
            v4u pk; pk.x = pk2(o0[0], o0[1]); pk.y = pk2(o0[2], o0[3]); pk.z = pk2(o1[0], o1[1]); pk.w = pk2(o1[2], o1[3]);
            *(LAS v4u*)(rcT + (rgp * 8 + r) * RCP + c8 * 16) = pk; }
    }
    __syncthreads();
    if (w >= 4) __builtin_amdgcn_s_sleep(13);
    const int ch = blk * 128 + 16 * w + c;
    float* SA = (float*)(A.ws + WS_SA); float* SH = (float*)(A.ws + WS_SH);
    pg8::bf16x8 Bid;
#pragma unroll
    for (int e = 0; e < 8; ++e) Bid[e] = (8 * q + e == (w & 1) * 16 + c) ? (short)0x3F80 : (short)0;
    float cin = 0.f;
    if (PASS3) {
        const int d = (lane >> 4) & 1, b = pm >> 5; const int chc = blk * 128 + 16 * w + (lane & 15);
#pragma unroll 11
        for (int s = 0; s < 33; ++s) {
            int T; bool ok;
            if (s == 0) { T = 64 + b; ok = true; } else if (d == 0) { T = 32 * b + s - 1; ok = T < pm; } else { T = 32 * b + 32 - s; ok = T > pm; }
            const int Tc = ok ? T : pm;
            const float av = SA[(size_t)(Tc * 2 + d) * DRNN + chc], hv = SH[(size_t)(Tc * 2 + d) * DRNN + chc];
            if (ok) cin = av * cin + hv;
        }
    }
    LAS unsigned* hfl = (LAS unsigned*)(F.lds + HFL_OFF + w * 8192) + lane;
    bf16* Y1 = (bf16*)(A.ws + WS_Y1);
#pragma unroll
    for (int d = 0; d < 2; ++d) {
        const float nba = -LOG2E * A.in[24][d * DRNN + ch], nbx = -LOG2E * A.in[26][d * DRNN + ch], kc = -8.f * log1pf(expf(-A.in[27][d * DRNN + ch]));
        pg8::bf16x8 Bw[2][4];
        { const bf16* LW = (const bf16*)(A.ws + WS_LW);
#pragma unroll
          for (int g = 0; g < 2; ++g)
#pragma unroll
            for (int ks = 0; ks < 4; ++ks) Bw[g][ks] = *(const pg8::bf16x8*)(LW + (size_t)((d * 2 + g) * 10 + blk) * 16384 + (16 * w + c) * 128 + ks * 32 + 8 * q); }
        float a_run = 1.f, h_run = PASS3 ? __shfl(cin, d * 16 + c) : 0.f;
#pragma unroll 1
        for (int gi = 0; gi < 4; ++gi) {
            const int g4 = d == 0 ? gi : 3 - gi;
            float gt[4][4];
            if (PASS3 && d == 1) {
#pragma unroll
                for (int mm = 0; mm < 4; ++mm)
#pragma unroll
                    for (int r = 0; r < 4; ++r) gt[mm][r] = bf2f(G2[(size_t)(r0 + (g4 * 4 + mm) * 16 + 4 * q + r) * NIN_O + ch]);
            }
            pg8::f32x4 acc[2][4], rcv[4];
#pragma unroll
            for (int mm = 0; mm < 4; ++mm) { acc[0][mm] = (pg8::f32x4){0.f, 0.f, 0.f, 0.f}; acc[1][mm] = acc[0][mm]; rcv[mm] = acc[0][mm]; }
#pragma unroll
            for (int mm = 0; mm < 4; ++mm) {
                const LAS unsigned char* ap = rcT + ((g4 * 4 + mm) * 16 + c) * RCP + q * 16;
                pg8::bf16x8 af[4];
#pragma unroll
                for (int ks = 0; ks < 4; ++ks) af[ks] = *(const LAS pg8::bf16x8*)(ap + ks * 64);
                const pg8::bf16x8 afi = *(const LAS pg8::bf16x8*)(ap + (w >> 1) * 64);
#pragma unroll
                for (int ks = 0; ks < 4; ++ks) {
                    acc[0][mm] = __builtin_amdgcn_mfma_f32_16x16x32_bf16(af[ks], Bw[0][ks], acc[0][mm], 0, 0, 0);
                    acc[1][mm] = __builtin_amdgcn_mfma_f32_16x16x32_bf16(af[ks], Bw[1][ks], acc[1][mm], 0, 0, 0);
                }
                rcv[mm] = __builtin_amdgcn_mfma_f32_16x16x32_bf16(afi, Bid, rcv[mm], 0, 0, 0);
            }
#pragma unroll
            for (int mmi = 0; mmi < 4; ++mmi) {
                const int mm = d == 0 ? mmi : 3 - mmi, m = g4 * 4 + mm;
                float av[4], bv[4];
#pragma unroll
                for (int r = 0; r < 4; ++r) lru_ab(acc[0][mm][r], acc[1][mm][r], rcv[mm][r], nba, nbx, kc, av[r], bv[r]);
                float A4, B4;
                if (d == 0) { A4 = av[0] * av[1] * av[2] * av[3]; B4 = ((bv[0] * av[1] + bv[1]) * av[2] + bv[2]) * av[3] + bv[3]; }
                else        { A4 = av[0] * av[1] * av[2] * av[3]; B4 = ((bv[3] * av[2] + bv[2]) * av[1] + bv[1]) * av[0] + bv[0]; }
                float TA[4], TB[4];
#pragma unroll
                for (int k = 0; k < 4; ++k) { TA[k] = __shfl(A4, c + 16 * k); TB[k] = __shfl(B4, c + 16 * k); }
                float EA = 1.f, EB = 0.f, PA = 1.f, PB = 0.f;
#pragma unroll
                for (int k = 0; k < 4; ++k) { const int kk = d == 0 ? k : 3 - k; if (kk == q) { EA = PA; EB = PB; } PB = TA[kk] * PB + TB[kk]; PA = PA * TA[kk]; }
                if (PASS3) {
                    float h = EA * h_run + EB; float hv[4];
#pragma unroll
                    for (int ri = 0; ri < 4; ++ri) { const int r = d == 0 ? ri : 3 - ri; h = av[r] * h + bv[r]; hv[r] = h; }
                    if (d == 0) { hfl[(m * 2 + 0) * 64] = pk2(hv[0], hv[1]); hfl[(m * 2 + 1) * 64] = pk2(hv[2], hv[3]); }
                    else { const unsigned f0 = hfl[(m * 2 + 0) * 64], f1 = hfl[(m * 2 + 1) * 64];
                        const size_t row = (size_t)(r0 + m * 16 + 4 * q);
                        Y1[(row + 0) * DRNN + ch] = f2bf1(gt[mm][0] * (bflo(f0) + hv[0])); Y1[(row + 1) * DRNN + ch] = f2bf1(gt[mm][1] * (bfhi(f0) + hv[1]));
                        Y1[(row + 2) * DRNN + ch] = f2bf1(gt[mm][2] * (bflo(f1) + hv[2])); Y1[(row + 3) * DRNN + ch] = f2bf1(gt[mm][3] * (bfhi(f1) + hv[3])); }
                }
                h_run = PA * h_run + PB; a_run *= PA;
            }
        }
        if (!PASS3) { if (q == 0) { SA[(size_t)(pm * 2 + d) * DRNN + ch] = a_run; SH[(size_t)(pm * 2 + d) * DRNN + ch] = h_run; } }
    }
    __syncthreads();
}
template <bool PASS3>
__device__ __forceinline__ void ph_lru(const Args& A, Frame& F) {
    const int ntile = PASS3 ? 64 : 66;
    for (int u = blockIdx.x; u < ntile * 10; u += F.G) lru_unit<PASS3>(A, F, u / 10, u % 10);
}

typedef short s16x4 __attribute__((ext_vector_type(4)));
__device__ __forceinline__ s16x4 lds_tr16(const LAS unsigned char* p) { return __builtin_bit_cast(s16x4, __builtin_amdgcn_ds_read_tr16_b64_v4i16((LAS s16x4*)p)); }
constexpr int KP = 144, VP = 160;
constexpr int ATT_KOFF = 0, ATT_VOFF = 2 * 64 * KP, ATT_QOFF = ATT_VOFF + 2 * 64 * VP;
__device__ __forceinline__ void attn_unit(const Args& A, Frame& F, int b, int kvh, int qb, bool ctxq) {
    const bf16* G1 = (const bf16*)(A.ws + WS_G1); bf16* MIX = (bf16*)(A.ws + WS_MIX);
    const int lane = lane_id_asm(), tid = F.wave * 64 + lane, w = F.wave, li = lane & 15, g = lane >> 4, hw = w & 1, h = kvh * 4 + (w >> 1);
    const int qrow0 = (ctxq ? MLAT + b * CTXL : b * SEQ) + qb * 128 + 64 * hw;
    LAS unsigned char* lQ = F.lds + ATT_QOFF + w * (64 * KP);
#pragma unroll
    for (int i = 0; i < 8; ++i) { const int ck = lane + 64 * i, row = ck >> 3, dc = ck & 7;
        *(LAS v4u*)(lQ + row * KP + dc * 16) = *(const v4u*)(G1 + (size_t)(qrow0 + row) * NIN_E + COL_Q + h * 64 + 8 * dc); }
    const float sk = A.in[11][h] * LOG2E;
    float mrun[4], lrun[4]; pg8::f32x4 O[4][4];
#pragma unroll
    for (int mt = 0; mt < 4; ++mt) { mrun[mt] = sk; lrun[mt] = (g == 0) ? 1.f : 0.f;
#pragma unroll
        for (int dt = 0; dt < 4; ++dt) O[dt][mt] = (pg8::f32x4){0.f, 0.f, 0.f, 0.f}; }
    const int t_first = ctxq ? 6 : (qb == 0 ? 2 : 0), t_hi = ctxq ? 6 : (qb == SEQ / 128 - 1 ? 4 : 6);
    const int skey = tid >> 3, sdc = tid & 7;
    LAS unsigned char* lK = F.lds + ATT_KOFF; LAS unsigned char* lV = F.lds + ATT_VOFF;
    int cur = t_first, buf = 0;
    { const size_t rowb = cur < 6 ? (size_t)b * SEQ + (qb - 1) * 128 + 64 * cur : (size_t)MLAT + b * CTXL + 64 * (cur - 6);
      const bf16* src = G1 + (rowb + skey) * NIN_E + kvh * 64 + 8 * sdc;
      const v4u kr = *(const v4u*)(src + COL_K), vr = *(const v4u*)(src + COL_VAL);
      *(LAS v4u*)(lK + skey * KP + sdc * 16) = kr; *(LAS v4u*)(lV + skey * VP + sdc * 16) = vr; }
    __syncthreads();
    for (;;) {
        const int nxt = (cur < 6 && cur + 1 == t_hi) ? 6 : cur + 1; const bool has = nxt < 10;
        v4u kr = {0u, 0u, 0u, 0u}, vr = {0u, 0u, 0u, 0u};
        if (has) { const size_t rowb = nxt < 6 ? (size_t)b * SEQ + (qb - 1) * 128 + 64 * nxt : (size_t)MLAT + b * CTXL + 64 * (nxt - 6);
            const bf16* src = G1 + (rowb + skey) * NIN_E + kvh * 64 + 8 * sdc; kr = *(const v4u*)(src + COL_K); vr = *(const v4u*)(src + COL_VAL); }
        const bool skip = (cur == 0 && hw == 1) || (cur == 5 && hw == 0);
        if (!skip) {
            const LAS unsigned char* kb = lK + buf * (64 * KP); const LAS unsigned char* vb = lV + buf * (64 * VP);
            pg8::bf16x8 Kf[4][2];
#pragma unroll
            for (int nt = 0; nt < 4; ++nt)
#pragma unroll
                for (int ks = 0; ks < 2; ++ks) Kf[nt][ks] = *(const LAS pg8::bf16x8*)(kb + (16 * nt + li) * KP + (32 * ks + 8 * g) * 2);
            const int kpos0 = (qb - 1) * 128 + 64 * cur;
            float alpha[4]; pg8::bf16x8 Pf[4][2];
#pragma unroll
            for (int mt = 0; mt < 4; ++mt) {
                pg8::f32x4 S[4];
#pragma unroll
                for (int nt = 0; nt < 4; ++nt) S[nt] = (pg8::f32x4){0.f, 0.f, 0.f, 0.f};
#pragma unroll
                for (int ks = 0; ks < 2; ++ks)
                    { const pg8::bf16x8 qf = *(const LAS pg8::bf16x8*)(lQ + (16 * mt + li) * KP + (32 * ks + 8 * g) * 2);
#pragma unroll
                    for (int nt = 0; nt < 4; ++nt) S[nt] = __builtin_amdgcn_mfma_f32_16x16x32_bf16(Kf[nt][ks], qf, S[nt], 0, 0, 0); }
                if (cur < 2 || cur == 4 || cur == 5) {
                    const int tq = qb * 128 + 64 * hw + 16 * mt + li;
#pragma unroll
                    for (int nt = 0; nt < 4; ++nt)
#pragma unroll
                        for (int r = 0; r < 4; ++r) { const int tk = kpos0 + 16 * nt + 4 * g + r; const int df = cur < 2 ? tq - tk : tk - tq; if (df > 128) S[nt][r] = -INFINITY; }
                }
                float mx = fmaxf(fmaxf(fmaxf(S[0][0], S[0][1]), fmaxf(S[0][2], S[0][3])), fmaxf(fmaxf(S[1][0], S[1][1]), fmaxf(S[1][2], S[1][3])));
                mx = fmaxf(mx, fmaxf(fmaxf(fmaxf(S[2][0], S[2][1]), fmaxf(S[2][2], S[2][3])), fmaxf(fmaxf(S[3][0], S[3][1]), fmaxf(S[3][2], S[3][3]))));
                mx = fmaxf(mx, __shfl_xor(mx, 16)); mx = fmaxf(mx, __shfl_xor(mx, 32));
                const float mnew = fmaxf(mrun[mt], mx); alpha[mt] = fexp2(mrun[mt] - mnew); mrun[mt] = mnew;
                float ls = 0.f;
#pragma unroll
                for (int nt = 0; nt < 4; ++nt)
#pragma unroll
                    for (int r = 0; r < 4; ++r) { const float p = fexp2(S[nt][r] - mnew); S[nt][r] = p; ls += p; }
                lrun[mt] = lrun[mt] * alpha[mt] + ls;
#pragma unroll
                for (int ks = 0; ks < 2; ++ks) { v4u pw; pw.x = pk2(S[2 * ks][0], S[2 * ks][1]); pw.y = pk2(S[2 * ks][2], S[2 * ks][3]); pw.z = pk2(S[2 * ks + 1][0], S[2 * ks + 1][1]); pw.w = pk2(S[2 * ks + 1][2], S[2 * ks + 1][3]);
                    Pf[mt][ks] = __builtin_bit_cast(pg8::bf16x8, pw); }
                if (mt == 1 && has) { LAS unsigned char* kd = lK + (buf ^ 1) * (64 * KP); LAS unsigned char* vd = lV + (buf ^ 1) * (64 * VP);
                    *(LAS v4u*)(kd + skey * KP + sdc * 16) = kr; *(LAS v4u*)(vd + skey * VP + sdc * 16) = vr; }
            }
#pragma unroll
            for (int dt = 0; dt < 4; ++dt) {
                pg8::bf16x8 Vf[2];
#pragma unroll
                for (int ks = 0; ks < 2; ++ks) {
                    const LAS unsigned char* p0 = vb + (32 * ks + 4 * g + (li >> 2)) * VP + (16 * dt + 4 * (li & 3)) * 2;
                    const s16x4 lo = lds_tr16(p0), hi = lds_tr16(p0 + 16 * VP);
                    Vf[ks] = (pg8::bf16x8){lo[0], lo[1], lo[2], lo[3], hi[0], hi[1], hi[2], hi[3]};
                }
#pragma unroll
                for (int mt = 0; mt < 4; ++mt) { O[dt][mt] = O[dt][mt] * alpha[mt];
#pragma unroll
                    for (int ks = 0; ks < 2; ++ks) O[dt][mt] = __builtin_amdgcn_mfma_f32_16x16x32_bf16(Vf[ks], Pf[mt][ks], O[dt][mt], 0, 0, 0); }
            }
        }
        if (skip && has) { LAS unsigned char* kd = lK + (buf ^ 1) * (64 * KP); LAS unsigned char* vd = lV + (buf ^ 1) * (64 * VP);
            *(LAS v4u*)(kd + skey * KP + sdc * 16) = kr; *(LAS v4u*)(vd + skey * VP + sdc * 16) = vr; }
        __syncthreads();
        if (!has) break;
        cur = nxt; buf ^= 1;
    }
#pragma unroll
    for (int mt = 0; mt < 4; ++mt) {
        float l = lrun[mt]; l += __shfl_xor(l, 16); l += __shfl_xor(l, 32); const float inv = 1.f / l;
        bf16* orow = MIX + (size_t)(qrow0 + 16 * mt + li) * DM + 512 + h * 64 + 4 * g;
#pragma unroll
        for (int dt = 0; dt < 4; ++dt) { v2u o; o.x = pk2(O[dt][mt][0] * inv, O[dt][mt][1] * inv); o.y = pk2(O[dt][mt][2] * inv, O[dt][mt][3] * inv); *(v2u*)(orow + 16 * dt) = o; }
    }
}
constexpr int SGP = 272;
__device__ __forceinline__ float red16(float v) { v += __shfl_xor(v, 1); v += __shfl_xor(v, 2); v += __shfl_xor(v, 4); v += __shfl_xor(v, 8); return v; }
__device__ __forceinline__ void sgu_unit(const Args& A, Frame& F, int chunk, int grp) {
    const bf16* G1 = (const bf16*)(A.ws + WS_G1); bf16* MIX = (bf16*)(A.ws + WS_MIX);
    const int lane = lane_id_asm(), tid = F.wave * 64 + lane, row0 = chunk * 128, w = F.wave, li = lane & 15, gq = lane >> 4;
    LAS unsigned char* vn = F.lds;
    { const int ck = tid & 15;
#pragma unroll
      for (int i = 0; i < 4; ++i) { const int row = (tid >> 4) + 32 * i;
        const v4u x = *(const v4u*)(G1 + (size_t)(row0 + row) * NIN_E + COL_V + grp * 128 + ck * 8);
        float f[8] = {bflo(x.x), bfhi(x.x), bflo(x.y), bfhi(x.y), bflo(x.z), bfhi(x.z), bflo(x.w), bfhi(x.w)};
        float s = ((f[0] + f[1]) + (f[2] + f[3])) + ((f[4] + f[5]) + (f[6] + f[7])); s = red16(s); const float mean = s * (1.f / 128.f);
        float ss = 0.f;
#pragma unroll
        for (int e = 0; e < 8; ++e) { f[e] -= mean; ss += f[e] * f[e]; }
        ss = red16(ss); const float rs = 1.f / sqrtf(ss * (1.f / 128.f) + EPS);
        v4u o; o.x = pk2(f[0] * rs, f[1] * rs); o.y = pk2(f[2] * rs, f[3] * rs); o.z = pk2(f[4] * rs, f[5] * rs); o.w = pk2(f[6] * rs, f[7] * rs);
        *(LAS v4u*)(vn + row * SGP + ck * 16) = o; } }
    __syncthreads();
    const bf16* Wb = (const bf16*)(A.ws + WS_SGW) + (size_t)(grp * 128 + 16 * w + li) * 128 + 8 * gq;
    pg8::bf16x8 Wf[4];
#pragma unroll
    for (int ks = 0; ks < 4; ++ks) Wf[ks] = *(const pg8::bf16x8*)(Wb + 32 * ks);
    pg8::f32x4 acc[8];
#pragma unroll
    for (int nt = 0; nt < 8; ++nt) acc[nt] = (pg8::f32x4){0.f, 0.f, 0.f, 0.f};
#pragma unroll
    for (int ks = 0; ks < 4; ++ks)
#pragma unroll
        for (int nt = 0; nt < 8; ++nt) {
            const LAS unsigned char* p0 = vn + (32 * ks + 8 * gq + (li >> 2)) * SGP + (16 * nt + 4 * (li & 3)) * 2;
            const s16x4 lo = lds_tr16(p0), hi = lds_tr16(p0 + 4 * SGP);
            const pg8::bf16x8 vf = (pg8::bf16x8){lo[0], lo[1], lo[2], lo[3], hi[0], hi[1], hi[2], hi[3]};
            acc[nt] = __builtin_amdgcn_mfma_f32_16x16x32_bf16(vf, Wf[ks], acc[nt], 0, 0, 0);
        }
    const float bias = A.in[10][grp * 128 + 16 * w + li];
    const size_t prow = (size_t)(row0 + 16 * w + li);
#pragma unroll
    for (int nt = 0; nt < 8; ++nt) {
        const v2u u = *(const v2u*)(G1 + prow * NIN_E + grp * 128 + 16 * nt + 4 * gq);
        v2u o; o.x = pk2(bflo(u.x) * (acc[nt][0] + bias), bfhi(u.x) * (acc[nt][1] + bias)); o.y = pk2(bflo(u.y) * (acc[nt][2] + bias), bfhi(u.y) * (acc[nt][3] + bias));
        *(v2u*)(MIX + prow * DM + grp * 128 + 16 * nt + 4 * gq) = o;
    }
    __syncthreads();
}
__device__ __forceinline__ void ph_mix(const Args& A, Frame& F) {
    constexpr int N_ATT = NB * (SEQ / 128) * 2, N_CATT = NB * (CTXL / 128) * 2, N_SGU = (MTOT / 128) * 4;
    for (int it = F.vcu; it < N_ATT + N_CATT + N_SGU; it += F.G) {
        if (it < N_ATT + N_CATT) {
            const bool cq = it >= N_ATT; const int j = cq ? it - N_ATT : it;
            const int b = cq ? (j >> 2) : (j >> 7), qb = cq ? ((j >> 1) & 1) : ((j >> 1) & 63), kvh = j & 1;
            attn_unit(A, F, b, kvh, qb, cq);
        } else { const int s = it - (N_ATT + N_CATT); sgu_unit(A, F, s >> 2, s & 3); }
    }
}


__global__ void __launch_bounds__(NTHR, 2) fwd_kernel(Args A) {
    extern __shared__ __attribute__((aligned(16))) unsigned char lds[];
    Frame F;
    F.lds = (LAS unsigned char*)lds; F.MISC = (volatile LAS unsigned*)(F.lds + MISC_OFF);
    F.wave = __builtin_amdgcn_readfirstlane((int)threadIdx.x >> 6);
    F.G = gridDim.x; { const int bx = blockIdx.x; F.vcu = (F.G % 8 == 0) ? (bx % 8) * (F.G / 8) + bx / 8 : bx; }
    unsigned char* ws = A.ws;
    F.ctl = (gu32*)(ws + WS_CTL);
    for (int u = threadIdx.x; u < (LDS_BYTES - LDSCTL_OFF) / 4; u += NTHR) ((LAS unsigned*)(F.lds + LDSCTL_OFF))[u] = 0u;
    __syncthreads();
    XcdBarrier bar; bar.bar = (unsigned*)(F.ctl + CW_BAR); bar.x = 0; bar.st = nullptr;
    if (MK_ONE_LAUNCH) bar = xcd_barrier_post((unsigned*)(F.ctl + CW_BAR), F.MISC + 8, threadIdx.x == 0);
    const int lo = A.ph_lo, hi = A.ph_hi;
#define IN(k) (lo <= (k) && (k) < hi)
    struct CvtFill { const Args* A; Frame* F; int k; __device__ __forceinline__ void operator()() const {
        if (F->wave != 0 && F->G == 256 && k < CVT_NFILL) { const int lane = lane_id_asm(); const int it = CVT_S7 + k * (256 * 7) + (int)blockIdx.x * 7 + (F->wave - 1);
            tr_run(MoeDesc{A}, (LAS float*)(F->lds + F->wave * 16384), lane, it, CVT_TOTAL, it < CVT_FILL_END ? it + 1 : it); } } };
#define SEAM(k) do { if (IN(k) && IN((k) + 1)) xcd_barrier_fill(bar, F.wave == 0 && lane_id_asm() == 0, CvtFill{&A, &F, (k)}); } while (0)
    const float* mod = (const float*)(ws + WS_MOD);
    bf16* Hb = (bf16*)(ws + WS_H); float* XC = (float*)(ws + WS_XC);

    if (IN(PH_PRO)) { ph_prologue(A, F); __syncthreads(); } SEAM(PH_PRO);
    if (IN(PH_NORM1E)) ph_norm(F, A.in[0], A.in[2], A.in[6], mod, 0, 1, Hb, MTOT, CtxFix{nullptr, 0, nullptr, nullptr, nullptr}); SEAM(PH_NORM1E);
    if (IN(PH_GIN_E)) {
        pg8::Gemm g{Hb, (const bf16*)(ws + WS_WINE), MTOT, NIN_E, DM, DM}; pg8::StaticOrder S; S.init(MTOT, NIN_E, F.G, (int)blockIdx.x);
        EpiInEven E{(bf16*)(ws + WS_G1), (const float*)(ws + WS_ROPE)};
        pg8::gemm_phase<EpiInEven, pg8::StaticOrder, true, true>(F.lds, g, S, E, F.wave);
        if ((int)blockIdx.x >= 206 && F.G == 256) convert_moe_range(A, F, 0, CVT_S1, 50, (int)blockIdx.x - 206);
    } SEAM(PH_GIN_E);
    if (IN(PH_MIX_E)) ph_mix(A, F); SEAM(PH_MIX_E);
    if (IN(PH_GOUT_E)) {
        { pg8::Gemm g{(const bf16*)(ws + WS_MIX), (const bf16*)(ws + WS_WOUTE), MLAT, DM, DM, DM}; pg8::StaticOrder S; S.init(MLAT, DM, F.G, (int)blockIdx.x);
          EpiResid E{A.in[0], A.in[2], A.out, XC, mod + 2 * 1024};
          pg8::gemm_phase<EpiResid, pg8::StaticOrder, true, true>(F.lds, g, S, E, F.wave); }
        { pg8::Gemm g{(const bf16*)(ws + WS_MIX), (const bf16*)(ws + WS_WOUTE), MTOT, DM, 256, DM}; CtxSplitOrder S{4, 512, F.G, (int)blockIdx.x};
          EpiPartial E{(float*)(ws + WS_PART), 512};
          pg8::gemm_phase<EpiPartial, CtxSplitOrder, true, true>(F.lds, g, S, E, F.wave); }
        if ((int)blockIdx.x >= 32 && F.G == 256) convert_moe_range(A, F, CVT_S5, CVT_S6, 224, (int)blockIdx.x - 32);
    } SEAM(PH_GOUT_E);
    if (IN(PH_NORM2E)) ph_norm(F, A.out, XC, A.in[7], mod, 3, 4, Hb, MTOT, CtxFix{(const float*)(ws + WS_PART), 4, mod + 2 * 6144 + 2 * 1024, A.in[2], XC}); SEAM(PH_NORM2E);
    if (IN(PH_FFN_UP)) {
        pg8::Gemm g{Hb, (const bf16*)(ws + WS_FFN13), MTOT, NFF2, DM, DM}; pg8::StaticOrder S; S.init(MTOT, NFF2, F.G, (int)blockIdx.x);
        EpiSwiGLU E{(bf16*)(ws + WS_FH), NFF2 / 256};
        pg8::gemm_phase<EpiSwiGLU, pg8::StaticOrder, true, true>(F.lds, g, S, E, F.wave);
        if ((int)blockIdx.x >= 172 && F.G == 256) convert_moe_range(A, F, CVT_S1, CVT_S2, 84, (int)blockIdx.x - 172);
    } SEAM(PH_FFN_UP);
    if (IN(PH_FFN_DN)) {
        { pg8::Gemm g{(const bf16*)(ws + WS_FH), (const bf16*)(ws + WS_FFN2), MLAT, DM, DFF, DFF}; pg8::StaticOrder S; S.init(MLAT, DM, F.G, (int)blockIdx.x);
          EpiResid E{A.out, XC, A.out, XC, mod + 5 * 1024};
          pg8::gemm_phase<EpiResid, pg8::StaticOrder, true, true>(F.lds, g, S, E, F.wave); }
        { pg8::Gemm g{(const bf16*)(ws + WS_FH), (const bf16*)(ws + WS_FFN2), MTOT, DM, 256, DFF}; CtxSplitOrder S{11, 512, F.G, (int)blockIdx.x};
          EpiPartial E{(float*)(ws + WS_PART), 512};
          pg8::gemm_phase<EpiPartial, CtxSplitOrder, true, true>(F.lds, g, S, E, F.wave); }
        if ((int)blockIdx.x >= 88 && F.G == 256) convert_moe_range(A, F, CVT_S6, CVT_S7, 168, (int)blockIdx.x - 88);
    } SEAM(PH_FFN_DN);
    if (IN(PH_NORM1O)) ph_norm(F, A.out, XC, A.in[18], mod + 3 * 6144, 0, 1, Hb, MTOT, CtxFix{(const float*)(ws + WS_PART), 11, mod + 2 * 6144 + 5 * 1024, XC, XC}); SEAM(PH_NORM1O);
    if (IN(PH_GIN_O)) {
        pg8::Gemm g{Hb, (const bf16*)(ws + WS_WINO), MTOT, NIN_O, DM, DM}; pg8::StaticOrder S; S.init(MTOT, NIN_O, F.G, (int)blockIdx.x);
        EpiStore E{(bf16*)(ws + WS_G2), NIN_O, NIN_O / 256, 5};
        pg8::gemm_phase<EpiStore, pg8::StaticOrder, true, true>(F.lds, g, S, E, F.wave);
        if ((int)blockIdx.x >= 138 && F.G == 256) convert_moe_range(A, F, CVT_S2, CVT_S3, 118, (int)blockIdx.x - 138);
    } SEAM(PH_GIN_O);
    if (IN(PH_LRU_G)) { ph_lru<false>(A, F); if ((int)blockIdx.x >= 148 && F.G == 256) convert_moe_range(A, F, CVT_S3, CVT_S4, 108, (int)blockIdx.x - 148); } SEAM(PH_LRU_G);
    if (IN(PH_LRU_S)) { ph_lru<true>(A, F); if ((int)blockIdx.x >= 128 && F.G == 256) convert_moe_range(A, F, CVT_S4, CVT_S5, 128, (int)blockIdx.x - 128); } SEAM(PH_LRU_S);
    if (IN(PH_GOUT_O)) {
        pg8::Gemm g{(const bf16*)(ws + WS_Y1), (const bf16*)(ws + WS_WOUTO), MLAT, DM, DRNN, DRNN}; pg8::StaticOrder S; S.init(MLAT, DM, F.G, (int)blockIdx.x);
        EpiResid E{A.out, XC, A.out, XC, mod + 3 * 6144 + 2 * 1024};
        pg8::gemm_phase<EpiResid, pg8::StaticOrder, true, true>(F.lds, g, S, E, F.wave);
    } SEAM(PH_GOUT_O);
    if (IN(PH_ROUTE)) { ph_route(A, F); if (F.G == 256) convert_moe_range(A, F, CVT_FILL_END, CVT_TOTAL, F.G, F.vcu); else convert_moe_range(A, F, 0, CVT_TOTAL, F.G, F.vcu); } SEAM(PH_ROUTE);
    if (IN(PH_PERM)) ph_permute(A, F); SEAM(PH_PERM);
    if (IN(PH_MOE_UP)) {
        const int* meta = (const int*)(ws + WS_META); const int nt = __builtin_amdgcn_readfirstlane(ld_i32_agent(meta + 256));
        pg8::Gemm g{(const bf16*)(ws + WS_HP), (const bf16*)(ws + WS_MOE13), MOE_ROWS, NFF2, DM, DM}; MoeOrder S{meta, nt, NFF2 / 256, F.G, (int)blockIdx.x};
        EpiSwiGLU E{(bf16*)(ws + WS_MH), NFF2 / 256};
        pg8::gemm_phase<EpiSwiGLU, MoeOrder, true, true>(F.lds, g, S, E, F.wave);
    } SEAM(PH_MOE_UP);
    if (IN(PH_MOE_DN)) {
        const int* meta = (const int*)(ws + WS_META); const int nt = __builtin_amdgcn_readfirstlane(ld_i32_agent(meta + 256));
        { pg8::Gemm g{(const bf16*)(ws + WS_MH), (const bf16*)(ws + WS_MOE2), MOE_ROWS, DM, DFF, DFF}; MoeOrder S{meta, nt < 128 ? nt : 128, DM / 256, F.G, (int)blockIdx.x};
          EpiStore E{(bf16*)(ws + WS_YD), DM, DM / 256, 0};
          pg8::gemm_phase<EpiStore, MoeOrder, true, true>(F.lds, g, S, E, F.wave); }
        { pg8::Gemm g{(const bf16*)(ws + WS_MH), (const bf16*)(ws + WS_MOE2), MOE_ROWS, DM, 256, DFF}; MoeTailOrder S{meta, nt > 128 ? nt - 128 : 0, F.G, (int)blockIdx.x};
          EpiPartialBf16 E{(bf16*)(ws + WS_PARTM)};
          pg8::gemm_phase<EpiPartialBf16, MoeTailOrder, true, true>(F.lds, g, S, E, F.wave); }
    } SEAM(PH_MOE_DN);
    if (IN(PH_COMB)) ph_combine(A, F, A.out);
#undef IN
#undef SEAM
}

extern "C" void kernel_launch(void* const* d_in, const int* in_sizes, int n_in, void* d_out, int out_size, void* d_ws, size_t ws_size, hipStream_t stream) {
    static int grid = 0;
    if (grid == 0) {
        if (n_in != 34 || in_sizes[0] != MLAT * DM || out_size != MLAT * DM || ws_size < WS_NEED) { fprintf(stderr, "kernel_launch: unexpected shapes (n_in %d, out %d, ws %zu)\n", n_in, out_size, ws_size); grid = -1; return; }
        int dev = 0, cus = 0, per_cu = 0;
        if (hipGetDevice(&dev) != hipSuccess || hipDeviceGetAttribute(&cus, hipDeviceAttributeMultiprocessorCount, dev) != hipSuccess) { grid = -1; return; }
        if (hipFuncSetAttribute((const void*)fwd_kernel, hipFuncAttributeMaxDynamicSharedMemorySize, LDS_BYTES) != hipSuccess) { grid = -1; return; }
        if (hipOccupancyMaxActiveBlocksPerMultiprocessor(&per_cu, (const void*)fwd_kernel, NTHR, LDS_BYTES) != hipSuccess || per_cu < 1) { fprintf(stderr, "kernel_launch: occupancy query says %d\n", per_cu); }
        (void)hipGetLastError();
        grid = cus;
    }
    if (grid < 0) return;
    (void)hipMemsetAsync((char*)d_ws + WS_CTL, 0, CTL_ZERO_BYTES, stream);
    Args a{};
    for (int i = 0; i < 34; ++i) a.in[i] = (const float*)d_in[i];
    a.out = (float*)d_out; a.ws = (unsigned char*)d_ws;
#if MK_ONE_LAUNCH
    a.ph_lo = 0; a.ph_hi = NPH;
    hipLaunchKernelGGL(fwd_kernel, dim3(grid), dim3(NTHR), LDS_BYTES, stream, a);
#else
    for (int p = 0; p < NPH; ++p) { a.ph_lo = p; a.ph_hi = p + 1; hipLaunchKernelGGL(fwd_kernel, dim3(grid), dim3(NTHR), LDS_BYTES, stream, a); }
#endif
}
```

```cpp
#include <hip/hip_runtime.h>
#include <cstdio>
#include <cstdint>
namespace pg8 {
#define PG8_LAS __attribute__((address_space(3)))
typedef unsigned short bf16_t;
typedef short bf16x8 __attribute__((ext_vector_type(8)));
typedef float f32x4 __attribute__((ext_vector_type(4)));
typedef unsigned u32x4 __attribute__((ext_vector_type(4)));
constexpr int BM = 256, BK = 64, HALF = 128, HTB = HALF * BK * 2  , STAGE_BYTES = 8 * HTB, NXCD = 8, WGM = 8;

__host__ __device__ __forceinline__ int lds_byte(int r, int c) { const int st = (r >> 4) * 2 + (c >> 5), rr = r & 15, cc = c & 31, ob = rr * 64 + cc * 2; return st * 1024 + (ob ^ (((ob >> 9) & 1) << 5)); }
__host__ __device__ __forceinline__ void stage_rc(int b, int& R, int& C) { const int st = b / 1024, sb = b % 1024, swz = sb ^ (((sb >> 9) & 1) << 5); R = (st >> 1) * 16 + swz / 64; C = (st & 1) * 32 + (swz % 64) / 2; }
__host__ __device__ __forceinline__ int perm32(int rho) { const int n = rho >> 4, i = rho & 15; return 8 * (i >> 2) + 4 * n + (i & 3); }

struct Unit { int pm, pn, kb; };
struct Gemm { const bf16_t* A; const bf16_t* Bt; int M, N, K, ld; };

struct StaticOrder {
    int nM, nN, nwg, G, c;
    __host__ __device__ void init(int M, int N, int G_, int c_) { nM = M / BM; nN = N / BM; nwg = nM * nN; G = G_; c = c_; }
    __host__ __device__ bool next(int i, Unit& u) const {
        const long L = (long)i * G + c; if (L >= nwg) return false;
        int wgid = (int)L; { const int q = nwg / NXCD, r = nwg % NXCD, xcd = wgid % NXCD, off = wgid / NXCD; wgid = (xcd < r ? xcd * (q + 1) : r * (q + 1) + (xcd - r) * q) + off; }
        const int nig = WGM * nN, gid = wgid / nig, fm = gid * WGM, gsz = (nM - fm) < WGM ? (nM - fm) : WGM;
        u.pm = fm + ((wgid % nig) % gsz); u.pn = (wgid % nig) / gsz; u.kb = 0; return true;
    }
    __device__ __forceinline__ void a_ready(const Unit&) const {}
    __device__ __forceinline__ void done(const Unit&) const {}
};

__device__ __forceinline__ unsigned cvt_pk_bf16(float lo, float hi) { unsigned r; asm volatile("v_cvt_pk_bf16_f32 %0, %1, %2" : "=v"(r) : "v"(lo), "v"(hi)); return r; }
typedef float f32x2 __attribute__((ext_vector_type(2)));
template <class Epi, class Sched, bool ALIGN_EPI = false, bool SP2 = false>
__device__ __forceinline__ void gemm_phase(PG8_LAS unsigned char* lds, const Gemm g, const Sched& S, const Epi& E, const int wid) {
    int lane_; asm volatile("v_mbcnt_lo_u32_b32 %0, -1, 0\n\tv_mbcnt_hi_u32_b32 %0, -1, %0" : "=v"(lane_));
    const int lane = lane_, tid = wid * 64 + lane, wr = wid >> 2, wc = wid & 3, fr = lane & 15, fq = lane >> 4;
    const int K = g.ld, nt = g.K / BK;
    unsigned voffA[2], voffB[2];
#pragma unroll
    for (int i = 0; i < 2; ++i) { int R, C; stage_rc(tid * 16 + i * 8192, R, C); const int Rb = Epi::PERM ? ((R & ~31) + perm32(R & 31)) : R;
        voffA[i] = (unsigned)(R * K + C) * 2u; voffB[i] = (unsigned)(Rb * K + C) * 2u; }
    const size_t kstep = (size_t)(BK * 2);
    const size_t hstep = (size_t)HALF * K * 2;
    const size_t tstep = 2 * hstep;
    const unsigned ldsw = (unsigned)wid * 1024u;
    const int aoff = lds_byte(wr * 64 + fr, fq * 8), boff = lds_byte(wc * 32 + fr, fq * 8);
#define PG8_SA(b, h) (((b) * 2 + (h)) * HTB)
#define PG8_SB(b, h) ((4 + (b) * 2 + (h)) * HTB)
#define PG8_STAGE(bufoff, gbase, voff) do { _Pragma("unroll") for (int _i = 0; _i < 2; ++_i) \
        __builtin_amdgcn_global_load_lds((const unsigned*)((const char*)(gbase) + (voff)[_i]), (PG8_LAS unsigned*)(lds + (bufoff) + ldsw + _i * 8192), 16, 0, 0); } while (0)
#define PG8_LDA(dst, b, h) do { _Pragma("unroll") for (int m = 0; m < 4; ++m) _Pragma("unroll") for (int k = 0; k < 2; ++k) dst[m][k] = *(const PG8_LAS bf16x8*)(lds + PG8_SA(b, h) + aoff + m * 2048 + k * 1024); } while (0)
#define PG8_LDB(dst, b, h) do { _Pragma("unroll") for (int n = 0; n < 2; ++n) _Pragma("unroll") for (int k = 0; k < 2; ++k) dst[n][k] = *(const PG8_LAS bf16x8*)(lds + PG8_SB(b, h) + boff + n * 2048 + k * 1024); } while (0)
#define PG8_MMA(ai, bj, At, Bt) do { __builtin_amdgcn_s_setprio(1); _Pragma("unroll") for (int m = 0; m < 4; ++m) _Pragma("unroll") for (int n = 0; n < 2; ++n) _Pragma("unroll") for (int k = 0; k < 2; ++k) \
        acc[ai][bj][m][n] = __builtin_amdgcn_mfma_f32_16x16x32_bf16(Bt[n][k], At[m][k], acc[ai][bj][m][n], 0, 0, 0); __builtin_amdgcn_s_setprio(0); } while (0)
#define PG8_WAIT_V(n) asm volatile("s_waitcnt vmcnt(" #n ")" ::: "memory")
#define PG8_WAIT_L(n) asm volatile("s_waitcnt lgkmcnt(" #n ")" ::: "memory")
#define PG8_BAR __builtin_amdgcn_s_barrier()
#define PG8_SCHED __builtin_amdgcn_sched_barrier(0)
    Unit cur, nxt; int ui = 0;
    if (!S.next(0, cur)) return;
    f32x4 acc[2][2][4][2];
#pragma unroll
    for (int a = 0; a < 2; ++a)
#pragma unroll
        for (int b = 0; b < 2; ++b)
#pragma unroll
            for (int m = 0; m < 4; ++m)
#pragma unroll
                for (int n = 0; n < 2; ++n) acc[a][b][m][n] = (f32x4){0.f, 0.f, 0.f, 0.f};
    bf16x8 At[4][2], B0[2][2], B1[2][2];
    const char* cA = (const char*)g.A + (size_t)cur.pm * tstep + cur.kb; const char* cB = (const char*)g.Bt + (size_t)cur.pn * tstep + cur.kb;
    S.a_ready(cur);
    if constexpr (SP2) {
        PG8_STAGE(PG8_SB(0, 0), cB, voffB); PG8_STAGE(PG8_SB(0, 1), cB + hstep, voffB); PG8_STAGE(PG8_SA(0, 0), cA, voffA); PG8_STAGE(PG8_SA(0, 1), cA + hstep, voffA);
        if (wr == 1) PG8_BAR;
        PG8_WAIT_V(2); PG8_BAR;
        PG8_STAGE(PG8_SB(1, 0), cB + kstep, voffB); PG8_STAGE(PG8_SA(1, 0), cA + kstep, voffA); PG8_STAGE(PG8_SB(1, 1), cB + hstep + kstep, voffB);
        PG8_WAIT_V(6); PG8_BAR;
    } else {
        PG8_STAGE(PG8_SB(0, 0), cB, voffB); PG8_STAGE(PG8_SA(0, 0), cA, voffA); PG8_STAGE(PG8_SB(0, 1), cB + hstep, voffB); PG8_STAGE(PG8_SA(0, 1), cA + hstep, voffA);
        if (wr == 1) PG8_BAR;
        PG8_WAIT_V(4); PG8_BAR;
        PG8_STAGE(PG8_SB(1, 0), cB + kstep, voffB); PG8_STAGE(PG8_SA(1, 0), cA + kstep, voffA); PG8_STAGE(PG8_SB(1, 1), cB + hstep + kstep, voffB);
        PG8_WAIT_V(6); PG8_BAR;
    }
    for (;;) {
        const bool has_next = S.next(ui + 1, nxt);
        const char* nA = has_next ? (const char*)g.A + (size_t)nxt.pm * tstep + nxt.kb : cA; const char* nB = has_next ? (const char*)g.Bt + (size_t)nxt.pn * tstep + nxt.kb : cB;
        for (int t = 0; t < nt; t += 2) {
            const bool last = (t == nt - 2);
            const char* a1 = cA + (size_t)(t + 1) * kstep;
            const char* a2 = last ? nA : cA + (size_t)(t + 2) * kstep; const char* b2 = last ? nB : cB + (size_t)(t + 2) * kstep;
            const char* a3 = a2 + kstep; const char* b3 = b2 + kstep;
            if (last && has_next) S.a_ready(nxt);
            if constexpr (SP2) {
            PG8_LDB(B0, 0, 0); PG8_LDB(B1, 0, 1); PG8_SCHED; PG8_LDA(At, 0, 0); PG8_STAGE(PG8_SA(1, 1), a1 + hstep, voffA);
            PG8_WAIT_V(8); PG8_WAIT_L(0); PG8_BAR; PG8_MMA(0, 0, At, B0); PG8_MMA(0, 1, At, B1); PG8_BAR; PG8_SCHED;
            PG8_LDA(At, 0, 1); PG8_STAGE(PG8_SB(0, 0), b2, voffB); PG8_STAGE(PG8_SB(0, 1), b2 + hstep, voffB); PG8_STAGE(PG8_SA(0, 0), a2, voffA);
            PG8_WAIT_V(8); PG8_WAIT_L(0); PG8_BAR; PG8_MMA(1, 0, At, B0); PG8_MMA(1, 1, At, B1); PG8_BAR; PG8_SCHED;
            PG8_LDB(B0, 1, 0); PG8_LDB(B1, 1, 1); PG8_SCHED; PG8_LDA(At, 1, 0); PG8_STAGE(PG8_SA(0, 1), a2 + hstep, voffA);
            PG8_WAIT_V(8); PG8_WAIT_L(0); PG8_BAR; PG8_MMA(0, 0, At, B0); PG8_MMA(0, 1, At, B1); PG8_BAR; PG8_SCHED;
            PG8_LDA(At, 1, 1); PG8_STAGE(PG8_SB(1, 0), b3, voffB); PG8_STAGE(PG8_SB(1, 1), b3 + hstep, voffB); PG8_STAGE(PG8_SA(1, 0), a3, voffA);
            PG8_WAIT_V(8); PG8_WAIT_L(0); PG8_BAR; PG8_MMA(1, 0, At, B0); PG8_MMA(1, 1, At, B1); PG8_BAR; PG8_SCHED;
            } else {
            PG8_LDB(B0, 0, 0); PG8_SCHED; PG8_LDA(At, 0, 0); PG8_STAGE(PG8_SA(1, 1), a1 + hstep, voffA);
            PG8_WAIT_L(8); PG8_BAR; PG8_WAIT_L(0); PG8_MMA(0, 0, At, B0); PG8_BAR; PG8_SCHED;
            PG8_LDB(B1, 0, 1); PG8_STAGE(PG8_SB(0, 0), b2, voffB);
            PG8_BAR; PG8_WAIT_L(0); PG8_MMA(0, 1, At, B1); PG8_BAR;
            PG8_LDA(At, 0, 1); PG8_STAGE(PG8_SA(0, 0), a2, voffA);
            PG8_BAR; PG8_WAIT_L(0); PG8_MMA(1, 0, At, B0); PG8_BAR; PG8_SCHED;
            PG8_STAGE(PG8_SB(0, 1), b2 + hstep, voffB);
            PG8_WAIT_V(6); PG8_BAR; PG8_MMA(1, 1, At, B1); PG8_BAR;
            PG8_LDB(B0, 1, 0); PG8_SCHED; PG8_LDA(At, 1, 0); PG8_STAGE(PG8_SA(0, 1), a2 + hstep, voffA);
            PG8_WAIT_L(8); PG8_BAR; PG8_WAIT_L(0); PG8_MMA(0, 0, At, B0); PG8_BAR; PG8_SCHED;
            PG8_LDB(B1, 1, 1); PG8_STAGE(PG8_SB(1, 0), b3, voffB);
            PG8_BAR; PG8_WAIT_L(0); PG8_MMA(0, 1, At, B1); PG8_BAR;
            PG8_LDA(At, 1, 1); PG8_STAGE(PG8_SA(1, 0), a3, voffA);
            PG8_BAR; PG8_WAIT_L(0); PG8_MMA(1, 0, At, B0); PG8_BAR; PG8_SCHED;
            PG8_STAGE(PG8_SB(1, 1), b3 + hstep, voffB);
            PG8_WAIT_V(6); PG8_BAR; PG8_MMA(1, 1, At, B1); PG8_BAR;
            }
        }
        if constexpr (ALIGN_EPI) { if (wr == 0) PG8_BAR; }
        if constexpr (!Epi::AFTER_DRAIN) { E(acc, cur, wr, wc, fr, fq); S.done(cur); }
        if (!has_next) break;
#pragma unroll
        for (int a = 0; a < 2; ++a)
#pragma unroll
            for (int b = 0; b < 2; ++b)
#pragma unroll
                for (int m = 0; m < 4; ++m)
#pragma unroll
                    for (int n = 0; n < 2; ++n) acc[a][b][m][n] = (f32x4){0.f, 0.f, 0.f, 0.f};
        cur = nxt; cA = nA; cB = nB; ++ui;
        if constexpr (ALIGN_EPI) { if (wr == 1) PG8_BAR; }
    }
    PG8_WAIT_V(0);
    if constexpr (!ALIGN_EPI) { if (wr == 0) PG8_BAR; }
    PG8_BAR;
    if constexpr (Epi::AFTER_DRAIN) { E.fused(acc, cur, wr, wc, fr, fq, lds, wid, lane); S.done(cur); }
#undef PG8_SA
#undef PG8_SB
#undef PG8_STAGE
#undef PG8_LDA
#undef PG8_LDB
#undef PG8_MMA
#undef PG8_WAIT_V
#undef PG8_WAIT_L
#undef PG8_BAR
#undef PG8_SCHED
}
}

constexpr int DM = 1024, NB = 2, SEQ = 8192, CTXL = 256;
constexpr int MLAT = NB * SEQ, MCTX = NB * CTXL, MTOT = MLAT + MCTX;
constexpr int NIN_E = 1792, NIN_O = 2560, DRNN = 1280, DFF = 2816, NEXP = 8, NFF2 = 2 * DFF;
constexpr int COL_V = 512, COL_Q = 1024, COL_K = 1536, COL_VAL = 1664;
constexpr float EPS = 1e-6f, LOG2E = 1.4426950408889634f, QSCALE = 0.125f * LOG2E;
constexpr int MOE_MAXT = 136;
constexpr int MOE_ROWS = MOE_MAXT * 256;

typedef unsigned short bf16;
typedef unsigned v4u __attribute__((ext_vector_type(4)));
typedef unsigned v2u __attribute__((ext_vector_type(2)));
typedef float f32x4 __attribute__((ext_vector_type(4)));
typedef float f32x2 __attribute__((ext_vector_type(2)));
#define GAS __attribute__((address_space(1)))
#define LAS __attribute__((address_space(3)))
typedef GAS unsigned gu32;
#define RLX_AGENT __ATOMIC_RELAXED, __HIP_MEMORY_SCOPE_AGENT
#define LDS_WAIT() asm volatile("s_waitcnt lgkmcnt(0)" ::: "memory")
#define VM_WAIT() asm volatile("s_waitcnt vmcnt(0)" ::: "memory")

__device__ __forceinline__ float bf2f(unsigned short u) { return __builtin_bit_cast(float, (unsigned)u << 16); }
__device__ __forceinline__ float bflo(unsigned u) { return __builtin_bit_cast(float, u << 16); }
__device__ __forceinline__ float bfhi(unsigned u) { return __builtin_bit_cast(float, u & 0xffff0000u); }
__device__ __forceinline__ unsigned pk2(float lo, float hi) { return pg8::cvt_pk_bf16(lo, hi); }
__device__ __forceinline__ unsigned short f2bf1(float x) { return (unsigned short)(pg8::cvt_pk_bf16(x, 0.f) & 0xffffu); }
__device__ __forceinline__ float fexp2(float x) { return __builtin_amdgcn_exp2f(x); }
__device__ __forceinline__ float frcp(float x) { return __builtin_amdgcn_rcpf(x); }
__device__ __forceinline__ float sigmoid_f(float x) { return frcp(1.f + fexp2(-LOG2E * x)); }
__device__ __forceinline__ float silu_f(float x) { return x * sigmoid_f(x); }
__device__ __forceinline__ float gelu_f(float x) { const float u = x * (1.f + 0.044715f * x * x); return x * frcp(1.f + fexp2((-2.f * 0.7978845608028654f * LOG2E) * u)); }
__device__ __forceinline__ f32x4 gelu4(f32x4 v) { return (f32x4){gelu_f(v[0]), gelu_f(v[1]), gelu_f(v[2]), gelu_f(v[3])}; }
__device__ __forceinline__ int ld_i32_agent(const int* p) { return __hip_atomic_load(p, RLX_AGENT); }
__device__ __forceinline__ float wave_sum(float v) {
#pragma unroll
    for (int o = 1; o < 64; o <<= 1) v += __shfl_xor(v, o);
    return v;
}
__device__ __forceinline__ float wave_max(float v) {
#pragma unroll
    for (int o = 1; o < 64; o <<= 1) v = fmaxf(v, __shfl_xor(v, o));
    return v;
}
__device__ __forceinline__ int lane_id_asm() { int l; asm volatile("v_mbcnt_lo_u32_b32 %0, -1, 0\n\tv_mbcnt_hi_u32_b32 %0, -1, %0" : "=v"(l)); return l; }
#define FRESH_TID() (F.wave * 64 + lane_id_asm())
__device__ __forceinline__ void st16_wt(void* p, v4u w) { asm volatile("global_store_dwordx4 %0, %1, off sc1\n\ts_nop 1" :: "v"(p), "v"(w) : "memory"); }
__device__ __forceinline__ int mod_of_tile(int pm) { return pm < 32 ? 0 : (pm < 64 ? 1 : 2); }
__device__ __forceinline__ int mod_of_row(int r) { return r < SEQ ? 0 : (r < MLAT ? 1 : 2); }

struct EpiInEven {
    static constexpr bool PERM = true, AFTER_DRAIN = false;
    bf16* G1; const float* rope;
    __device__ __forceinline__ void operator()(const pg8::f32x4 (&acc)[2][2][4][2], const pg8::Unit& u, int wr, int wc, int fr_, int fq_) const {
        (void)fr_; (void)fq_; const int lane_e = lane_id_asm(), fr = lane_e & 15, fq = lane_e >> 4;
        const int pn = u.pn; const bool lat = u.pm < 64;
#pragma unroll
        for (int ai = 0; ai < 2; ++ai)
#pragma unroll
            for (int m = 0; m < 4; ++m) {
                const int row = u.pm * 256 + ai * 128 + wr * 64 + m * 16 + fr;
                bf16* rowp = G1 + (size_t)row * NIN_E + pn * 256 + wc * 32 + 8 * fq;
                const int t = row & (SEQ - 1);
#pragma unroll
                for (int bj = 0; bj < 2; ++bj) {
                    f32x4 v0 = acc[ai][bj][m][0], v1 = acc[ai][bj][m][1];
                    if (pn < 4) { v0 = gelu4(v0); v1 = gelu4(v1); }
                    else if (pn < 6 || bj == 0) {
                        if (lat) {
                            const int pos = (wc & 1) ? (t & 63) : (t >> 6);
                            const f32x4* tp = (const f32x4*)(rope + (pos * 16 + 4 * fq) * 2);
                            const f32x4 c0 = tp[0], c1 = tp[1];
                            f32x4 w0, w1;
                            w0[0] = v0[0] * c0[0] - v0[1] * c0[1]; w0[1] = v0[1] * c0[0] + v0[0] * c0[1];
                            w0[2] = v0[2] * c0[2] - v0[3] * c0[3]; w0[3] = v0[3] * c0[2] + v0[2] * c0[3];
                            w1[0] = v1[0] * c1[0] - v1[1] * c1[1]; w1[1] = v1[1] * c1[0] + v1[0] * c1[1];
                            w1[2] = v1[2] * c1[2] - v1[3] * c1[3]; w1[3] = v1[3] * c1[2] + v1[2] * c1[3];
                            v0 = w0; v1 = w1;
                        }
                        if (pn < 6) { v0 = v0 * QSCALE; v1 = v1 * QSCALE; }
                    }
                    v4u w; w.x = pk2(v0[0], v0[1]); w.y = pk2(v0[2], v0[3]); w.z = pk2(v1[0], v1[1]); w.w = pk2(v1[2], v1[3]);
                    *(v4u*)(rowp + bj * 128) = w;
                }
            }
    }
};
struct EpiResid {
    static constexpr bool PERM = true, AFTER_DRAIN = false;
    const float* rin_lat; const float* rin_ctx; float* out_lat; float* out_ctx; const float* gate;
    __device__ __forceinline__ void operator()(const pg8::f32x4 (&acc)[2][2][4][2], const pg8::Unit& u, int wr, int wc, int fr_, int fq_) const {
        (void)fr_; (void)fq_; const int lane_e = lane_id_asm(), fr = lane_e & 15, fq = lane_e >> 4;
        const bool lat = u.pm < 64; const float* g = gate + mod_of_tile(u.pm) * 6144;
        const float* rb = lat ? rin_lat : rin_ctx - (size_t)MLAT * DM; float* ob = lat ? out_lat : out_ctx - (size_t)MLAT * DM;
        const int col0 = u.pn * 256 + wc * 32 + 8 * fq;
        f32x4 gv[2][2];
#pragma unroll
        for (int bj = 0; bj < 2; ++bj)
#pragma unroll
            for (int n = 0; n < 2; ++n) gv[bj][n] = *(const f32x4*)(g + col0 + bj * 128 + 4 * n);
#pragma unroll
        for (int ai = 0; ai < 2; ++ai)
#pragma unroll
            for (int m = 0; m < 4; ++m) {
                const size_t p = (size_t)(u.pm * 256 + ai * 128 + wr * 64 + m * 16 + fr) * DM + col0;
#pragma unroll
                for (int bj = 0; bj < 2; ++bj) {
                    const f32x4 r0 = *(const f32x4*)(rb + p + bj * 128), r1 = *(const f32x4*)(rb + p + bj * 128 + 4);
                    *(f32x4*)(ob + p + bj * 128) = r0 + gv[bj][0] * acc[ai][bj][m][0];
                    *(f32x4*)(ob + p + bj * 128 + 4) = r1 + gv[bj][1] * acc[ai][bj][m][1];
                }
            }
    }
};
struct EpiSwiGLU {
    static constexpr bool PERM = true, AFTER_DRAIN = false;
    bf16* H; int nN;
    __device__ __forceinline__ void operator()(const pg8::f32x4 (&acc)[2][2][4][2], const pg8::Unit& u, int wr, int wc, int fr_, int fq_) const {
        (void)fr_; (void)fq_; const int lane_e = lane_id_asm(), fr = lane_e & 15, fq = lane_e >> 4;
        const int pnl = u.pn % nN, col0 = pnl * 128 + wc * 32 + 8 * fq;
#pragma unroll
        for (int ai = 0; ai < 2; ++ai)
#pragma unroll
            for (int m = 0; m < 4; ++m) {
                const size_t row = (size_t)(u.pm * 256 + ai * 128 + wr * 64 + m * 16 + fr);
                const f32x4 a0 = acc[ai][0][m][0], a1 = acc[ai][0][m][1], b0 = acc[ai][1][m][0], b1 = acc[ai][1][m][1];
                v4u w;
                w.x = pk2(silu_f(a0[0]) * b0[0], silu_f(a0[1]) * b0[1]); w.y = pk2(silu_f(a0[2]) * b0[2], silu_f(a0[3]) * b0[3]);
                w.z = pk2(silu_f(a1[0]) * b1[0], silu_f(a1[1]) * b1[1]); w.w = pk2(silu_f(a1[2]) * b1[2], silu_f(a1[3]) * b1[3]);
                *(v4u*)(H + row * DFF + col0) = w;
            }
    }
};
struct EpiStore {
    static constexpr bool PERM = true, AFTER_DRAIN = false;
    bf16* O; int ldc; int nN; int ngelu;
    __device__ __forceinline__ void operator()(const pg8::f32x4 (&acc)[2][2][4][2], const pg8::Unit& u, int wr, int wc, int fr_, int fq_) const {
        (void)fr_; (void)fq_; const int lane_e = lane_id_asm(), fr = lane_e & 15, fq = lane_e >> 4;
        const int pnl = u.pn % nN, col0 = pnl * 256 + wc * 32 + 8 * fq; const bool g = pnl < ngelu;
#pragma unroll
        for (int ai = 0; ai < 2; ++ai)
#pragma unroll
            for (int m = 0; m < 4; ++m) {
                bf16* rowp = O + (size_t)(u.pm * 256 + ai * 128 + wr * 64 + m * 16 + fr) * ldc + col0;
#pragma unroll
                for (int bj = 0; bj < 2; ++bj) {
                    f32x4 v0 = acc[ai][bj][m][0], v1 = acc[ai][bj][m][1];
                    if (g) { v0 = gelu4(v0); v1 = gelu4(v1); }
                    v4u w; w.x = pk2(v0[0], v0[1]); w.y = pk2(v0[2], v0[3]); w.z = pk2(v1[0], v1[1]); w.w = pk2(v1[2], v1[3]);
                    *(v4u*)(rowp + bj * 128) = w;
                }
            }
    }
};
struct MoeOrder {
    const int* tile_e; int ntiles, nN, G, c;
    __device__ __forceinline__ bool next(int i, pg8::Unit& u) const {
        pg8::StaticOrder S; S.init(ntiles * 256, nN * 256, G, c);
        if (!S.next(i, u)) return false;
        u.pn += __builtin_amdgcn_readfirstlane(ld_i32_agent(tile_e + u.pm)) * nN; return true;
    }
    __device__ __forceinline__ void a_ready(const pg8::Unit&) const {}
    __device__ __forceinline__ void done(const pg8::Unit&) const {}
};

struct CtxSplitOrder {
    int nsplit, klen_bytes, G, c;
    __device__ __forceinline__ bool next(int i, pg8::Unit& u) const {
        const int L = i * G + c; if (L >= 8 * nsplit) return false;
        const int tile = L / nsplit, kp = L % nsplit; u.pm = 64 + (tile >> 2); u.pn = tile & 3; u.kb = kp * klen_bytes; return true;
    }
    __device__ __forceinline__ void a_ready(const pg8::Unit&) const {}
    __device__ __forceinline__ void done(const pg8::Unit&) const {}
};
struct EpiPartial {
    static constexpr bool PERM = true, AFTER_DRAIN = false;
    float* part; int klen_bytes;
    __device__ __forceinline__ void operator()(const pg8::f32x4 (&acc)[2][2][4][2], const pg8::Unit& u, int wr, int wc, int fr_, int fq_) const {
        (void)fr_; (void)fq_; const int lane_e = lane_id_asm(), fr = lane_e & 15, fq = lane_e >> 4;
        float* pb = part + (size_t)(u.kb / klen_bytes) * MCTX * DM; const int col0 = u.pn * 256 + wc * 32 + 8 * fq;
#pragma unroll
        for (int ai = 0; ai < 2; ++ai)
#pragma unroll
            for (int m = 0; m < 4; ++m) {
                const size_t p = (size_t)((u.pm - 64) * 256 + ai * 128 + wr * 64 + m * 16 + fr) * DM + col0;
#pragma unroll
                for (int bj = 0; bj < 2; ++bj) { *(f32x4*)(pb + p + bj * 128) = acc[ai][bj][m][0]; *(f32x4*)(pb + p + bj * 128 + 4) = acc[ai][bj][m][1]; }
            }
    }
};

struct MoeTailOrder {
    const int* tile_e; int ntail, G, c;
    __device__ __forceinline__ bool next(int i, pg8::Unit& u) const {
        const int L = i * G + c; if (L >= ntail * 44) return false;
        const int tile = 128 + L / 44, r = L % 44, pn = r / 11, kp = r % 11;
        u.pm = tile; u.pn = __builtin_amdgcn_readfirstlane(ld_i32_agent(tile_e + tile)) * 4 + pn; u.kb = kp * 512; return true;
    }
    __device__ __forceinline__ void a_ready(const pg8::Unit&) const {}
    __device__ __forceinline__ void done(const pg8::Unit&) const {}
};
struct EpiPartialBf16 {
    static constexpr bool PERM = true, AFTER_DRAIN = false;
    bf16* part;
    __device__ __forceinline__ void operator()(const pg8::f32x4 (&acc)[2][2][4][2], const pg8::Unit& u, int wr, int wc, int fr_, int fq_) const {
        (void)fr_; (void)fq_; const int lane_e = lane_id_asm(), fr = lane_e & 15, fq = lane_e >> 4;
        bf16* pb = part + (size_t)(u.kb / 512) * (8 * 256) * DM; const int col0 = (u.pn & 3) * 256 + wc * 32 + 8 * fq;
#pragma unroll
        for (int ai = 0; ai < 2; ++ai)
#pragma unroll
            for (int m = 0; m < 4; ++m) {
                bf16* rowp = pb + (size_t)((u.pm - 128) * 256 + ai * 128 + wr * 64 + m * 16 + fr) * DM + col0;
#pragma unroll
                for (int bj = 0; bj < 2; ++bj) { const pg8::f32x4 v0 = acc[ai][bj][m][0], v1 = acc[ai][bj][m][1];
                    v4u w; w.x = pk2(v0[0], v0[1]); w.y = pk2(v0[2], v0[3]); w.z = pk2(v1[0], v1[1]); w.w = pk2(v1[2], v1[3]);
                    *(v4u*)(rowp + bj * 128) = w; }
            }
    }
};
#define XB_TMO      128
#define XB_XCNT(j)  (256  + 64 * (j))
#define XB_XSUB(j)  (1280 + 64 * (j))
#define XB_XGEN(j)  (2304 + 64 * (j))
#define XB_TOP      3328
#define XB_TOPGEN   3392
#define XCD_BAR_WORDS 3456
#define XB_SPIN_CAP (1u << 18)

__device__ __forceinline__ unsigned xb_ld(unsigned* p)              { return __hip_atomic_load(p, __ATOMIC_RELAXED, __HIP_MEMORY_SCOPE_AGENT); }
__device__ __forceinline__ unsigned xb_add(unsigned* p, unsigned v) { return __hip_atomic_fetch_add(p, v, __ATOMIC_RELAXED, __HIP_MEMORY_SCOPE_AGENT); }
__device__ __forceinline__ unsigned xb_xcc_id() { return (unsigned)__builtin_amdgcn_s_getreg((3 << 11) | 20) & 0xFu; }
#define XB_SPIN(cond, bar) do { unsigned _sp = 0; while (cond) { __builtin_amdgcn_s_sleep(1); \
    if ((++_sp & 255u) == 0u) { if (xb_ld(&(bar)[XB_TMO])) break; if (_sp > XB_SPIN_CAP) { atomicAdd(&(bar)[XB_TMO], 1u); break; } } } } while (0)

struct XcdBarrier {
    unsigned* bar; unsigned x;
    volatile LAS unsigned* st;
};

__device__ __forceinline__ XcdBarrier xcd_barrier_post(unsigned* bar, volatile LAS unsigned* st, const bool t0) {
    XcdBarrier b; b.bar = bar; b.x = xb_xcc_id(); b.st = st;
    if (t0) (void)xb_add(&bar[XB_XCNT(b.x)], 1u);
    return b;
}
__device__ __forceinline__ void xcd_barrier_complete(unsigned* bar, unsigned x, unsigned& nloc, unsigned& nx) {
    const unsigned G = gridDim.x * gridDim.y * gridDim.z;
    unsigned sum, cnt, mine, sp = 0u;
    for (;;) {
        sum = 0u; cnt = 0u; mine = 0u;
#pragma unroll
        for (unsigned j = 0; j < 16; ++j) { const unsigned c = xb_ld(&bar[XB_XCNT(j)]); sum += c; cnt += (c > 0u) ? 1u : 0u; mine = (j == x) ? c : mine; }
        if (sum == G) break;
        __builtin_amdgcn_s_sleep(1);
        if ((++sp & 255u) == 0u) { if (xb_ld(&bar[XB_TMO])) break; if (sp > XB_SPIN_CAP) { atomicAdd(&bar[XB_TMO], 1u); break; } }
    }
    nloc = mine > 0u ? mine : 1u; nx = cnt > 0u ? cnt : 1u;
}

__device__ __forceinline__ void xcd_barrier(const XcdBarrier& b, const bool t0) {
    asm volatile("s_waitcnt vmcnt(0)" ::: "memory");
    __syncthreads();
    if (t0) {
        unsigned* bar = b.bar;
        __builtin_amdgcn_s_waitcnt(0);
        unsigned nloc = b.st[0], nx = b.st[1];
        if (nloc == 0u) { xcd_barrier_complete(bar, b.x, nloc, nx); b.st[0] = nloc; b.st[1] = nx; }
        const unsigned old = xb_add(&bar[XB_XSUB(b.x)], 1u);
        const unsigned gen = old / nloc;
        if (old + 1u == (gen + 1u) * nloc) {
            __builtin_amdgcn_fence(__ATOMIC_RELEASE, "agent");
            asm volatile("s_waitcnt vmcnt(0)" ::: "memory");
            const unsigned og = xb_add(&bar[XB_TOP], 1u);
            const unsigned tg = og / nx;
            if (og + 1u == (tg + 1u) * nx) xb_add(&bar[XB_TOPGEN], 1u);
            else XB_SPIN(xb_ld(&bar[XB_TOPGEN]) == tg, bar);
            __builtin_amdgcn_fence(__ATOMIC_ACQUIRE, "agent");
            xb_add(&bar[XB_XGEN(b.x)], 1u);
            asm volatile("s_waitcnt vmcnt(0)" ::: "memory");
        } else {
            XB_SPIN(xb_ld(&bar[XB_XGEN(b.x)]) == gen, bar);
            __builtin_amdgcn_fence(__ATOMIC_ACQUIRE, "agent");
            asm volatile("s_waitcnt vmcnt(0)" ::: "memory");
        }
    }
    __syncthreads();
}

constexpr size_t MiB = 1u << 20;
constexpr size_t WS_CTL = 0, CTL_ZERO_BYTES = 1 * MiB;
constexpr size_t WS_MOD = 1 * MiB;
constexpr size_t WS_ROPE = 1 * MiB + 256 * 1024;
constexpr size_t WS_TOKE = 1 * MiB + 512 * 1024;
constexpr size_t WS_TOKG = WS_TOKE + 128 * 1024;
constexpr size_t WS_TOKR = WS_TOKG + 128 * 1024;
constexpr size_t WS_TOKS = WS_TOKR + 128 * 1024;
constexpr size_t WS_META = 2 * MiB;
constexpr size_t WS_SA = 2 * MiB + 256 * 1024, WS_SH = 3 * MiB;
constexpr size_t WS_SGW = 35 * MiB + 768 * 1024;
constexpr size_t WS_LW = 34 * MiB + 512 * 1024;
constexpr size_t WS_WINE = 4 * MiB, WS_WOUTE = 8 * MiB, WS_FFN13 = 10 * MiB, WS_FFN2 = 21 * MiB, WS_WINO = 27 * MiB, WS_WOUTO = 32 * MiB;
constexpr size_t WS_MOE13 = 36 * MiB, WS_MOE2 = 124 * MiB;
constexpr size_t WS_H = 168 * MiB;
constexpr size_t WS_G1 = 201 * MiB;
constexpr size_t WS_PART = 201 * MiB;
constexpr size_t WS_MIX = 259 * MiB;
constexpr size_t WS_XC = 292 * MiB;
constexpr size_t WS_FH = 294 * MiB;
constexpr size_t WS_G2 = 201 * MiB;
constexpr size_t WS_Y1 = 284 * MiB;
constexpr size_t WS_LAF = 36 * MiB, WS_BBF = 78 * MiB, WS_LAB = 120 * MiB, WS_BBB = 324 * MiB, WS_HF = 366 * MiB;
constexpr size_t WS_HP = 168 * MiB;
constexpr size_t WS_MH = 236 * MiB;
constexpr size_t WS_YD = 36 * MiB;
constexpr size_t WS_PARTM = 168 * MiB;
constexpr size_t WS_NEED = 424 * MiB;
constexpr int CW_CNT = 64;
constexpr int CW_BAR = 4096;

constexpr int RING_BYTES = 143360, LDSCTL_OFF = RING_BYTES, MISC_OFF = LDSCTL_OFF + 320, LDS_BYTES = 147456;
constexpr int NWAVES = 8, NTHR = 512;

enum Phase { PH_PRO = 0, PH_NORM1E, PH_GIN_E, PH_MIX_E, PH_GOUT_E, PH_NORM2E, PH_FFN_UP, PH_FFN_DN, PH_NORM1O, PH_GIN_O, PH_LRU_G, PH_LRU_S, PH_GOUT_O, PH_ROUTE, PH_PERM,
             PH_MOE_UP, PH_MOE_DN, PH_COMB, NPH };
#ifndef MK_ONE_LAUNCH
#define MK_ONE_LAUNCH 1
#endif

struct Args { const float* in[34]; float* out; unsigned char* ws; int ph_lo, ph_hi; };
struct Frame {
    LAS unsigned char* lds; volatile LAS unsigned* MISC; gu32* ctl;
    int wave, vcu, G;
};

struct MapId { __device__ __forceinline__ int operator()(int n) const { return n; } };
struct MapRope {
    __device__ __forceinline__ int operator()(int n) const {
        if (n < COL_Q || n >= COL_VAL) return n;
        const int base = n < COL_K ? COL_Q : COL_K, r = n - base, h = r >> 6, d = r & 63;
        return base + h * 64 + (d & 32) + 2 * (d & 15) + ((d >> 4) & 1);
    }
};
struct MapGLU { int off; __device__ __forceinline__ int operator()(int n) const { return (n >> 7) * 256 + off + (n & 127); } };

struct TrDesc { const float* W; bf16* WT; int K, N, item, mk, off; };
__device__ __forceinline__ int tr_rowmap(int mk, int off, int n) { return mk == 0 ? n : (mk == 1 ? MapRope{}(n) : ((n >> 7) * 256 + off + (n & 127))); }
__device__ __forceinline__ void tr_load(const TrDesc& t, int lane, float (&ld)[32]) {
    const int nblk = t.N / 32, kb = t.item / nblk, nb = t.item % nblk; const float* p = t.W + (size_t)(64 * kb + (lane >> 5)) * t.N + 32 * nb + (lane & 31);
#pragma unroll
    for (int i = 0; i < 32; ++i) ld[i] = p[(size_t)(2 * i) * t.N];
}
__device__ __forceinline__ void tr_store(const TrDesc& t, int lane, LAS float* scr, const float (&ld)[32]) {
    const int nblk = t.N / 32, kb = t.item / nblk, nb = t.item % nblk, k0 = 64 * kb, n0 = 32 * nb;
#pragma unroll
    for (int i = 0; i < 32; ++i) scr[(2 * i + (lane >> 5)) * 33 + (lane & 31)] = ld[i];
    LDS_WAIT(); asm volatile("" ::: "memory");
    const int c = lane & 7;
#pragma unroll
    for (int j = 0; j < 4; ++j) { const int n = (lane >> 3) + 8 * j; const LAS float* s = scr + (8 * c) * 33 + n;
        v4u o; o.x = pk2(s[0 * 33], s[1 * 33]); o.y = pk2(s[2 * 33], s[3 * 33]); o.z = pk2(s[4 * 33], s[5 * 33]); o.w = pk2(s[6 * 33], s[7 * 33]);
        *(GAS v4u*)(t.WT + (size_t)tr_rowmap(t.mk, t.off, n0 + n) * t.K + k0 + 8 * c) = o; }
    LDS_WAIT(); asm volatile("" ::: "memory");
}
template <class D>
__device__ __forceinline__ void tr_run(const D& desc, LAS float* scr, int lane, int first, int stride, int hi) {
    int it = first; if (it >= hi) return;
    float la[32], lb[32];
    TrDesc ta = desc(it), tb = ta; tr_load(ta, lane, la);
    for (;;) {
        int nx = it + stride; bool has = nx < hi;
        if (has) { tb = desc(nx); tr_load(tb, lane, lb); }
        tr_store(ta, lane, scr, la);
        if (!has) break;
        it = nx; nx = it + stride; has = nx < hi;
        if (has) { ta = desc(nx); tr_load(ta, lane, la); }
        tr_store(tb, lane, scr, lb);
        if (!has) break;
        it = nx;
    }
}
struct ProDesc {
    const Args* A;
    __device__ __forceinline__ TrDesc operator()(int it) const {
        constexpr int I_WINE = 16 * 56, I_WOUTE = 16 * 32, I_F1 = 16 * 88, I_F2 = 44 * 32, I_WINO = 16 * 80, I_WOUTO = 20 * 32;
        unsigned char* ws = A->ws; int r = it;
        if (r < I_WINE) return TrDesc{A->in[8], (bf16*)(ws + WS_WINE), DM, NIN_E, r, 1, 0}; r -= I_WINE;
        if (r < I_WOUTE) return TrDesc{A->in[12], (bf16*)(ws + WS_WOUTE), DM, DM, r, 0, 0}; r -= I_WOUTE;
        if (r < I_F1) return TrDesc{A->in[13], (bf16*)(ws + WS_FFN13), DM, DFF, r, 2, 0}; r -= I_F1;
        if (r < I_F1) return TrDesc{A->in[14], (bf16*)(ws + WS_FFN13), DM, DFF, r, 2, 128}; r -= I_F1;
        if (r < I_F2) return TrDesc{A->in[15], (bf16*)(ws + WS_FFN2), DFF, DM, r, 0, 0}; r -= I_F2;
        if (r < I_WINO) return TrDesc{A->in[20], (bf16*)(ws + WS_WINO), DM, NIN_O, r, 0, 0}; r -= I_WINO;
        if (r < I_WOUTO) return TrDesc{A->in[28], (bf16*)(ws + WS_WOUTO), DRNN, DM, r, 0, 0}; r -= I_WOUTO;
        const int g = r / 160, mi = (r % 160) / 8, item = r % 8, dd = mi / 10, blk = mi % 10;
        return TrDesc{A->in[g ? 25 : 23] + (size_t)mi * 16384, (bf16*)(ws + WS_LW) + (size_t)((dd * 2 + g) * 10 + blk) * 16384, 128, 128, item, 0, 0};
    }
};
constexpr int PRO_NITEMS = 16 * 56 + 16 * 32 + 2 * 16 * 88 + 44 * 32 + 16 * 80 + 20 * 32 + 2 * 20 * 8;
constexpr int CVT_I_F1 = 16 * 88, CVT_I_F2 = 44 * 32, CVT_PER_E = 2 * CVT_I_F1 + CVT_I_F2, CVT_TOTAL = NEXP * CVT_PER_E;
struct MoeDesc {
    const Args* A;
    __device__ __forceinline__ TrDesc operator()(int it) const {
        unsigned char* ws = A->ws; const int e = it / CVT_PER_E; int r = it % CVT_PER_E;
        bf16* w13 = (bf16*)(ws + WS_MOE13) + (size_t)e * NFF2 * DM; bf16* w2 = (bf16*)(ws + WS_MOE2) + (size_t)e * DM * DFF;
        if (r < CVT_I_F1) return TrDesc{A->in[30] + (size_t)e * DM * DFF, w13, DM, DFF, r, 2, 0}; r -= CVT_I_F1;
        if (r < CVT_I_F1) return TrDesc{A->in[31] + (size_t)e * DM * DFF, w13, DM, DFF, r, 2, 128}; r -= CVT_I_F1;
        return TrDesc{A->in[32] + (size_t)e * DFF * DM, w2, DFF, DM, r, 0, 0};
    }
};

__device__ __forceinline__ void ph_prologue(const Args& A, Frame& F) {
    const int lane = lane_id_asm(), tid = F.wave * 64 + lane; (void)tid;
    unsigned char* ws = A.ws;
    LAS float* sact = (LAS float*)F.lds;
    LAS float* red = sact + 3 * 1024;
    for (int t = tid; t < 3 * 1024; t += NTHR) { const int v = t >> 10, k = t & 1023; const float x = v < 2 ? A.in[1][v * 1024 + k] : A.in[3][k]; sact[t] = silu_f(x); }
    __syncthreads();
    float* mod = (float*)(ws + WS_MOD);
    for (int item = blockIdx.x; item < 256; item += F.G) {
        const int L = item >> 7, ch = item & 127; const float* W = (L ? A.in[16] : A.in[4]) + ch * 48; const float* bias = (L ? A.in[17] : A.in[5]);
        if (tid < 504) {
            const int c4 = tid % 12, ks = tid / 12; f32x4 a0 = {0.f, 0.f, 0.f, 0.f}, a1 = a0, a2 = a0;
#pragma unroll 8
            for (int k = ks; k < 1024; k += 42) { const f32x4 w = *(const f32x4*)(W + (size_t)k * 6144 + c4 * 4); a0 += sact[k] * w; a1 += sact[1024 + k] * w; a2 += sact[2048 + k] * w; }
            LAS float* r = red + ks * 144 + c4 * 4;
#pragma unroll
            for (int j = 0; j < 4; ++j) { r[j] = a0[j]; r[48 + j] = a1[j]; r[96 + j] = a2[j]; }
        }
        __syncthreads();
        if (tid < 144) { const int v = tid / 48, cc = tid % 48, n = ch * 48 + cc; float s = 0.f; for (int ks = 0; ks < 42; ++ks) s += red[ks * 144 + tid]; mod[(L * 3 + v) * 6144 + n] = s + bias[n]; }
        __syncthreads();
    }
    { const int idx = blockIdx.x * NTHR + tid; if (idx < 128 * 16) { const int pos = idx >> 4, f = idx & 15; const float freq = fexp2(-(float)f * (13.287712379549449f / 16.f)); const float rev = (float)pos * freq * 0.15915494309189535f;
        float* rp = (float*)(ws + WS_ROPE) + idx * 2; rp[0] = __builtin_amdgcn_cosf(rev); rp[1] = __builtin_amdgcn_sinf(rev); } }
    { const int idx = blockIdx.x * NTHR + tid; if (idx < 4 * 128 * 128 / 4) { const f32x4 v = ((const f32x4*)A.in[9])[idx]; v2u o; o.x = pk2(v[0], v[1]); o.y = pk2(v[2], v[3]); ((v2u*)(ws + WS_SGW))[idx] = o; } }
    LAS float* scr = (LAS float*)(F.lds + F.wave * 16384);
    tr_run(ProDesc{&A}, scr, lane, F.vcu * NWAVES + F.wave, F.G * NWAVES, PRO_NITEMS);
}
__device__ __forceinline__ void convert_moe_range(const Args& A, Frame& F, int lo, int hi, int nblk, int brank) {
    const int lane = lane_id_asm();
    tr_run(MoeDesc{&A}, (LAS float*)(F.lds + F.wave * 16384), lane, lo + brank * NWAVES + F.wave, nblk * NWAVES, hi);
}
constexpr int CVT_S1 = 2000, CVT_S2 = 5360, CVT_S3 = 10080, CVT_S4 = 14400, CVT_S5 = 20544, CVT_S6 = CVT_S5 + 1792, CVT_S7 = CVT_S6 + 1344;
constexpr int CVT_NFILL = 6, CVT_FILL_END = (CVT_S7 + CVT_NFILL * 256 * 7 < CVT_TOTAL) ? CVT_S7 + CVT_NFILL * 256 * 7 : CVT_TOTAL;

__device__ __forceinline__ void norm_mod_v(const float* gain, const float* scale, const float* shift, int lane, f32x4 (&v)[4]) {
    float ss = 0.f;
#pragma unroll
    for (int j = 0; j < 4; ++j) ss += (v[j][0] * v[j][0] + v[j][1] * v[j][1]) + (v[j][2] * v[j][2] + v[j][3] * v[j][3]);
    const float rstd = 1.f / sqrtf(wave_sum(ss) * (1.f / DM) + EPS);
#pragma unroll
    for (int j = 0; j < 4; ++j) { const f32x4 g = ((const f32x4*)gain)[lane + 64 * j], sc = ((const f32x4*)scale)[lane + 64 * j], sh = ((const f32x4*)shift)[lane + 64 * j];
        v[j] = v[j] * rstd * g * (1.f + sc) + sh; }
}
__device__ __forceinline__ void norm_mod_regs(const float* xrow, const float* gain, const float* scale, const float* shift, int lane, f32x4 (&v)[4]) {
    const f32x4* xr = (const f32x4*)xrow + lane;
#pragma unroll
    for (int j = 0; j < 4; ++j) v[j] = xr[64 * j];
    norm_mod_v(gain, scale, shift, lane, v);
}
struct RowMod { f32x4 gs[4], sh[4]; };
__device__ __forceinline__ RowMod load_rowmod(const float* gain, const float* scale, const float* shift, int lane) {
    RowMod m;
#pragma unroll
    for (int j = 0; j < 4; ++j) { m.gs[j] = ((const f32x4*)gain)[lane + 64 * j] * (1.f + ((const f32x4*)scale)[lane + 64 * j]); m.sh[j] = ((const f32x4*)shift)[lane + 64 * j]; }
    return m;
}
__device__ __forceinline__ void load_row(const float* xrow, int lane, f32x4 (&v)[4]) {
    const f32x4* xr = (const f32x4*)xrow + lane;
#pragma unroll
    for (int j = 0; j < 4; ++j) v[j] = xr[64 * j];
}
__device__ __forceinline__ void norm_apply(const RowMod& m, f32x4 (&v)[4]) {
    float ss = 0.f;
#pragma unroll
    for (int j = 0; j < 4; ++j) ss += (v[j][0] * v[j][0] + v[j][1] * v[j][1]) + (v[j][2] * v[j][2] + v[j][3] * v[j][3]);
    const float rstd = 1.f / sqrtf(wave_sum(ss) * (1.f / DM) + EPS);
#pragma unroll
    for (int j = 0; j < 4; ++j) v[j] = v[j] * rstd * m.gs[j] + m.sh[j];
}
__device__ __forceinline__ void store_row_bf16(bf16* orow, int lane, const f32x4 (&v)[4]) {
    GAS v2u* o = (GAS v2u*)orow + lane;
#pragma unroll
    for (int j = 0; j < 4; ++j) { v2u w; w.x = pk2(v[j][0], v[j][1]); w.y = pk2(v[j][2], v[j][3]); o[64 * j] = w; }
}
struct CtxFix { const float* part; int nsplit; const float* gate; const float* base; float* xout; };
__device__ __forceinline__ void ph_norm(Frame& F, const float* xl, const float* xc, const float* gain, const float* modL, int p_shift, int p_scale, bf16* H, int nrows, const CtxFix cf) {
    const int lane = lane_id_asm();
    const int gw = F.vcu * NWAVES + F.wave, NGW = F.G * NWAVES, per = MLAT / NGW;
    for (int r0 = gw * per; r0 < MLAT; r0 += NGW * per) {
        const float* md = modL + mod_of_row(r0) * 6144; const RowMod m = load_rowmod(gain, md + p_scale * 1024, md + p_shift * 1024, lane);
        f32x4 cur[4], nxt[4]; load_row(xl + (size_t)r0 * DM, lane, cur);
        for (int i = 0; i < per; ++i) {
            if (i + 1 < per) load_row(xl + (size_t)(r0 + i + 1) * DM, lane, nxt);
            norm_apply(m, cur); store_row_bf16(H + (size_t)(r0 + i) * DM, lane, cur);
#pragma unroll
            for (int j = 0; j < 4; ++j) cur[j] = nxt[j];
        }
    }
    for (int r = MLAT + gw; r < nrows; r += NGW) {
        const float* md = modL + 2 * 6144; const RowMod m = load_rowmod(gain, md + p_scale * 1024, md + p_shift * 1024, lane);
        f32x4 v[4]; const size_t ro = (size_t)(r - MLAT) * DM;
        if (cf.nsplit > 0) {
#pragma unroll
            for (int j = 0; j < 4; ++j) { f32x4 s = ((const f32x4*)(cf.part + ro))[lane + 64 * j];
                for (int kp = 1; kp < cf.nsplit; ++kp) s += ((const f32x4*)(cf.part + (size_t)kp * MCTX * DM + ro))[lane + 64 * j];
                v[j] = ((const f32x4*)(cf.base + ro))[lane + 64 * j] + ((const f32x4*)cf.gate)[lane + 64 * j] * s;
                ((f32x4*)(cf.xout + ro))[lane + 64 * j] = v[j]; }
        } else load_row(xc + ro, lane, v);
        norm_apply(m, v); store_row_bf16(H + (size_t)r * DM, lane, v);
    }
}

__device__ __forceinline__ void route_logits(const LAS float* rw, int lane, const f32x4 (&v)[4], float (&lg)[8]) {
#pragma unroll
    for (int e = 0; e < 8; ++e) { float s = 0.f;
#pragma unroll
        for (int j = 0; j < 4; ++j) { const f32x4 w = *(const LAS f32x4*)(rw + e * 1024 + 4 * (lane + 64 * j)); s += (v[j][0] * w[0] + v[j][1] * w[1]) + (v[j][2] * w[2] + v[j][3] * w[3]); }
        lg[e] = wave_sum(s); }
}
__device__ __forceinline__ void ph_route(const Args& A, Frame& F) {
    const int lane = lane_id_asm(), tid = F.wave * 64 + lane;
    LAS float* rw = (LAS float*)F.lds; LAS unsigned* lcnt = (LAS unsigned*)(F.lds + 32768);
    for (int i = tid; i < DM * 8; i += NTHR) rw[(i & 7) * 1024 + (i >> 3)] = A.in[29][i];
    if (tid < 16) lcnt[tid] = 0u;
    __syncthreads();
    int* toke = (int*)(A.ws + WS_TOKE); float* tokg = (float*)(A.ws + WS_TOKG); int* tokr = (int*)(A.ws + WS_TOKR);
    for (int t0 = blockIdx.x * 64; t0 < MLAT; t0 += F.G * 64) {
        const float* md = (const float*)(A.ws + WS_MOD) + (3 + (t0 >> 13)) * 6144; const RowMod m = load_rowmod(A.in[19], md + 4 * 1024, md + 3 * 1024, lane);
        const int tb = t0 + F.wave * 8;
        f32x4 cur[4], nxt[4]; load_row(A.out + (size_t)tb * DM, lane, cur);
        for (int i = 0; i < 8; ++i) {
            const int t = tb + i;
            if (i + 1 < 8) load_row(A.out + (size_t)(t + 1) * DM, lane, nxt);
            norm_apply(m, cur);
            float lg[8]; route_logits(rw, lane, cur, lg);
            int i0 = 0; float l0 = lg[0];
#pragma unroll
            for (int e = 1; e < 8; ++e) if (lg[e] > l0) { l0 = lg[e]; i0 = e; }
            int i1 = -1; float l1 = -INFINITY;
#pragma unroll
            for (int e = 0; e < 8; ++e) if (e != i0 && lg[e] > l1) { l1 = lg[e]; i1 = e; }
            const float g0 = 1.f / (1.f + expf(l1 - l0)), g1 = 1.f - g0;
            if (lane == 0) {
                const int r0 = (int)__hip_atomic_fetch_add(lcnt + i0, 1u, __ATOMIC_RELAXED, __HIP_MEMORY_SCOPE_WORKGROUP), r1 = (int)__hip_atomic_fetch_add(lcnt + i1, 1u, __ATOMIC_RELAXED, __HIP_MEMORY_SCOPE_WORKGROUP);
                toke[t] = i0; toke[MLAT + t] = i1; tokg[t] = g0; tokg[MLAT + t] = g1; tokr[t] = r0; tokr[MLAT + t] = r1;
            }
#pragma unroll
            for (int j = 0; j < 4; ++j) cur[j] = nxt[j];
        }
        __syncthreads();
        if (tid < 8) { const unsigned c = lcnt[tid]; lcnt[8 + tid] = c ? __hip_atomic_fetch_add((unsigned*)(F.ctl + CW_CNT + 16 * tid), c, RLX_AGENT) : 0u; }
        __syncthreads();
        if (tid < 128) { const int idx = (tid & 1) * MLAT + t0 + (tid >> 1); tokr[idx] += (int)lcnt[8 + toke[idx]]; }
        __syncthreads();
        if (tid < 8) lcnt[tid] = 0u;
        __syncthreads();
    }
}
__device__ __forceinline__ void ph_permute(const Args& A, Frame& F) {
    const int lane = lane_id_asm(), tid = F.wave * 64 + lane; (void)tid;
    const int* toke = (const int*)(A.ws + WS_TOKE); const int* tokr = (const int*)(A.ws + WS_TOKR); int* toks = (int*)(A.ws + WS_TOKS); int* meta = (int*)(A.ws + WS_META); bf16* HP = (bf16*)(A.ws + WS_HP);
    int off[8]; int tot = 0;
#pragma unroll
    for (int e = 0; e < 8; ++e) { const int c = (int)__hip_atomic_load((unsigned*)(F.ctl + CW_CNT + 16 * e), RLX_AGENT); off[e] = tot; tot += ((c + 255) >> 8) << 8; }
    if (blockIdx.x == 0 && tid < MOE_MAXT + 8) { int e = 0;
#pragma unroll
        for (int k = 1; k < 8; ++k) if (tid * 256 >= off[k]) e = k;
        meta[tid] = e; if (tid == 0) meta[256] = tot >> 8; }
    const int gw = F.vcu * NWAVES + F.wave, NGW = F.G * NWAVES, per = MLAT / NGW;
    for (int r0 = gw * per; r0 < MLAT; r0 += NGW * per) {
        const float* md = (const float*)(A.ws + WS_MOD) + (3 + (r0 >> 13)) * 6144; const RowMod m = load_rowmod(A.in[19], md + 4 * 1024, md + 3 * 1024, lane);
        f32x4 cur[4], nxt[4]; load_row(A.out + (size_t)r0 * DM, lane, cur);
        for (int i = 0; i < per; ++i) {
            const int t = r0 + i;
            if (i + 1 < per) load_row(A.out + (size_t)(t + 1) * DM, lane, nxt);
            const int e0 = toke[t], e1 = toke[MLAT + t]; int s0 = tokr[t], s1 = tokr[MLAT + t];
            norm_apply(m, cur);
            int o0 = 0, o1 = 0;
#pragma unroll
            for (int k = 0; k < 8; ++k) { if (k == e0) o0 = off[k]; if (k == e1) o1 = off[k]; }
            s0 += o0; s1 += o1;
            store_row_bf16(HP + (size_t)s0 * DM, lane, cur); store_row_bf16(HP + (size_t)s1 * DM, lane, cur);
            if (lane == 0) { toks[t] = s0; toks[MLAT + t] = s1; }
#pragma unroll
            for (int j = 0; j < 4; ++j) cur[j] = nxt[j];
        }
    }
}
struct CombRow { f32x4 x[4]; v2u a[4], b[4]; };
__device__ __forceinline__ void comb_load(const Args& A, int t, int s0, int s1, int lane, CombRow& r) {
    const bf16* YD = (const bf16*)(A.ws + WS_YD);
    const f32x4* xr = (const f32x4*)(A.out + (size_t)t * DM) + lane; const v2u* y0 = (const v2u*)(YD + (size_t)(s0 < 32768 ? s0 : 0) * DM) + lane; const v2u* y1 = (const v2u*)(YD + (size_t)(s1 < 32768 ? s1 : 0) * DM) + lane;
#pragma unroll
    for (int j = 0; j < 4; ++j) { r.x[j] = xr[64 * j]; r.a[j] = y0[64 * j]; r.b[j] = y1[64 * j]; }
}
__device__ __forceinline__ f32x4 bf4(v2u a) { return (f32x4){bflo(a.x), bfhi(a.x), bflo(a.y), bfhi(a.y)}; }
__device__ __forceinline__ void ph_combine(const Args& A, Frame& F, float* outp) {
    const int lane = lane_id_asm();
    const float* tokg = (const float*)(A.ws + WS_TOKG); const int* toks = (const int*)(A.ws + WS_TOKS); const float* fn = A.in[33];
    const bf16* PM = (const bf16*)(A.ws + WS_PARTM);
    const int gw = F.vcu * NWAVES + F.wave, NGW = F.G * NWAVES, per = MLAT / NGW;
    for (int r0 = gw * per; r0 < MLAT; r0 += NGW * per) {
        const float* g2p = (const float*)(A.ws + WS_MOD) + (3 + (r0 >> 13)) * 6144 + 5 * 1024;
        f32x4 g2[4], fnv[4];
#pragma unroll
        for (int j = 0; j < 4; ++j) { g2[j] = ((const f32x4*)g2p)[lane + 64 * j]; fnv[j] = ((const f32x4*)fn)[lane + 64 * j]; }
        const int li = lane < per ? lane : per - 1;
        const int ms0 = toks[r0 + li], ms1 = toks[MLAT + r0 + li]; const float mg0 = tokg[r0 + li], mg1 = tokg[MLAT + r0 + li];
        CombRow cur, nxt; comb_load(A, r0, __shfl(ms0, 0), __shfl(ms1, 0), lane, cur);
        for (int i = 0; i < per; ++i) {
            const int t = r0 + i; const int s0 = __shfl(ms0, i), s1 = __shfl(ms1, i); const float g0 = __shfl(mg0, i), g1 = __shfl(mg1, i);
            if (i + 1 < per) comb_load(A, t + 1, __shfl(ms0, i + 1), __shfl(ms1, i + 1), lane, nxt);
            f32x4 z[4]; float ss = 0.f;
#pragma unroll
            for (int j = 0; j < 4; ++j) {
                f32x4 ya = bf4(cur.a[j]), yb = bf4(cur.b[j]);
                if (s0 >= 32768) { ya = (f32x4){0.f, 0.f, 0.f, 0.f}; for (int kp = 0; kp < 11; ++kp) ya += bf4(((const v2u*)(PM + ((size_t)kp * 2048 + (s0 - 32768)) * DM))[lane + 64 * j]); }
                if (s1 >= 32768) { yb = (f32x4){0.f, 0.f, 0.f, 0.f}; for (int kp = 0; kp < 11; ++kp) yb += bf4(((const v2u*)(PM + ((size_t)kp * 2048 + (s1 - 32768)) * DM))[lane + 64 * j]); }
                z[j] = cur.x[j] + g2[j] * (g0 * ya + g1 * yb); ss += (z[j][0] * z[j][0] + z[j][1] * z[j][1]) + (z[j][2] * z[j][2] + z[j][3] * z[j][3]); }
            const float rstd = 1.f / sqrtf(wave_sum(ss) * (1.f / DM) + EPS);
            f32x4* orow = (f32x4*)(outp + (size_t)t * DM) + lane;
#pragma unroll
            for (int j = 0; j < 4; ++j) orow[64 * j] = z[j] * rstd * fnv[j];
            cur = nxt;
        }
    }
}
template <class Fill>
__device__ __forceinline__ void xcd_barrier_fill(const XcdBarrier& b, const bool t0, const Fill& fill) {
    asm volatile("s_waitcnt vmcnt(0)" ::: "memory");
    __syncthreads();
    if (t0) {
        unsigned* bar = b.bar;
        __builtin_amdgcn_s_waitcnt(0);
        unsigned nloc = b.st[0], nx = b.st[1];
        if (nloc == 0u) { xcd_barrier_complete(bar, b.x, nloc, nx); b.st[0] = nloc; b.st[1] = nx; }
        const unsigned old = xb_add(&bar[XB_XSUB(b.x)], 1u);
        const unsigned gen = old / nloc;
        if (old + 1u == (gen + 1u) * nloc) {
            __builtin_amdgcn_fence(__ATOMIC_RELEASE, "agent");
            asm volatile("s_waitcnt vmcnt(0)" ::: "memory");
            const unsigned og = xb_add(&bar[XB_TOP], 1u);
            const unsigned tg = og / nx;
            if (og + 1u == (tg + 1u) * nx) xb_add(&bar[XB_TOPGEN], 1u);
            else XB_SPIN(xb_ld(&bar[XB_TOPGEN]) == tg, bar);
            __builtin_amdgcn_fence(__ATOMIC_ACQUIRE, "agent");
            xb_add(&bar[XB_XGEN(b.x)], 1u);
            asm volatile("s_waitcnt vmcnt(0)" ::: "memory");
        } else {
            XB_SPIN(xb_ld(&bar[XB_XGEN(b.x)]) == gen, bar);
            __builtin_amdgcn_fence(__ATOMIC_ACQUIRE, "agent");
            asm volatile("s_waitcnt vmcnt(0)" ::: "memory");
        }
    }
    fill();
    __syncthreads();
}

constexpr int RCP = 272, HFL_OFF = 256 * RCP;
__device__ __forceinline__ void lru_ab(float rp, float ip, float rcv, float nba, float nbx, float kc, float& a, float& b) {
    const float rg = frcp(1.f + fexp2(fmaf(rp, -LOG2E, nba)));
    const float ig = frcp(1.f + fexp2(fmaf(ip, -LOG2E, nbx)));
    const float la = kc * rg;
    a = fexp2(la * LOG2E);
    const float om = fmaf(-a, a, 1.f);
    b = __builtin_amdgcn_sqrtf(om) * (ig * rcv);
}
template <bool PASS3>
__device__ __forceinline__ void lru_unit(const Args& A, Frame& F, int pm, int blk) {
    const bf16* G2 = (const bf16*)(A.ws + WS_G2);
    LAS unsigned char* rcT = F.lds;
    const int lane = lane_id_asm(), tid = F.wave * 64 + lane, r0 = pm * 256, w = F.wave, c = lane & 15, q = lane >> 4;
    int seg_lo, seg_hi; if (pm < 64) { seg_lo = (pm >> 5) * SEQ; seg_hi = seg_lo + SEQ; } else { seg_lo = r0; seg_hi = r0 + 256; }
    {
        const int c8 = tid & 15, rgp = tid >> 4, ch0 = blk * 128 + c8 * 8;
        const float* cw = A.in[21]; const float* cb = A.in[22];
        f32x4 wj[4][2], cbv[2];
#pragma unroll
        for (int j = 0; j < 4; ++j) { wj[j][0] = *(const f32x4*)(cw + j * DRNN + ch0); wj[j][1] = *(const f32x4*)(cw + j * DRNN + ch0 + 4); }
        cbv[0] = *(const f32x4*)(cb + ch0); cbv[1] = *(const f32x4*)(cb + ch0 + 4);
        v4u x[11];
#pragma unroll
        for (int i = 0; i < 11; ++i) { const int grow = r0 + rgp * 8 + i - 2; const bool ok = (grow >= seg_lo) && (grow < seg_hi); const int gc = grow < seg_lo ? seg_lo : (grow >= seg_hi ? seg_hi - 1 : grow);
            const v4u t = *(const v4u*)(G2 + (size_t)gc * NIN_O + DRNN + ch0); x[i].x = ok ? t.x : 0u; x[i].y = ok ? t.y : 0u; x[i].z = ok ? t.z : 0u; x[i].w = ok ? t.w : 0u; }
#pragma unroll
        for (int r = 0; r < 8; ++r) { f32x4 o0 = cbv[0], o1 = cbv[1];
#pragma unroll
            for (int j = 0; j < 4; ++j) { const v4u t = x[r + j]; o0 += wj[j][0] * (f32x4){bflo(t.x), bfhi(t.x), bflo(t.y), bfhi(t.y)}; o1 += wj[j][1] * (f32x4){bflo(t.z), bfhi(t.z), bflo(t.w), bfhi(t.w)}; }
            v4u pk; pk.x = pk2(o0[0], o0[1]); pk.y = pk2(o0[2], o0[3]); pk.z = pk2(o1[0], o1[1]); pk.w = pk2(o1[2], o1[3]);
            *(LAS v4u*)(rcT + (rgp * 8 + r) * RCP + c8 * 16) = pk; }
    }
    __syncthreads();
    if (w >= 4) __builtin_amdgcn_s_sleep(13);
    const int ch = blk * 128 + 16 * w + c;
    float* SA = (float*)(A.ws + WS_SA); float* SH = (float*)(A.ws + WS_SH);
    pg8::bf16x8 Bid;
#pragma unroll
    for (int e = 0; e < 8; ++e) Bid[e] = (8 * q + e == (w & 1) * 16 + c) ? (short)0x3F80 : (short)0;
    float cin = 0.f;
    if (PASS3) {
        const int d = (lane >> 4) & 1, b = pm >> 5; const int chc = blk * 128 + 16 * w + (lane & 15);
#pragma unroll 11
        for (int s = 0; s < 33; ++s) {
            int T; bool ok;
            if (s == 0) { T = 64 + b; ok = true; } else if (d == 0) { T = 32 * b + s - 1; ok = T < pm; } else { T = 32 * b + 32 - s; ok = T > pm; }
            const int Tc = ok ? T : pm;
            const float av = SA[(size_t)(Tc * 2 + d) * DRNN + chc], hv = SH[(size_t)(Tc * 2 + d) * DRNN + chc];
            if (ok) cin = av * cin + hv;
        }
    }
    LAS unsigned* hfl = (LAS unsigned*)(F.lds + HFL_OFF + w * 8192) + lane;
    bf16* Y1 = (bf16*)(A.ws + WS_Y1);
#pragma unroll
    for (int d = 0; d < 2; ++d) {
        const float nba = -LOG2E * A.in[24][d * DRNN + ch], nbx = -LOG2E * A.in[26][d * DRNN + ch], kc = -8.f * log1pf(expf(-A.in[27][d * DRNN + ch]));
        pg8::bf16x8 Bw[2][4];
        { const bf16* LW = (const bf16*)(A.ws + WS_LW);
#pragma unroll
          for (int g = 0; g < 2; ++g)
#pragma unroll
            for (int ks = 0; ks < 4; ++ks) Bw[g][ks] = *(const pg8::bf16x8*)(LW + (size_t)((d * 2 + g) * 10 + blk) * 16384 + (16 * w + c) * 128 + ks * 32 + 8 * q); }
        float a_run = 1.f, h_run = PASS3 ? __shfl(cin, d * 16 + c) : 0.f;
#pragma unroll 1
        for (int gi = 0; gi < 4; ++gi) {
            const int g4 = d == 0 ? gi : 3 - gi;
            float gt[4][4];
            if (PASS3 && d == 1) {
#pragma unroll
                for (int mm = 0; mm < 4; ++mm)
#pragma unroll
                    for (int r = 0; r < 4; ++r) gt[mm][r] = bf2f(G2[(size_t)(r0 + (g4 * 4 + mm) * 16 + 4 * q + r) * NIN_O + ch]);
            }
            pg8::f32x4 acc[2][4], rcv[4];
#pragma unroll
            for (int mm = 0; mm < 4; ++mm) { acc[0][mm] = (pg8::f32x4){0.f, 0.f, 0.f, 0.f}; acc[1][mm] = acc[0][mm]; rcv[mm] = acc[0][mm]; }
#pragma unroll
            for (int mm = 0; mm < 4; ++mm) {
                const LAS unsigned char* ap = rcT + ((g4 * 4 + mm) * 16 + c) * RCP + q * 16;
                pg8::bf16x8 af[4];
#pragma unroll
                for (int ks = 0; ks < 4; ++ks) af[ks] = *(const LAS pg8::bf16x8*)(ap + ks * 64);
                const pg8::bf16x8 afi = *(const LAS pg8::bf16x8*)(ap + (w >> 1) * 64);
#pragma unroll
                for (int ks = 0; ks < 4; ++ks) {
                    acc[0][mm] = __builtin_amdgcn_mfma_f32_16x16x32_bf16(af[ks], Bw[0][ks], acc[0][mm], 0, 0, 0);
                    acc[1][mm] = __builtin_amdgcn_mfma_f32_16x16x32_bf16(af[ks], Bw[1][ks], acc[1][mm], 0, 0, 0);
                }
                rcv[mm] = __builtin_amdgcn_mfma_f32_16x16x32_bf16(afi, Bid, rcv[mm], 0, 0, 0);
            }
#pragma unroll
            for (int mmi = 0; mmi < 4; ++mmi) {
                const int mm = d == 0 ? mmi : 3 - mmi, m = g4 * 4 + mm;
                float av[4], bv[4];
#pragma unroll
                for (int r = 0; r < 4; ++r) lru_ab(acc[0][mm][r], acc[1][mm][r], rcv[mm][r], nba, nbx, kc, av[r], bv[r]);
                float A4, B4;
                if (d == 0) { A4 = av[0] * av[1] * av[2] * av[3]; B4 = ((bv[0] * av[1] + bv[1]) * av[2] + bv[2]) * av[3] + bv[3]; }
                else        { A4 = av[0] * av[1] * av[2] * av[3]; B4 = ((bv[3] * av[2] + bv[2]) * av[1] + bv[1]) * av[0] + bv[0]; }
                float TA[4], TB[4];
#pragma unroll
                for (int k = 0; k < 4; ++k) { TA[k] = __shfl(A4, c + 16 * k); TB[k] = __shfl(B4, c + 16 * k); }
                float EA = 1.f, EB = 0.f, PA = 1.f, PB = 0.f;
#pragma unroll
                for (int k = 0; k < 4; ++k) { const int kk = d == 0 ? k : 3 - k; if (kk == q) { EA = PA; EB = PB; } PB = TA[kk] * PB + TB[kk]; PA = PA * TA[kk]; }
                if (PASS3) {
                    float h = EA * h_run + EB; float hv[4];
#pragma unroll
                    for (int ri = 0; ri < 4; ++ri) { const int r = d == 0 ? ri : 3 - ri; h = av[r] * h + bv[r]; hv[r] = h; }
                    if (d == 0) { hfl[(m * 2 + 0) * 64] = pk2(hv[0], hv[1]); hfl[(m * 2 + 1) * 64] = pk2(hv[2], hv[3]); }
                    else { const unsigned f0 = hfl[(m * 2 + 0) * 64], f1 = hfl[(m * 2 + 1) * 64];
                        const size_t row = (size_t)(r0 + m * 16 + 4 * q);
                        Y1[(row + 0) * DRNN + ch] = f2bf1(gt[mm][0] * (bflo(f0) + hv[0])); Y1[(row + 1) * DRNN + ch] = f2bf1(gt[mm][1] * (bfhi(f0) + hv[1]));
                        Y1[(row + 2) * DRNN + ch] = f2bf1(gt[mm][2] * (bflo(f1) + hv[2])); Y1[(row + 3) * DRNN + ch] = f2bf1(gt[mm][3] * (bfhi(f1) + hv[3])); }
                }
                h_run = PA * h_run + PB; a_run *= PA;
            }
        }
        if (!PASS3) { if (q == 0) { SA[(size_t)(pm * 2 + d) * DRNN + ch] = a_run; SH[(size_t)(pm * 2 + d) * DRNN + ch] = h_run; } }
    }
    __syncthreads();
}
template <bool PASS3>
__device__ __forceinline__ void ph_lru(const Args& A, Frame& F) {
    const int ntile = PASS3 ? 64 : 66;
    for (int u = blockIdx.x; u < ntile * 10; u += F.G) lru_unit<PASS3>(A, F, u / 10, u % 10);
}


typedef short s16x4 __attribute__((ext_vector_type(4)));
__device__ __forceinline__ s16x4 lds_tr16(const LAS unsigned char* p) { return __builtin_bit_cast(s16x4, __builtin_amdgcn_ds_read_tr16_b64_v4i16((LAS s16x4*)p)); }
constexpr int KP = 144, VP = 160;
constexpr int ATT_KOFF = 0, ATT_VOFF = 2 * 64 * KP, ATT_QOFF = ATT_VOFF + 2 * 64 * VP;
__device__ __forceinline__ void attn_unit(const Args& A, Frame& F, int b, int kvh, int qb, bool ctxq) {
    const bf16* G1 = (const bf16*)(A.ws + WS_G1); bf16* MIX = (bf16*)(A.ws + WS_MIX);
    const int lane = lane_id_asm(), tid = F.wave * 64 + lane, w = F.wave, li = lane & 15, g = lane >> 4, hw = w & 1, h = kvh * 4 + (w >> 1);
    const int qrow0 = (ctxq ? MLAT + b * CTXL : b * SEQ) + qb * 128 + 64 * hw;
    LAS unsigned char* lQ = F.lds + ATT_QOFF + w * (64 * KP);
#pragma unroll
    for (int i = 0; i < 8; ++i) { const int ck = lane + 64 * i, row = ck >> 3, dc = ck & 7;
        *(LAS v4u*)(lQ + row * KP + dc * 16) = *(const v4u*)(G1 + (size_t)(qrow0 + row) * NIN_E + COL_Q + h * 64 + 8 * dc); }
    const float sk = A.in[11][h] * LOG2E;
    float mrun[4], lrun[4]; pg8::f32x4 O[4][4];
#pragma unroll
    for (int mt = 0; mt < 4; ++mt) { mrun[mt] = sk; lrun[mt] = (g == 0) ? 1.f : 0.f;
#pragma unroll
        for (int dt = 0; dt < 4; ++dt) O[dt][mt] = (pg8::f32x4){0.f, 0.f, 0.f, 0.f}; }
    const int t_first = ctxq ? 6 : (qb == 0 ? 2 : 0), t_hi = ctxq ? 6 : (qb == SEQ / 128 - 1 ? 4 : 6);
    const int skey = tid >> 3, sdc = tid & 7;
    LAS unsigned char* lK = F.lds + ATT_KOFF; LAS unsigned char* lV = F.lds + ATT_VOFF;
    int cur = t_first, buf = 0;
    { const size_t rowb = cur < 6 ? (size_t)b * SEQ + (qb - 1) * 128 + 64 * cur : (size_t)MLAT + b * CTXL + 64 * (cur - 6);
      const bf16* src = G1 + (rowb + skey) * NIN_E + kvh * 64 + 8 * sdc;
      const v4u kr = *(const v4u*)(src + COL_K), vr = *(const v4u*)(src + COL_VAL);
      *(LAS v4u*)(lK + skey * KP + sdc * 16) = kr; *(LAS v4u*)(lV + skey * VP + sdc * 16) = vr; }
    __syncthreads();
    for (;;) {
        const int nxt = (cur < 6 && cur + 1 == t_hi) ? 6 : cur + 1; const bool has = nxt < 10;
        v4u kr = {0u, 0u, 0u, 0u}, vr = {0u, 0u, 0u, 0u};
        if (has) { const size_t rowb = nxt < 6 ? (size_t)b * SEQ + (qb - 1) * 128 + 64 * nxt : (size_t)MLAT + b * CTXL + 64 * (nxt - 6);
            const bf16* src = G1 + (rowb + skey) * NIN_E + kvh * 64 + 8 * sdc; kr = *(const v4u*)(src + COL_K); vr = *(const v4u*)(src + COL_VAL); }
        const bool skip = (cur == 0 && hw == 1) || (cur == 5 && hw == 0);
        if (!skip) {
            if (w >= 4) __builtin_amdgcn_s_sleep(7);
            const LAS unsigned char* kb = lK + buf * (64 * KP); const LAS unsigned char* vb = lV + buf * (64 * VP);
            pg8::bf16x8 Kf[4][2];
#pragma unroll
            for (int nt = 0; nt < 4; ++nt)
#pragma unroll
                for (int ks = 0; ks < 2; ++ks) Kf[nt][ks] = *(const LAS pg8::bf16x8*)(kb + (16 * nt + li) * KP + (32 * ks + 8 * g) * 2);
            const int kpos0 = (qb - 1) * 128 + 64 * cur;
            float alpha[4]; pg8::bf16x8 Pf[4][2];
#pragma unroll
            for (int mt = 0; mt < 4; ++mt) {
                pg8::f32x4 S[4];
#pragma unroll
                for (int nt = 0; nt < 4; ++nt) S[nt] = (pg8::f32x4){0.f, 0.f, 0.f, 0.f};
#pragma unroll
                for (int ks = 0; ks < 2; ++ks)
                    { const pg8::bf16x8 qf = *(const LAS pg8::bf16x8*)(lQ + (16 * mt + li) * KP + (32 * ks + 8 * g) * 2);
#pragma unroll
                    for (int nt = 0; nt < 4; ++nt) S[nt] = __builtin_amdgcn_mfma_f32_16x16x32_bf16(Kf[nt][ks], qf, S[nt], 0, 0, 0); }
                if (cur < 2 || cur == 4 || cur == 5) {
                    const int tq = qb * 128 + 64 * hw + 16 * mt + li;
#pragma unroll
                    for (int nt = 0; nt < 4; ++nt)
#pragma unroll
                        for (int r = 0; r < 4; ++r) { const int tk = kpos0 + 16 * nt + 4 * g + r; const int df = cur < 2 ? tq - tk : tk - tq; if (df > 128) S[nt][r] = -INFINITY; }
                }
                float mx = fmaxf(fmaxf(fmaxf(S[0][0], S[0][1]), fmaxf(S[0][2], S[0][3])), fmaxf(fmaxf(S[1][0], S[1][1]), fmaxf(S[1][2], S[1][3])));
                mx = fmaxf(mx, fmaxf(fmaxf(fmaxf(S[2][0], S[2][1]), fmaxf(S[2][2], S[2][3])), fmaxf(fmaxf(S[3][0], S[3][1]), fmaxf(S[3][2], S[3][3]))));
                mx = fmaxf(mx, __shfl_xor(mx, 16)); mx = fmaxf(mx, __shfl_xor(mx, 32));
                const float mnew = fmaxf(mrun[mt], mx); alpha[mt] = fexp2(mrun[mt] - mnew); mrun[mt] = mnew;
                float ls = 0.f;
#pragma unroll
                for (int nt = 0; nt < 4; ++nt)
#pragma unroll
                    for (int r = 0; r < 4; ++r) { const float p = fexp2(S[nt][r] - mnew); S[nt][r] = p; ls += p; }
                lrun[mt] = lrun[mt] * alpha[mt] + ls;
#pragma unroll
                for (int ks = 0; ks < 2; ++ks) { v4u pw; pw.x = pk2(S[2 * ks][0], S[2 * ks][1]); pw.y = pk2(S[2 * ks][2], S[2 * ks][3]); pw.z = pk2(S[2 * ks + 1][0], S[2 * ks + 1][1]); pw.w = pk2(S[2 * ks + 1][2], S[2 * ks + 1][3]);
                    Pf[mt][ks] = __builtin_bit_cast(pg8::bf16x8, pw); }
                if (mt == 1 && has) { LAS unsigned char* kd = lK + (buf ^ 1) * (64 * KP); LAS unsigned char* vd = lV + (buf ^ 1) * (64 * VP);
                    *(LAS v4u*)(kd + skey * KP + sdc * 16) = kr; *(LAS v4u*)(vd + skey * VP + sdc * 16) = vr; }
            }
#pragma unroll
            for (int dt = 0; dt < 4; ++dt) {
                pg8::bf16x8 Vf[2];
#pragma unroll
                for (int ks = 0; ks < 2; ++ks) {
                    const LAS unsigned char* p0 = vb + (32 * ks + 4 * g + (li >> 2)) * VP + (16 * dt + 4 * (li & 3)) * 2;
                    const s16x4 lo = lds_tr16(p0), hi = lds_tr16(p0 + 16 * VP);
                    Vf[ks] = (pg8::bf16x8){lo[0], lo[1], lo[2], lo[3], hi[0], hi[1], hi[2], hi[3]};
                }
#pragma unroll
                for (int mt = 0; mt < 4; ++mt) { O[dt][mt] = O[dt][mt] * alpha[mt];
#pragma unroll
                    for (int ks = 0; ks < 2; ++ks) O[dt][mt] = __builtin_amdgcn_mfma_f32_16x16x32_bf16(Vf[ks], Pf[mt][ks], O[dt][mt], 0, 0, 0); }
            }
        }
        if (skip && has) { LAS unsigned char* kd = lK + (buf ^ 1) * (64 * KP); LAS unsigned char* vd = lV + (buf ^ 1) * (64 * VP);
            *(LAS v4u*)(kd + skey * KP + sdc * 16) = kr; *(LAS v4u*)(vd + skey * VP + sdc * 16) = vr; }
        __syncthreads();
        if (!has) break;
        cur = nxt; buf ^= 1;
    }
#pragma unroll
    for (int mt = 0; mt < 4; ++mt) {
        float l = lrun[mt]; l += __shfl_xor(l, 16); l += __shfl_xor(l, 32); const float inv = 1.f / l;
        bf16* orow = MIX + (size_t)(qrow0 + 16 * mt + li) * DM + 512 + h * 64 + 4 * g;
#pragma unroll
        for (int dt = 0; dt < 4; ++dt) { v2u o; o.x = pk2(O[dt][mt][0] * inv, O[dt][mt][1] * inv); o.y = pk2(O[dt][mt][2] * inv, O[dt][mt][3] * inv); *(v2u*)(orow + 16 * dt) = o; }
    }
}
constexpr int SGP = 272;
__device__ __forceinline__ float red16(float v) { v += __shfl_xor(v, 1); v += __shfl_xor(v, 2); v += __shfl_xor(v, 4); v += __shfl_xor(v, 8); return v; }
__device__ __forceinline__ void sgu_unit(const Args& A, Frame& F, int chunk, int grp) {
    const bf16* G1 = (const bf16*)(A.ws + WS_G1); bf16* MIX = (bf16*)(A.ws + WS_MIX);
    const int lane = lane_id_asm(), tid = F.wave * 64 + lane, row0 = chunk * 128, w = F.wave, li = lane & 15, gq = lane >> 4;
    LAS unsigned char* vn = F.lds;
    { const int ck = tid & 15;
#pragma unroll
      for (int i = 0; i < 4; ++i) { const int row = (tid >> 4) + 32 * i;
        const v4u x = *(const v4u*)(G1 + (size_t)(row0 + row) * NIN_E + COL_V + grp * 128 + ck * 8);
        float f[8] = {bflo(x.x), bfhi(x.x), bflo(x.y), bfhi(x.y), bflo(x.z), bfhi(x.z), bflo(x.w), bfhi(x.w)};
        float s = ((f[0] + f[1]) + (f[2] + f[3])) + ((f[4] + f[5]) + (f[6] + f[7])); s = red16(s); const float mean = s * (1.f / 128.f);
        float ss = 0.f;
#pragma unroll
        for (int e = 0; e < 8; ++e) { f[e] -= mean; ss += f[e] * f[e]; }
        ss = red16(ss); const float rs = 1.f / sqrtf(ss * (1.f / 128.f) + EPS);
        v4u o; o.x = pk2(f[0] * rs, f[1] * rs); o.y = pk2(f[2] * rs, f[3] * rs); o.z = pk2(f[4] * rs, f[5] * rs); o.w = pk2(f[6] * rs, f[7] * rs);
        *(LAS v4u*)(vn + row * SGP + ck * 16) = o; } }
    __syncthreads();
    const bf16* Wb = (const bf16*)(A.ws + WS_SGW) + (size_t)(grp * 128 + 16 * w + li) * 128 + 8 * gq;
    pg8::bf16x8 Wf[4];
#pragma unroll
    for (int ks = 0; ks < 4; ++ks) Wf[ks] = *(const pg8::bf16x8*)(Wb + 32 * ks);
    pg8::f32x4 acc[8];
#pragma unroll
    for (int nt = 0; nt < 8; ++nt) acc[nt] = (pg8::f32x4){0.f, 0.f, 0.f, 0.f};
#pragma unroll
    for (int ks = 0; ks < 4; ++ks)
#pragma unroll
        for (int nt = 0; nt < 8; ++nt) {
            const LAS unsigned char* p0 = vn + (32 * ks + 8 * gq + (li >> 2)) * SGP + (16 * nt + 4 * (li & 3)) * 2;
            const s16x4 lo = lds_tr16(p0), hi = lds_tr16(p0 + 4 * SGP);
            const pg8::bf16x8 vf = (pg8::bf16x8){lo[0], lo[1], lo[2], lo[3], hi[0], hi[1], hi[2], hi[3]};
            acc[nt] = __builtin_amdgcn_mfma_f32_16x16x32_bf16(vf, Wf[ks], acc[nt], 0, 0, 0);
        }
    const float bias = A.in[10][grp * 128 + 16 * w + li];
    const size_t prow = (size_t)(row0 + 16 * w + li);
#pragma unroll
    for (int nt = 0; nt < 8; ++nt) {
        const v2u u = *(const v2u*)(G1 + prow * NIN_E + grp * 128 + 16 * nt + 4 * gq);
        v2u o; o.x = pk2(bflo(u.x) * (acc[nt][0] + bias), bfhi(u.x) * (acc[nt][1] + bias)); o.y = pk2(bflo(u.y) * (acc[nt][2] + bias), bfhi(u.y) * (acc[nt][3] + bias));
        *(v2u*)(MIX + prow * DM + grp * 128 + 16 * nt + 4 * gq) = o;
    }
    __syncthreads();
}
__device__ __forceinline__ void ph_mix(const Args& A, Frame& F) {
    constexpr int N_ATT = NB * (SEQ / 128) * 2, N_CATT = NB * (CTXL / 128) * 2, N_SGU = (MTOT / 128) * 4;
    for (int j = F.vcu; j < N_ATT; j += F.G) attn_unit(A, F, j >> 7, j & 1, (j >> 1) & 63, false);
    if (F.G > N_CATT) {
        if (F.vcu < N_CATT) { const int j = F.vcu; attn_unit(A, F, j >> 2, j & 1, (j >> 1) & 1, true); }
        else for (int s = F.vcu - N_CATT; s < N_SGU; s += F.G - N_CATT) sgu_unit(A, F, s >> 2, s & 3);
    } else {
        for (int j = F.vcu; j < N_CATT; j += F.G) attn_unit(A, F, j >> 2, j & 1, (j >> 1) & 1, true);
        for (int s = F.vcu; s < N_SGU; s += F.G) sgu_unit(A, F, s >> 2, s & 3);
    }
}

__global__ void __launch_bounds__(NTHR, 2) fwd_kernel(Args A) {
    extern __shared__ __attribute__((aligned(16))) unsigned char lds[];
    Frame F;
    F.lds = (LAS unsigned char*)lds; F.MISC = (volatile LAS unsigned*)(F.lds + MISC_OFF);
    F.wave = __builtin_amdgcn_readfirstlane((int)threadIdx.x >> 6);
    F.G = gridDim.x; { const int bx = blockIdx.x; F.vcu = (F.G % 8 == 0) ? (bx % 8) * (F.G / 8) + bx / 8 : bx; }
    unsigned char* ws = A.ws;
    F.ctl = (gu32*)(ws + WS_CTL);
    for (int u = threadIdx.x; u < (LDS_BYTES - LDSCTL_OFF) / 4; u += NTHR) ((LAS unsigned*)(F.lds + LDSCTL_OFF))[u] = 0u;
    __syncthreads();
    XcdBarrier bar; bar.bar = (unsigned*)(F.ctl + CW_BAR); bar.x = 0; bar.st = nullptr;
    if (MK_ONE_LAUNCH) bar = xcd_barrier_post((unsigned*)(F.ctl + CW_BAR), F.MISC + 8, threadIdx.x == 0);
    const int lo = A.ph_lo, hi = A.ph_hi;
#define IN(k) (lo <= (k) && (k) < hi)
    struct CvtFill { const Args* A; Frame* F; int k; __device__ __forceinline__ void operator()() const {
        if (F->wave != 0 && F->G == 256 && k < CVT_NFILL) { const int lane = lane_id_asm(); const int it = CVT_S7 + k * (256 * 7) + (int)blockIdx.x * 7 + (F->wave - 1);
            tr_run(MoeDesc{A}, (LAS float*)(F->lds + F->wave * 16384), lane, it, CVT_TOTAL, it < CVT_FILL_END ? it + 1 : it); } } };
#define SEAM(k) do { if (IN(k) && IN((k) + 1)) xcd_barrier_fill(bar, F.wave == 0 && lane_id_asm() == 0, CvtFill{&A, &F, (k)}); } while (0)
    const float* mod = (const float*)(ws + WS_MOD);
    bf16* Hb = (bf16*)(ws + WS_H); float* XC = (float*)(ws + WS_XC);

    if (IN(PH_PRO)) { ph_prologue(A, F); __syncthreads(); } SEAM(PH_PRO);
    if (IN(PH_NORM1E)) ph_norm(F, A.in[0], A.in[2], A.in[6], mod, 0, 1, Hb, MTOT, CtxFix{nullptr, 0, nullptr, nullptr, nullptr}); SEAM(PH_NORM1E);
    if (IN(PH_GIN_E)) {
        pg8::Gemm g{Hb, (const bf16*)(ws + WS_WINE), MTOT, NIN_E, DM, DM}; pg8::StaticOrder S; S.init(MTOT, NIN_E, F.G, (int)blockIdx.x);
        EpiInEven E{(bf16*)(ws + WS_G1), (const float*)(ws + WS_ROPE)};
        pg8::gemm_phase<EpiInEven, pg8::StaticOrder, true, true>(F.lds, g, S, E, F.wave);
        if ((int)blockIdx.x >= 206 && F.G == 256) convert_moe_range(A, F, 0, CVT_S1, 50, (int)blockIdx.x - 206);
    } SEAM(PH_GIN_E);
    if (IN(PH_MIX_E)) ph_mix(A, F); SEAM(PH_MIX_E);
    if (IN(PH_GOUT_E)) {
        { pg8::Gemm g{(const bf16*)(ws + WS_MIX), (const bf16*)(ws + WS_WOUTE), MLAT, DM, DM, DM}; pg8::StaticOrder S; S.init(MLAT, DM, F.G, (int)blockIdx.x);
          EpiResid E{A.in[0], A.in[2], A.out, XC, mod + 2 * 1024};
          pg8::gemm_phase<EpiResid, pg8::StaticOrder, true, true>(F.lds, g, S, E, F.wave); }
        { pg8::Gemm g{(const bf16*)(ws + WS_MIX), (const bf16*)(ws + WS_WOUTE), MTOT, DM, 256, DM}; CtxSplitOrder S{4, 512, F.G, (int)blockIdx.x};
          EpiPartial E{(float*)(ws + WS_PART), 512};
          pg8::gemm_phase<EpiPartial, CtxSplitOrder, true, true>(F.lds, g, S, E, F.wave); }
        if ((int)blockIdx.x >= 32 && F.G == 256) convert_moe_range(A, F, CVT_S5, CVT_S6, 224, (int)blockIdx.x - 32);
    } SEAM(PH_GOUT_E);
    if (IN(PH_NORM2E)) ph_norm(F, A.out, XC, A.in[7], mod, 3, 4, Hb, MTOT, CtxFix{(const float*)(ws + WS_PART), 4, mod + 2 * 6144 + 2 * 1024, A.in[2], XC}); SEAM(PH_NORM2E);
    if (IN(PH_FFN_UP)) {
        pg8::Gemm g{Hb, (const bf16*)(ws + WS_FFN13), MTOT, NFF2, DM, DM}; pg8::StaticOrder S; S.init(MTOT, NFF2, F.G, (int)blockIdx.x);
        EpiSwiGLU E{(bf16*)(ws + WS_FH), NFF2 / 256};
        pg8::gemm_phase<EpiSwiGLU, pg8::StaticOrder, true, true>(F.lds, g, S, E, F.wave);
        if ((int)blockIdx.x >= 172 && F.G == 256) convert_moe_range(A, F, CVT_S1, CVT_S2, 84, (int)blockIdx.x - 172);
    } SEAM(PH_FFN_UP);
    if (IN(PH_FFN_DN)) {
        { pg8::Gemm g{(const bf16*)(ws + WS_FH), (const bf16*)(ws + WS_FFN2), MLAT, DM, DFF, DFF}; pg8::StaticOrder S; S.init(MLAT, DM, F.G, (int)blockIdx.x);
          EpiResid E{A.out, XC, A.out, XC, mod + 5 * 1024};
          pg8::gemm_phase<EpiResid, pg8::StaticOrder, true, true>(F.lds, g, S, E, F.wave); }
        { pg8::Gemm g{(const bf16*)(ws + WS_FH), (const bf16*)(ws + WS_FFN2), MTOT, DM, 256, DFF}; CtxSplitOrder S{11, 512, F.G, (int)blockIdx.x};
          EpiPartial E{(float*)(ws + WS_PART), 512};
          pg8::gemm_phase<EpiPartial, CtxSplitOrder, true, true>(F.lds, g, S, E, F.wave); }
        if ((int)blockIdx.x >= 88 && F.G == 256) convert_moe_range(A, F, CVT_S6, CVT_S7, 168, (int)blockIdx.x - 88);
    } SEAM(PH_FFN_DN);
    if (IN(PH_NORM1O)) ph_norm(F, A.out, XC, A.in[18], mod + 3 * 6144, 0, 1, Hb, MTOT, CtxFix{(const float*)(ws + WS_PART), 11, mod + 2 * 6144 + 5 * 1024, XC, XC}); SEAM(PH_NORM1O);
    if (IN(PH_GIN_O)) {
        pg8::Gemm g{Hb, (const bf16*)(ws + WS_WINO), MTOT, NIN_O, DM, DM}; pg8::StaticOrder S; S.init(MTOT, NIN_O, F.G, (int)blockIdx.x);
        EpiStore E{(bf16*)(ws + WS_G2), NIN_O, NIN_O / 256, 5};
        pg8::gemm_phase<EpiStore, pg8::StaticOrder, true, true>(F.lds, g, S, E, F.wave);
        if ((int)blockIdx.x >= 138 && F.G == 256) convert_moe_range(A, F, CVT_S2, CVT_S3, 118, (int)blockIdx.x - 138);
    } SEAM(PH_GIN_O);
    if (IN(PH_LRU_G)) { ph_lru<false>(A, F); if ((int)blockIdx.x >= 148 && F.G == 256) convert_moe_range(A, F, CVT_S3, CVT_S4, 108, (int)blockIdx.x - 148); } SEAM(PH_LRU_G);
    if (IN(PH_LRU_S)) { ph_lru<true>(A, F); if ((int)blockIdx.x >= 128 && F.G == 256) convert_moe_range(A, F, CVT_S4, CVT_S5, 128, (int)blockIdx.x - 128); } SEAM(PH_LRU_S);
    if (IN(PH_GOUT_O)) {
        pg8::Gemm g{(const bf16*)(ws + WS_Y1), (const bf16*)(ws + WS_WOUTO), MLAT, DM, DRNN, DRNN}; pg8::StaticOrder S; S.init(MLAT, DM, F.G, (int)blockIdx.x);
        EpiResid E{A.out, XC, A.out, XC, mod + 3 * 6144 + 2 * 1024};
        pg8::gemm_phase<EpiResid, pg8::StaticOrder, true, true>(F.lds, g, S, E, F.wave);
    } SEAM(PH_GOUT_O);
    if (IN(PH_ROUTE)) { ph_route(A, F); if (F.G == 256) convert_moe_range(A, F, CVT_FILL_END, CVT_TOTAL, F.G, F.vcu); else convert_moe_range(A, F, 0, CVT_TOTAL, F.G, F.vcu); } SEAM(PH_ROUTE);
    if (IN(PH_PERM)) ph_permute(A, F); SEAM(PH_PERM);
    if (IN(PH_MOE_UP)) {
        const int* meta = (const int*)(ws + WS_META); const int nt = __builtin_amdgcn_readfirstlane(ld_i32_agent(meta + 256));
        pg8::Gemm g{(const bf16*)(ws + WS_HP), (const bf16*)(ws + WS_MOE13), MOE_ROWS, NFF2, DM, DM}; MoeOrder S{meta, nt, NFF2 / 256, F.G, (int)blockIdx.x};
        EpiSwiGLU E{(bf16*)(ws + WS_MH), NFF2 / 256};
        pg8::gemm_phase<EpiSwiGLU, MoeOrder, true, true>(F.lds, g, S, E, F.wave);
    } SEAM(PH_MOE_UP);
    if (IN(PH_MOE_DN)) {
        const int* meta = (const int*)(ws + WS_META); const int nt = __builtin_amdgcn_readfirstlane(ld_i32_agent(meta + 256));
        { pg8::Gemm g{(const bf16*)(ws + WS_MH), (const bf16*)(ws + WS_MOE2), MOE_ROWS, DM, DFF, DFF}; MoeOrder S{meta, nt < 128 ? nt : 128, DM / 256, F.G, (int)blockIdx.x};
          EpiStore E{(bf16*)(ws + WS_YD), DM, DM / 256, 0};
          pg8::gemm_phase<EpiStore, MoeOrder, true, true>(F.lds, g, S, E, F.wave); }
        { pg8::Gemm g{(const bf16*)(ws + WS_MH), (const bf16*)(ws + WS_MOE2), MOE_ROWS, DM, 256, DFF}; MoeTailOrder S{meta, nt > 128 ? nt - 128 : 0, F.G, (int)blockIdx.x};
          EpiPartialBf16 E{(bf16*)(ws + WS_PARTM)};
          pg8::gemm_phase<EpiPartialBf16, MoeTailOrder, true, true>(F.lds, g, S, E, F.wave); }
    } SEAM(PH_MOE_DN);
    if (IN(PH_COMB)) ph_combine(A, F, A.out);
#undef IN
#undef SEAM
}

extern "C" void kernel_launch(void* const* d_in, const int* in_sizes, int n_in, void* d_out, int out_size, void* d_ws, size_t ws_size, hipStream_t stream) {
    static int grid = 0;
    if (grid == 0) {
        if (n_in != 34 || in_sizes[0] != MLAT * DM || out_size != MLAT * DM || ws_size < WS_NEED) { fprintf(stderr, "kernel_launch: unexpected shapes (n_in %d, out %d, ws %zu)\n", n_in, out_size, ws_size); grid = -1; return; }
        int dev = 0, cus = 0, per_cu = 0;
        if (hipGetDevice(&dev) != hipSuccess || hipDeviceGetAttribute(&cus, hipDeviceAttributeMultiprocessorCount, dev) != hipSuccess) { grid = -1; return; }
        if (hipFuncSetAttribute((const void*)fwd_kernel, hipFuncAttributeMaxDynamicSharedMemorySize, LDS_BYTES) != hipSuccess) { grid = -1; return; }
        if (hipOccupancyMaxActiveBlocksPerMultiprocessor(&per_cu, (const void*)fwd_kernel, NTHR, LDS_BYTES) != hipSuccess || per_cu < 1) { fprintf(stderr, "kernel_launch: occupancy query says %d\n", per_cu); }
        (void)hipGetLastError();
        grid = cus;
    }
    if (grid < 0) return;
    (void)hipMemsetAsync((char*)d_ws + WS_CTL, 0, CTL_ZERO_BYTES, stream);
    Args a{};
    for (int i = 0; i < 34; ++i) a.in[i] = (const float*)d_in[i];
    a.out = (float*)d_out; a.ws = (unsigned char*)d_ws;
#if MK_ONE_LAUNCH
    a.ph_lo = 0; a.ph_hi = NPH;
    hipLaunchKernelGGL(fwd_kernel, dim3(grid), dim3(NTHR), LDS_BYTES, stream, a);
#else
    for (int p = 0; p < NPH; ++p) { a.ph_lo = p; a.ph_hi = p + 1; hipLaunchKernelGGL(fwd_kernel, dim3(grid), dim3(NTHR), LDS_BYTES, stream, a); }
#endif
}
```
